# Optimizing an MI355X kernel written in HIP

```python
import functools
import jax, jax.numpy as jnp
from jax import lax
import numpy as np

D_MODEL = 2048
BATCH = 4
SEQ = 8192
DEPTH = 4
DEC_BATCH = 8
DEC_SEQ = 16
PAST_LEN = 1024

CHUNK = 64
N_MIXERS = 2
A_HEADS = 16
A_HEAD_DIM = D_MODEL // A_HEADS
A_PREV_CHUNKS = 8
A_REL_CLIP = 128
B_WINDOW = 128
B_PREV_CHUNKS = B_WINDOW // CHUNK
B_HEAD_DIM = 64
B_Q_HEADS = D_MODEL // B_HEAD_DIM
B_KV_HEADS = 8
B_GROUP = B_Q_HEADS // B_KV_HEADS
D_FF = 4 * D_MODEL
RMS_EPS = 1e-6
NEG_INF = -1e30

kernel_name = 'chunk_streaming_hybrid_encoder_step'


def _n_layers_of(kind):
    return len([i for i in range(DEPTH) if i % N_MIXERS == kind])


def _rmsnorm(x, g):
    x32 = x.astype(jnp.float32)
    y = x32 * lax.rsqrt(jnp.mean(x32 * x32, axis=-1, keepdims=True) + RMS_EPS)
    return (y * g.astype(jnp.float32)).astype(x.dtype)


def _sq_relu_mlp(h, w_up, w_down):
    return jnp.square(jax.nn.relu(h @ w_up)) @ w_down


def _relpos_bias(table, rel):
    idx = jnp.clip(rel, -A_REL_CLIP, A_REL_CLIP) + A_REL_CLIP
    return table.astype(jnp.float32)[:, idx][:, None]


def _alibi_bias(rel):
    slopes = jnp.asarray(2.0 ** (-8.0 * np.arange(1, B_Q_HEADS + 1) / B_Q_HEADS), dtype=jnp.float32)
    b = -slopes[:, None, None] * jnp.abs(rel).astype(jnp.float32)[None]
    return b.reshape((B_KV_HEADS, B_GROUP) + rel.shape)


def _attend(q, k, v, bias, valid, sinks):
    scale = q.shape[-1] ** -0.5
    s = jnp.einsum('bqhgd,bkhd->bhgqk', q, k).astype(jnp.float32) * scale + bias
    s = jnp.where(valid, s, NEG_INF)
    if sinks is not None:
        sink_col = jnp.broadcast_to(sinks.astype(jnp.float32)[None, :, :, None, None], s.shape[:-1] + (1,))
        p = jax.nn.softmax(jnp.concatenate([s, sink_col], axis=-1), axis=-1)[..., :-1]
    else:
        p = jax.nn.softmax(s, axis=-1)
    o = jnp.einsum('bhgqk,bkhd->bqhgd', p.astype(v.dtype), v)
    return o.reshape(o.shape[0], o.shape[1], -1)


def _band_prompt(q, k, v, n_prev, bias_fn, sinks):
    b, s = q.shape[:2]
    pad = n_prev * CHUNK
    band = pad + CHUNK
    kp = jnp.pad(k, ((0, 0), (pad, 0), (0, 0), (0, 0)))
    vp = jnp.pad(v, ((0, 0), (pad, 0), (0, 0), (0, 0)))
    i = jnp.arange(CHUNK)[:, None]
    j = jnp.arange(band)[None, :]
    bias = bias_fn(j - pad - i)

    def one_chunk(c):
        start = c * CHUNK
        qc = lax.dynamic_slice_in_dim(q, start, CHUNK, axis=1)
        kc = lax.dynamic_slice_in_dim(kp, start, band, axis=1)
        vc = lax.dynamic_slice_in_dim(vp, start, band, axis=1)
        valid = j >= pad - start
        return _attend(qc, kc, vc, bias, valid, sinks)

    out = lax.map(one_chunk, jnp.arange(s // CHUNK))
    return out.transpose(1, 0, 2, 3).reshape(b, s, -1)


def _band_sample(q, k_new, v_new, k_cache, v_cache, bias_fn, sinks):
    cl = k_cache.shape[1]
    t = q.shape[1]
    k = jnp.concatenate([k_cache, k_new.astype(k_cache.dtype)], axis=1)
    v = jnp.concatenate([v_cache, v_new.astype(v_cache.dtype)], axis=1)
    qpos = PAST_LEN + jnp.arange(t)
    kpos = jnp.concatenate([PAST_LEN - cl + jnp.arange(cl), PAST_LEN + jnp.arange(t)])
    rel = kpos[None, :] - qpos[:, None]
    valid = jnp.ones(rel.shape, dtype=bool)
    out = _attend(q, k, v, bias_fn(rel), valid, sinks)
    return out, k[:, t:], v[:, t:]


def _qkv_a(h, w_qkv):
    b, s = h.shape[:2]
    q, k, v = jnp.split(h @ w_qkv, 3, axis=-1)
    return (q.reshape(b, s, A_HEADS, 1, A_HEAD_DIM),
            k.reshape(b, s, A_HEADS, A_HEAD_DIM),
            v.reshape(b, s, A_HEADS, A_HEAD_DIM))


def _qkv_b(h, w_qkv):
    b, s = h.shape[:2]
    qkv = h @ w_qkv
    qd = B_Q_HEADS * B_HEAD_DIM
    kd = B_KV_HEADS * B_HEAD_DIM
    return (qkv[..., :qd].reshape(b, s, B_KV_HEADS, B_GROUP, B_HEAD_DIM),
            qkv[..., qd:qd + kd].reshape(b, s, B_KV_HEADS, B_HEAD_DIM),
            qkv[..., qd + kd:].reshape(b, s, B_KV_HEADS, B_HEAD_DIM))


def setup_inputs(seed: int = 0) -> dict:
    key = jax.random.key(seed)
    ks = jax.random.split(key, 17)
    n_a = _n_layers_of(0)
    n_b = _n_layers_of(1)
    cl_a = min(A_PREV_CHUNKS * CHUNK, PAST_LEN)
    cl_b = min(B_PREV_CHUNKS * CHUNK, PAST_LEN)
    f32 = jnp.float32

    def nrm(k, shape, scale):
        return scale * jax.random.normal(k, shape, f32)

    qkv_a_w = 3 * A_HEADS * A_HEAD_DIM
    qkv_b_w = (B_Q_HEADS + 2 * B_KV_HEADS) * B_HEAD_DIM
    return {
        'x_prompt': nrm(ks[0], (BATCH, SEQ, D_MODEL), 1.0),
        'x_sample': nrm(ks[1], (DEC_BATCH, DEC_SEQ, D_MODEL), 1.0),
        'cache_a_k': nrm(ks[2], (n_a, DEC_BATCH, cl_a, A_HEADS, A_HEAD_DIM), 1.0),
        'cache_a_v': nrm(ks[3], (n_a, DEC_BATCH, cl_a, A_HEADS, A_HEAD_DIM), 1.0),
        'cache_b_k': nrm(ks[4], (n_b, DEC_BATCH, cl_b, B_KV_HEADS, B_HEAD_DIM), 1.0),
        'cache_b_v': nrm(ks[5], (n_b, DEC_BATCH, cl_b, B_KV_HEADS, B_HEAD_DIM), 1.0),
        'norm_mix': 1.0 + nrm(ks[6], (DEPTH, D_MODEL), 0.02),
        'norm_ffn': 1.0 + nrm(ks[7], (DEPTH, D_MODEL), 0.02),
        'norm_final': 1.0 + nrm(ks[8], (D_MODEL,), 0.02),
        'a_w_qkv': nrm(ks[9], (n_a, D_MODEL, qkv_a_w), D_MODEL ** -0.5),
        'a_w_o': nrm(ks[10], (n_a, A_HEADS * A_HEAD_DIM, D_MODEL), (A_HEADS * A_HEAD_DIM) ** -0.5),
        'a_rel_bias': nrm(ks[11], (n_a, A_HEADS, 2 * A_REL_CLIP + 1), 0.5),
        'b_w_qkv': nrm(ks[12], (n_b, D_MODEL, qkv_b_w), D_MODEL ** -0.5),
        'b_w_o': nrm(ks[13], (n_b, B_Q_HEADS * B_HEAD_DIM, D_MODEL), (B_Q_HEADS * B_HEAD_DIM) ** -0.5),
        'b_sinks': nrm(ks[14], (n_b, B_Q_HEADS), 1.0),
        'w_up': nrm(ks[15], (DEPTH, D_MODEL, D_FF), D_MODEL ** -0.5),
        'w_down': nrm(ks[16], (DEPTH, D_FF, D_MODEL), D_FF ** -0.5),
    }


def reference(x_prompt, x_sample, cache_a_k, cache_a_v, cache_b_k, cache_b_v,
              norm_mix, norm_ffn, norm_final, a_w_qkv, a_w_o, a_rel_bias,
              b_w_qkv, b_w_o, b_sinks, w_up, w_down):
    xp, xs = x_prompt, x_sample
    s_len = xp.shape[1]
    a_kp, a_vp, a_ks, a_vs = [], [], [], []
    b_kp, b_vp, b_ks, b_vs = [], [], [], []
    for layer in range(DEPTH):
        slot = layer // N_MIXERS
        hp = _rmsnorm(xp, norm_mix[layer])
        hs = _rmsnorm(xs, norm_mix[layer])
        if layer % N_MIXERS == 0:
            bias_fn = functools.partial(_relpos_bias, a_rel_bias[slot])
            qp, kp, vp = _qkv_a(hp, a_w_qkv[slot])
            qs, kn, vn = _qkv_a(hs, a_w_qkv[slot])
            mp = _band_prompt(qp, kp, vp, A_PREV_CHUNKS, bias_fn, None)
            ms, nk, nv = _band_sample(qs, kn, vn, cache_a_k[slot], cache_a_v[slot], bias_fn, None)
            cl = min(A_PREV_CHUNKS * CHUNK, s_len)
            a_kp.append(kp[:, s_len - cl:])
            a_vp.append(vp[:, s_len - cl:])
            a_ks.append(nk)
            a_vs.append(nv)
            xp = xp + mp @ a_w_o[slot]
            xs = xs + ms @ a_w_o[slot]
        else:
            sinks = b_sinks[slot].reshape(B_KV_HEADS, B_GROUP)
            qp, kp, vp = _qkv_b(hp, b_w_qkv[slot])
            qs, kn, vn = _qkv_b(hs, b_w_qkv[slot])
            mp = _band_prompt(qp, kp, vp, B_PREV_CHUNKS, _alibi_bias, sinks)
            ms, nk, nv = _band_sample(qs, kn, vn, cache_b_k[slot], cache_b_v[slot], _alibi_bias, sinks)
            cl = min(B_PREV_CHUNKS * CHUNK, s_len)
            b_kp.append(kp[:, s_len - cl:])
            b_vp.append(vp[:, s_len - cl:])
            b_ks.append(nk)
            b_vs.append(nv)
            xp = xp + mp @ b_w_o[slot]
            xs = xs + ms @ b_w_o[slot]
        xp = xp + _sq_relu_mlp(_rmsnorm(xp, norm_ffn[layer]), w_up[layer], w_down[layer])
        xs = xs + _sq_relu_mlp(_rmsnorm(xs, norm_ffn[layer]), w_up[layer], w_down[layer])
    y_prompt = _rmsnorm(xp, norm_final)
    y_sample = _rmsnorm(xs, norm_final)
    return (y_prompt, y_sample,
            jnp.stack(a_kp), jnp.stack(a_vp), jnp.stack(b_kp), jnp.stack(b_vp),
            jnp.stack(a_ks), jnp.stack(a_vs), jnp.stack(b_ks), jnp.stack(b_vs))
```

```cpp
#include <hip/hip_runtime.h>
#include <cstdio>
#include <cstdint>
template <int K> __device__ __forceinline__ float xl_swz(float v) { return __builtin_bit_cast(float, __builtin_amdgcn_ds_swizzle(__builtin_bit_cast(int, v), (K << 10) | 0x1f)); }
__device__ __forceinline__ void xl_swap32(float& a, float& b) { asm volatile("s_nop 1\n\tv_permlane32_swap_b32 %0, %1" : "+v"(a), "+v"(b)); }
__device__ __forceinline__ float xl_add32(float v) { float a = v, b = v; xl_swap32(a, b); return a + b; }
__device__ __forceinline__ float xl_max32(float v) { float a = v, b = v; xl_swap32(a, b); return fmaxf(a, b); }
__device__ __forceinline__ float xl_wave_sum(float v) { v += xl_swz<1>(v); v += xl_swz<2>(v); v += xl_swz<4>(v); v += xl_swz<8>(v); v += xl_swz<16>(v); return xl_add32(v); }
__device__ __forceinline__ float xl_wave_max(float v) { v = fmaxf(v, xl_swz<1>(v)); v = fmaxf(v, xl_swz<2>(v)); v = fmaxf(v, xl_swz<4>(v)); v = fmaxf(v, xl_swz<8>(v)); v = fmaxf(v, xl_swz<16>(v)); return xl_max32(v); }
namespace pg8 {
#define PG8_LAS __attribute__((address_space(3)))
typedef unsigned short bf16_t;
typedef short bf16x8 __attribute__((ext_vector_type(8)));
typedef float f32x4 __attribute__((ext_vector_type(4)));
typedef unsigned u32x4 __attribute__((ext_vector_type(4)));
constexpr int BM = 256, BK = 64, HALF = 128, HTB = HALF * BK * 2  , STAGE_BYTES = 8 * HTB, NXCD = 8, WGM = 8;

__host__ __device__ __forceinline__ int lds_byte(int r, int c) { const int st = (r >> 4) * 2 + (c >> 5), rr = r & 15, cc = c & 31, ob = rr * 64 + cc * 2; return st * 1024 + (ob ^ (((ob >> 9) & 1) << 5)); }
__host__ __device__ __forceinline__ void stage_rc(int b, int& R, int& C) { const int st = b / 1024, sb = b % 1024, swz = sb ^ (((sb >> 9) & 1) << 5); R = (st >> 1) * 16 + swz / 64; C = (st & 1) * 32 + (swz % 64) / 2; }
__host__ __device__ __forceinline__ int perm32(int rho) { const int n = rho >> 4, i = rho & 15; return 8 * (i >> 2) + 4 * n + (i & 3); }

struct Unit { int pm, pn; };
struct Gemm { const bf16_t* A; const bf16_t* Bt; int M, N, K; };

struct StaticOrder {
    int nM, nN, nwg, G, c;
    __host__ __device__ void init(int M, int N, int G_, int c_) { nM = M / BM; nN = N / BM; nwg = nM * nN; G = G_; c = c_; }
    __host__ __device__ bool next(int i, Unit& u) const {
        const long L = (long)i * G + c; if (L >= nwg) return false;
        int wgid = (int)L; { const int q = nwg / NXCD, r = nwg % NXCD, xcd = wgid % NXCD, off = wgid / NXCD; wgid = (xcd < r ? xcd * (q + 1) : r * (q + 1) + (xcd - r) * q) + off; }
        const int nig = WGM * nN, gid = wgid / nig, fm = gid * WGM, gsz = (nM - fm) < WGM ? (nM - fm) : WGM;
        u.pm = fm + ((wgid % nig) % gsz); u.pn = (wgid % nig) / gsz; return true;
    }
    __device__ __forceinline__ void a_ready(const Unit&) const {}
    __device__ __forceinline__ void done(const Unit&) const {}
};

__device__ __forceinline__ unsigned cvt_pk_bf16(float lo, float hi) { unsigned r; asm volatile("v_cvt_pk_bf16_f32 %0, %1, %2" : "=v"(r) : "v"(lo), "v"(hi)); return r; }
typedef float f32x2 __attribute__((ext_vector_type(2)));
__device__ __forceinline__ float row_rstd(const float* SS, int row, int fq) {
    const f32x4* p = (const f32x4*)(SS + (size_t)row * 32 + fq * 8); const f32x4 a = p[0], b = p[1];
    float s = ((a[0] + a[1]) + (a[2] + a[3])) + ((b[0] + b[1]) + (b[2] + b[3]));
    s += xl_swz<16>(s); s = xl_add32(s);
    return __builtin_amdgcn_rsqf(s * (1.0f / 2048.0f) + 1e-6f);
}
constexpr int ROWS_P = 32768, ROWS_R = 32896;
constexpr size_t WS_XB_ = (size_t)361 << 20, WS_SS0_ = (size_t)490 << 20, WS_SS1_ = (size_t)495 << 20, WS_Q_ = (size_t)500 << 20, WS_K_ = (size_t)629 << 20, WS_V_ = (size_t)758 << 20;
template <bool ISB> struct EpiQKV {
    static constexpr bool PERM = true, AFTER_DRAIN = false;
    unsigned char* ws; float* out; int pr;
    __device__ __forceinline__ void operator()(const f32x4 (&acc)[2][2][4][2], const Unit& u, int wr, int wc, int fr, int fq) const {
        constexpr int nkv = ISB ? 512 : 2048, CL = ISB ? 128 : 512;
        constexpr float qscale = (ISB ? 0.125f : 0.08838834764831845f) * 1.4426950408889634f;
        constexpr size_t OKP = ISB ? 84148224 : 67371008, OVP = ISB ? 84672512 : 75759616, OKS = ISB ? 118751232 : 85196800, OVS = ISB ? 119799808 : 101974016;
        const float* SS = (const float*)(ws + WS_SS0_);
        const int colt = u.pn * BM; const int region = colt < 2048 ? 0 : (colt < 2048 + nkv ? 1 : 2);
        const int cbase = (region == 0 ? colt : (region == 1 ? colt - 2048 : colt - 2048 - nkv)) + wc * 32 + 8 * fq;
        bf16_t* const ob = (bf16_t*)(ws + (region == 0 ? WS_Q_ : (region == 1 ? WS_K_ : WS_V_))); const int ld = region == 0 ? 2048 : nkv;
        float* const stp = out + (region == 1 ? OKP : OVP) + (size_t)pr * 4 * CL * nkv; float* const sts = out + (region == 1 ? OKS : OVS) + (size_t)pr * 8 * CL * nkv;
        const float sc = region == 0 ? qscale : 1.0f;
#pragma unroll
        for (int ai = 0; ai < 2; ++ai)
#pragma unroll
            for (int m = 0; m < 4; ++m) {
                const int row = u.pm * BM + ai * HALF + wr * 64 + m * 16 + fr;
                const float rs = row_rstd(SS, row, fq) * sc;
                int srow = -1;
                if (region != 0) {
                    if (row < ROWS_P) { const int t = row & 8191, b = row >> 13; if (t >= 8192 - CL) srow = b * CL + (t - (8192 - CL)); }
                    else if (row < ROWS_R) { const int r = row - ROWS_P; srow = (r >> 4) * CL + (CL - 16 + (r & 15)); }
                }
                float* const sp = row < ROWS_P ? stp : sts;
#pragma unroll
                for (int bj = 0; bj < 2; ++bj) {
                    const f32x4 v0 = acc[ai][bj][m][0] * rs, v1 = acc[ai][bj][m][1] * rs; const int col = cbase + bj * HALF;
                    u32x4 w; w.x = cvt_pk_bf16(v0[0], v0[1]); w.y = cvt_pk_bf16(v0[2], v0[3]); w.z = cvt_pk_bf16(v1[0], v1[1]); w.w = cvt_pk_bf16(v1[2], v1[3]);
                    *(u32x4*)(ob + (size_t)row * ld + col) = w;
                    if (srow >= 0) { float* d = sp + (size_t)srow * nkv + col; *(f32x4*)d = v0; *(f32x4*)(d + 4) = v1; }
                }
            }
    }
};
struct EpiRes {
    static constexpr bool PERM = true, AFTER_DRAIN = false;
    const float* xin_p; const float* xin_s; float* xout; unsigned char* ws; int sssel;
    __device__ __forceinline__ void operator()(const f32x4 (&acc)[2][2][4][2], const Unit& u, int wr, int wc, int fr, int fq) const {
        const int col0 = u.pn * BM + wc * 32 + 8 * fq; bf16_t* const XB = (bf16_t*)(ws + WS_XB_); float* const SSout = (float*)(ws + (sssel ? WS_SS1_ : WS_SS0_));
#pragma unroll
        for (int ai = 0; ai < 2; ++ai)
#pragma unroll
            for (int m = 0; m < 4; ++m) {
                const int row = u.pm * BM + ai * HALF + wr * 64 + m * 16 + fr; const bool valid = row < ROWS_R;
                const float* xr = row < ROWS_P ? xin_p + (size_t)row * 2048 : xin_s + (size_t)(row - ROWS_P) * 2048;
                float ssq = 0.f;
                if (valid) {
#pragma unroll
                    for (int bj = 0; bj < 2; ++bj) { const int col = col0 + bj * HALF;
                        f32x4 a = *(const f32x4*)(xr + col), b = *(const f32x4*)(xr + col + 4);
                        a = a + acc[ai][bj][m][0]; b = b + acc[ai][bj][m][1];
                        *(f32x4*)(xout + (size_t)row * 2048 + col) = a; *(f32x4*)(xout + (size_t)row * 2048 + col + 4) = b;
                        u32x4 w; w.x = cvt_pk_bf16(a[0], a[1]); w.y = cvt_pk_bf16(a[2], a[3]); w.z = cvt_pk_bf16(b[0], b[1]); w.w = cvt_pk_bf16(b[2], b[3]);
                        *(u32x4*)(XB + (size_t)row * 2048 + col) = w;
                        ssq += ((a[0] * a[0] + a[1] * a[1]) + (a[2] * a[2] + a[3] * a[3])) + ((b[0] * b[0] + b[1] * b[1]) + (b[2] * b[2] + b[3] * b[3])); }
                }
                ssq += xl_swz<16>(ssq); ssq = xl_add32(ssq);
                if (fq == 0) SSout[(size_t)row * 32 + u.pn * 4 + wc] = ssq;
            }
    }
};
struct EpiUp {
    static constexpr bool PERM = true, AFTER_DRAIN = false;
    unsigned char* ws;
    __device__ __forceinline__ void operator()(const f32x4 (&acc)[2][2][4][2], const Unit& u, int wr, int wc, int fr, int fq) const {
        const int col0 = u.pn * BM + wc * 32 + 8 * fq; bf16_t* const H = (bf16_t*)(ws + WS_Q_); const float* const SS = (const float*)(ws + WS_SS1_);
#pragma unroll
        for (int ai = 0; ai < 2; ++ai)
#pragma unroll
            for (int m = 0; m < 4; ++m) {
                const int row = u.pm * BM + ai * HALF + wr * 64 + m * 16 + fr;
                const float rs = row_rstd(SS, row, fq);
#pragma unroll
                for (int bj = 0; bj < 2; ++bj) {
                    f32x4 v0 = acc[ai][bj][m][0] * rs, v1 = acc[ai][bj][m][1] * rs;
#pragma unroll
                    for (int e = 0; e < 4; ++e) { const float a = fmaxf(v0[e], 0.f), b = fmaxf(v1[e], 0.f); v0[e] = a * a; v1[e] = b * b; }
                    u32x4 w; w.x = cvt_pk_bf16(v0[0], v0[1]); w.y = cvt_pk_bf16(v0[2], v0[3]); w.z = cvt_pk_bf16(v1[0], v1[1]); w.w = cvt_pk_bf16(v1[2], v1[3]);
                    *(u32x4*)(H + (size_t)row * 8192 + col0 + bj * HALF) = w;
                }
            }
    }
};
template <class Epi, class Sched, bool ALIGN_EPI = false, bool SP2 = false>
__device__ __forceinline__ void gemm_phase(PG8_LAS unsigned char* lds, const Gemm g, const Sched& S, const Epi& E, const int tid_in) {
    int tid_ = tid_in; asm volatile("" : "+v"(tid_));
    const int tid = tid_, wid = __builtin_amdgcn_readfirstlane(tid >> 6), lane = tid & 63, wr = wid >> 2, wc = wid & 3, fr = lane & 15, fq = lane >> 4;
    const int K = g.K, nt = K / BK;
    unsigned voffA[2], voffB[2];
#pragma unroll
    for (int i = 0; i < 2; ++i) { int R, C; stage_rc(tid * 16 + i * 8192, R, C); const int Rb = Epi::PERM ? ((R & ~31) + perm32(R & 31)) : R;
        voffA[i] = (unsigned)(R * K + C) * 2u; voffB[i] = (unsigned)(Rb * K + C) * 2u; }
    const size_t kstep = (size_t)(BK * 2);
    const size_t hstep = (size_t)HALF * K * 2;
    const size_t tstep = 2 * hstep;
    const unsigned ldsw = (unsigned)wid * 1024u;
    const int aoff = lds_byte(wr * 64 + fr, fq * 8), boff = lds_byte(wc * 32 + fr, fq * 8);
#define PG8_SA(b, h) (((b) * 2 + (h)) * HTB)
#define PG8_SB(b, h) ((4 + (b) * 2 + (h)) * HTB)
#define PG8_STAGE(bufoff, gbase, voff) do { _Pragma("unroll") for (int _i = 0; _i < 2; ++_i) \
        __builtin_amdgcn_global_load_lds((const unsigned*)((const char*)(gbase) + (voff)[_i]), (PG8_LAS unsigned*)(lds + (bufoff) + ldsw + _i * 8192), 16, 0, 0); } while (0)
#define PG8_LDA(dst, b, h) do { _Pragma("unroll") for (int m = 0; m < 4; ++m) _Pragma("unroll") for (int k = 0; k < 2; ++k) dst[m][k] = *(const PG8_LAS bf16x8*)(lds + PG8_SA(b, h) + aoff + m * 2048 + k * 1024); } while (0)
#define PG8_LDB(dst, b, h) do { _Pragma("unroll") for (int n = 0; n < 2; ++n) _Pragma("unroll") for (int k = 0; k < 2; ++k) dst[n][k] = *(const PG8_LAS bf16x8*)(lds + PG8_SB(b, h) + boff + n * 2048 + k * 1024); } while (0)
#define PG8_MMA(ai, bj, At, Bt) do { __builtin_amdgcn_s_setprio(1); _Pragma("unroll") for (int m = 0; m < 4; ++m) _Pragma("unroll") for (int n = 0; n < 2; ++n) _Pragma("unroll") for (int k = 0; k < 2; ++k) \
        acc[ai][bj][m][n] = __builtin_amdgcn_mfma_f32_16x16x32_bf16(Bt[n][k], At[m][k], acc[ai][bj][m][n], 0, 0, 0); __builtin_amdgcn_s_setprio(0); } while (0)
#define PG8_WAIT_V(n) asm volatile("s_waitcnt vmcnt(" #n ")" ::: "memory")
#define PG8_WAIT_L(n) asm volatile("s_waitcnt lgkmcnt(" #n ")" ::: "memory")
#define PG8_BAR __builtin_amdgcn_s_barrier()
#define PG8_SCHED __builtin_amdgcn_sched_barrier(0)
    Unit cur, nxt; int ui = 0;
    if (!S.next(0, cur)) return;
    f32x4 acc[2][2][4][2];
#pragma unroll
    for (int a = 0; a < 2; ++a)
#pragma unroll
        for (int b = 0; b < 2; ++b)
#pragma unroll
            for (int m = 0; m < 4; ++m)
#pragma unroll
                for (int n = 0; n < 2; ++n) acc[a][b][m][n] = (f32x4){0.f, 0.f, 0.f, 0.f};
    bf16x8 At[4][2], B0[2][2], B1[2][2];
    const char* cA = (const char*)g.A + (size_t)cur.pm * tstep; const char* cB = (const char*)g.Bt + (size_t)cur.pn * tstep;
    S.a_ready(cur);
    if constexpr (SP2) {
        PG8_STAGE(PG8_SB(0, 0), cB, voffB); PG8_STAGE(PG8_SB(0, 1), cB + hstep, voffB); PG8_STAGE(PG8_SA(0, 0), cA, voffA); PG8_STAGE(PG8_SA(0, 1), cA + hstep, voffA);
        if (wr == 1) PG8_BAR;
        PG8_WAIT_V(2); PG8_BAR;
        PG8_STAGE(PG8_SB(1, 0), cB + kstep, voffB); PG8_STAGE(PG8_SA(1, 0), cA + kstep, voffA); PG8_STAGE(PG8_SB(1, 1), cB + hstep + kstep, voffB);
        PG8_WAIT_V(6); PG8_BAR;
    } else {
        PG8_STAGE(PG8_SB(0, 0), cB, voffB); PG8_STAGE(PG8_SA(0, 0), cA, voffA); PG8_STAGE(PG8_SB(0, 1), cB + hstep, voffB); PG8_STAGE(PG8_SA(0, 1), cA + hstep, voffA);
        if (wr == 1) PG8_BAR;
        PG8_WAIT_V(4); PG8_BAR;
        PG8_STAGE(PG8_SB(1, 0), cB + kstep, voffB); PG8_STAGE(PG8_SA(1, 0), cA + kstep, voffA); PG8_STAGE(PG8_SB(1, 1), cB + hstep + kstep, voffB);
        PG8_WAIT_V(6); PG8_BAR;
    }
    for (;;) {
        const bool has_next = S.next(ui + 1, nxt);
        const char* nA = has_next ? (const char*)g.A + (size_t)nxt.pm * tstep : cA; const char* nB = has_next ? (const char*)g.Bt + (size_t)nxt.pn * tstep : cB;
        for (int t = 0; t < nt; t += 2) {
            const bool last = (t == nt - 2);
            const char* a1 = cA + (size_t)(t + 1) * kstep;
            const char* a2 = last ? nA : cA + (size_t)(t + 2) * kstep; const char* b2 = last ? nB : cB + (size_t)(t + 2) * kstep;
            const char* a3 = a2 + kstep; const char* b3 = b2 + kstep;
            if (last && has_next) S.a_ready(nxt);
            if constexpr (SP2) {
            PG8_LDB(B0, 0, 0); PG8_LDB(B1, 0, 1); PG8_SCHED; PG8_LDA(At, 0, 0); PG8_STAGE(PG8_SA(1, 1), a1 + hstep, voffA);
            PG8_WAIT_V(8); PG8_WAIT_L(0); PG8_BAR; PG8_MMA(0, 0, At, B0); PG8_MMA(0, 1, At, B1); PG8_BAR; PG8_SCHED;
            PG8_LDA(At, 0, 1); PG8_STAGE(PG8_SB(0, 0), b2, voffB); PG8_STAGE(PG8_SB(0, 1), b2 + hstep, voffB); PG8_STAGE(PG8_SA(0, 0), a2, voffA);
            PG8_WAIT_V(8); PG8_WAIT_L(0); PG8_BAR; PG8_MMA(1, 0, At, B0); PG8_MMA(1, 1, At, B1); PG8_BAR; PG8_SCHED;
            PG8_LDB(B0, 1, 0); PG8_LDB(B1, 1, 1); PG8_SCHED; PG8_LDA(At, 1, 0); PG8_STAGE(PG8_SA(0, 1), a2 + hstep, voffA);
            PG8_WAIT_V(8); PG8_WAIT_L(0); PG8_BAR; PG8_MMA(0, 0, At, B0); PG8_MMA(0, 1, At, B1); PG8_BAR; PG8_SCHED;
            PG8_LDA(At, 1, 1); PG8_STAGE(PG8_SB(1, 0), b3, voffB); PG8_STAGE(PG8_SB(1, 1), b3 + hstep, voffB); PG8_STAGE(PG8_SA(1, 0), a3, voffA);
            PG8_WAIT_V(8); PG8_WAIT_L(0); PG8_BAR; PG8_MMA(1, 0, At, B0); PG8_MMA(1, 1, At, B1); PG8_BAR; PG8_SCHED;
            } else {
            PG8_LDB(B0, 0, 0); PG8_SCHED; PG8_LDA(At, 0, 0); PG8_STAGE(PG8_SA(1, 1), a1 + hstep, voffA);
            PG8_WAIT_L(8); PG8_BAR; PG8_WAIT_L(0); PG8_MMA(0, 0, At, B0); PG8_BAR; PG8_SCHED;
            PG8_LDB(B1, 0, 1); PG8_STAGE(PG8_SB(0, 0), b2, voffB);
            PG8_BAR; PG8_WAIT_L(0); PG8_MMA(0, 1, At, B1); PG8_BAR;
            PG8_LDA(At, 0, 1); PG8_STAGE(PG8_SA(0, 0), a2, voffA);
            PG8_BAR; PG8_WAIT_L(0); PG8_MMA(1, 0, At, B0); PG8_BAR; PG8_SCHED;
            PG8_STAGE(PG8_SB(0, 1), b2 + hstep, voffB);
            PG8_WAIT_V(6); PG8_BAR; PG8_MMA(1, 1, At, B1); PG8_BAR;
            PG8_LDB(B0, 1, 0); PG8_SCHED; PG8_LDA(At, 1, 0); PG8_STAGE(PG8_SA(0, 1), a2 + hstep, voffA);
            PG8_WAIT_L(8); PG8_BAR; PG8_WAIT_L(0); PG8_MMA(0, 0, At, B0); PG8_BAR; PG8_SCHED;
            PG8_LDB(B1, 1, 1); PG8_STAGE(PG8_SB(1, 0), b3, voffB);
            PG8_BAR; PG8_WAIT_L(0); PG8_MMA(0, 1, At, B1); PG8_BAR;
            PG8_LDA(At, 1, 1); PG8_STAGE(PG8_SA(1, 0), a3, voffA);
            PG8_BAR; PG8_WAIT_L(0); PG8_MMA(1, 0, At, B0); PG8_BAR; PG8_SCHED;
            PG8_STAGE(PG8_SB(1, 1), b3 + hstep, voffB);
            PG8_WAIT_V(6); PG8_BAR; PG8_MMA(1, 1, At, B1); PG8_BAR;
            }
        }
        if constexpr (ALIGN_EPI) { if (wr == 0) PG8_BAR; }
        if constexpr (!Epi::AFTER_DRAIN) { E(acc, cur, wr, wc, fr, fq); S.done(cur); }
        if (!has_next) break;
#pragma unroll
        for (int a = 0; a < 2; ++a)
#pragma unroll
            for (int b = 0; b < 2; ++b)
#pragma unroll
                for (int m = 0; m < 4; ++m)
#pragma unroll
                    for (int n = 0; n < 2; ++n) acc[a][b][m][n] = (f32x4){0.f, 0.f, 0.f, 0.f};
        cur = nxt; cA = nA; cB = nB; ++ui;
        if constexpr (ALIGN_EPI) { if (wr == 1) PG8_BAR; }
    }
    PG8_WAIT_V(0);
    if constexpr (!ALIGN_EPI) { if (wr == 0) PG8_BAR; }
    PG8_BAR;
    if constexpr (Epi::AFTER_DRAIN) { E.fused(acc, cur, wr, wc, fr, fq, lds, wid, lane); S.done(cur); }
#undef PG8_SA
#undef PG8_SB
#undef PG8_STAGE
#undef PG8_LDA
#undef PG8_LDB
#undef PG8_MMA
#undef PG8_WAIT_V
#undef PG8_WAIT_L
#undef PG8_BAR
#undef PG8_SCHED
}
}
namespace att {
using bf16 = unsigned short;
using bf16x8 = __attribute__((ext_vector_type(8))) short;
using s16x4  = __attribute__((ext_vector_type(4))) short;
using f32x16 = __attribute__((ext_vector_type(16))) float;
using f32x4v = __attribute__((ext_vector_type(4))) float;
using u32x4  = __attribute__((ext_vector_type(4))) unsigned;
using u32x2  = __attribute__((ext_vector_type(2))) unsigned;
#define ALAS __attribute__((address_space(3)))
#define SBAR() __builtin_amdgcn_sched_barrier(0)
constexpr float LOG2E = 1.4426950408889634f;
constexpr float THR2 = 4.0f;
__device__ __forceinline__ int crow(int r, int hi) { return (r & 3) + 8 * (r >> 2) + 4 * hi; }
__device__ __forceinline__ unsigned cvtpk(float lo, float hi) { unsigned r; asm volatile("v_cvt_pk_bf16_f32 %0, %1, %2" : "=v"(r) : "v"(lo), "v"(hi)); return r; }
__device__ __forceinline__ float bf2f(unsigned short h) { return __uint_as_float((unsigned)h << 16); }
template <int HD> __device__ __forceinline__ int kswz(int row, int colB) {
    if constexpr (HD == 128) return row * 256 + (colB ^ ((row & 15) << 4));
    else return row * 128 + (colB ^ (((row >> 1) & 7) << 4));
}
template <int HD> __device__ __forceinline__ void qkt(f32x16& p0, f32x16& p1, const ALAS char* Ks, const bf16x8* qr, int r32, int hi) {
    p0 = f32x16{}; p1 = f32x16{};
#pragma unroll
    for (int d0 = 0; d0 < HD / 16; ++d0) { const int cb = (d0 * 16 + hi * 8) * 2;
        const bf16x8 b0 = *(const ALAS bf16x8*)(Ks + kswz<HD>(r32, cb));
        const bf16x8 b1 = *(const ALAS bf16x8*)(Ks + kswz<HD>(32 + r32, cb));
        p0 = __builtin_amdgcn_mfma_f32_32x32x16_bf16(b0, qr[d0], p0, 0, 0, 0);
        p1 = __builtin_amdgcn_mfma_f32_32x32x16_bf16(b1, qr[d0], p1, 0, 0, 0); }
}
template <int NCB> __device__ __forceinline__ int v_st(int k, int c) { const int kk = (k & ~0xC) | ((k & 4) << 1) | ((k & 8) >> 1); return ((kk >> 3) * NCB + (c >> 5)) * 512 + ((kk & 7) * 32 + (c & 31)) * 2; }
__device__ __forceinline__ int v_rd_base(int lane) { return ((lane & 3) << 3) | (((lane >> 2) & 3) << 6) | (((lane >> 4) & 1) << 5) | (((lane >> 5) & 1) << 8); }
template <int NCB> constexpr int v_rd_off(int d0, int ks, int half) { return d0 * 512 + ks * (NCB * 1024) + half * (NCB * 512); }
template <int OFF> __device__ __forceinline__ s16x4 tr_read(int vb) { s16x4 r; asm volatile("ds_read_b64_tr_b16 %0, %1 offset:%2" : "=&v"(r) : "v"(vb), "i"(OFF) : "memory"); return r; }
template <int NCB, int D0> __device__ __forceinline__ void pv_one(f32x16& od, int vb, bf16x8 pa0, bf16x8 pa1, bf16x8 pa2, bf16x8 pa3) {
    const s16x4 l0 = tr_read<v_rd_off<NCB>(D0, 0, 0)>(vb), h0 = tr_read<v_rd_off<NCB>(D0, 0, 1)>(vb), l1 = tr_read<v_rd_off<NCB>(D0, 1, 0)>(vb), h1 = tr_read<v_rd_off<NCB>(D0, 1, 1)>(vb);
    const s16x4 l2 = tr_read<v_rd_off<NCB>(D0, 2, 0)>(vb), h2 = tr_read<v_rd_off<NCB>(D0, 2, 1)>(vb), l3 = tr_read<v_rd_off<NCB>(D0, 3, 0)>(vb), h3 = tr_read<v_rd_off<NCB>(D0, 3, 1)>(vb);
    asm volatile("s_waitcnt lgkmcnt(0)" ::: "memory"); SBAR();
#define PK(L, H) (bf16x8){L[0], L[1], L[2], L[3], H[0], H[1], H[2], H[3]}
    od = __builtin_amdgcn_mfma_f32_32x32x16_bf16(pa0, PK(l0, h0), od, 0, 0, 0);
    od = __builtin_amdgcn_mfma_f32_32x32x16_bf16(pa1, PK(l1, h1), od, 0, 0, 0);
    od = __builtin_amdgcn_mfma_f32_32x32x16_bf16(pa2, PK(l2, h2), od, 0, 0, 0);
    od = __builtin_amdgcn_mfma_f32_32x32x16_bf16(pa3, PK(l3, h3), od, 0, 0, 0);
#undef PK
}
__device__ __forceinline__ void softmax_tile(f32x16& p0, f32x16& p1, float& m_reg, float& l_reg, float& alpha, bf16x8& pa0, bf16x8& pa1, bf16x8& pa2, bf16x8& pa3) {
    float pmax = p0[0];
#pragma unroll
    for (int r = 1; r < 16; ++r) pmax = fmaxf(pmax, p0[r]);
#pragma unroll
    for (int r = 0; r < 16; ++r) pmax = fmaxf(pmax, p1[r]);
    { auto rr = __builtin_amdgcn_permlane32_swap(__float_as_uint(pmax), __float_as_uint(pmax), false, false); pmax = fmaxf(__uint_as_float(rr[0]), __uint_as_float(rr[1])); }
    if (__all(pmax - m_reg <= THR2)) { alpha = 1.f; }
    else { const float mn = fmaxf(m_reg, pmax); alpha = __builtin_amdgcn_exp2f(m_reg - mn); m_reg = mn; }
    float ps = 0.f;
#pragma unroll
    for (int r = 0; r < 16; ++r) { p0[r] = __builtin_amdgcn_exp2f(p0[r] - m_reg); p1[r] = __builtin_amdgcn_exp2f(p1[r] - m_reg); }
#pragma unroll
    for (int r = 0; r < 16; ++r) ps += p0[r];
#pragma unroll
    for (int r = 0; r < 16; ++r) ps += p1[r];
    { auto rr = __builtin_amdgcn_permlane32_swap(__float_as_uint(ps), __float_as_uint(ps), false, false); ps = __uint_as_float(rr[0]) + __uint_as_float(rr[1]); }
    l_reg = l_reg * alpha + ps;
#define PK4(P, BASE, OUT) do { unsigned a0 = cvtpk(P[BASE + 0], P[BASE + 1]), a1 = cvtpk(P[BASE + 2], P[BASE + 3]);   \
    unsigned b0 = cvtpk(P[BASE + 4], P[BASE + 5]), b1 = cvtpk(P[BASE + 6], P[BASE + 7]);                              \
    auto r0 = __builtin_amdgcn_permlane32_swap(a0, b0, false, false); auto r1 = __builtin_amdgcn_permlane32_swap(a1, b1, false, false); \
    u32x4 w = {r0[0], r1[0], r0[1], r1[1]}; OUT = __builtin_bit_cast(bf16x8, w); } while (0)
    PK4(p0, 0, pa0); PK4(p0, 8, pa1); PK4(p1, 0, pa2); PK4(p1, 8, pa3);
#undef PK4
}
template <int NB> __device__ __forceinline__ void rescale_o(f32x16* o, float alpha, ALAS float* al_l, int r32, int hi) {
    if (__any(alpha < 1.f)) {
        if (hi == 0) al_l[r32] = alpha;
        asm volatile("s_waitcnt lgkmcnt(0)" ::: "memory");
#pragma unroll
        for (int r = 0; r < 16; ++r) { const float a = al_l[crow(r, hi)];
#pragma unroll
            for (int d = 0; d < NB; ++d) o[d][r] *= a; }
        asm volatile("s_waitcnt lgkmcnt(0)" ::: "memory");
    }
}
template <int NB> __device__ __forceinline__ void store_o(const f32x16* o, float l_tot, ALAS float* li_l, bf16* Ow, int r32, int hi) {
    if (hi == 0) li_l[r32] = l_tot;
    asm volatile("s_waitcnt lgkmcnt(0)" ::: "memory");
#pragma unroll
    for (int r = 0; r < 16; ++r) { const int orow = crow(r, hi); const float rl = __builtin_amdgcn_rcpf(li_l[orow]);
#pragma unroll
        for (int d0 = 0; d0 < NB; ++d0) { const unsigned w = cvtpk(o[d0][r] * rl, 0.f); Ow[(size_t)orow * 2048 + d0 * 32 + r32] = (bf16)(w & 0xffffu); } }
    asm volatile("s_waitcnt lgkmcnt(0)" ::: "memory");
}

constexpr int ATTA_LDS = 65536 + 2048 + 1040;
__device__ __forceinline__ void attnA_unit(const int tid, int b, int h, int qb, const bf16* Qb, const bf16* Kb, const bf16* Vb, bf16* Ob, const float* tabsrc, ALAS char* lds) {
    constexpr int HD = 128, LD = 2048, TB = 16384;
    const int lane = tid & 63, r32 = lane & 31, hi = lane >> 5; const int wid = __builtin_amdgcn_readfirstlane(tid >> 6);
    ALAS char* V_lds = lds; ALAS char* K_lds = lds + 2 * TB;
    ALAS float* wsf = (ALAS float*)(lds + 4 * TB) + wid * 64; ALAS float* tab = (ALAS float*)(lds + 4 * TB + 2048);
    if (tid < 257) tab[tid] = tabsrc[tid] * LOG2E;
    const int c0 = qb * 4, co = wid >> 1, c = c0 + co, rh = wid & 1;
    const size_t rowbase = (size_t)b * 8192;
    const bf16* Qw = Qb + (rowbase + c * 64 + rh * 32 + r32) * LD + h * HD + hi * 8;
    bf16x8 qr[8];
#pragma unroll
    for (int d0 = 0; d0 < 8; ++d0) qr[d0] = *(const bf16x8*)(Qw + d0 * 16);
    const int kc_lo = c0 - 8 > 0 ? c0 - 8 : 0, NT = c0 + 3 - kc_lo + 1;
    const int my_lo = c - 8 > 0 ? c - 8 : 0, my_hi = c;
    const int krow = 4 * wid + (lane >> 4), kchunk = (lane & 15) ^ (krow & 15);
    const int vkk = (wid >> 1) * 8 + ((lane & 31) >> 2), vkey = (vkk & ~0xC) | ((vkk & 4) << 1) | ((vkk & 8) >> 1), vcol = (2 * (wid & 1) + (lane >> 5)) * 32 + (lane & 3) * 8;
    const bf16* Kh = Kb + rowbase * LD + h * HD + (size_t)krow * LD + kchunk * 8; const bf16* Vh = Vb + rowbase * LD + h * HD + (size_t)vkey * LD + vcol;
    const int vb0 = (int)(unsigned)(uintptr_t)V_lds + v_rd_base(lane);
#define SDMA(kc, bf) do { const size_t o_ = (size_t)(kc) * 64 * LD; \
        __builtin_amdgcn_global_load_lds((const unsigned*)(Kh + o_), (ALAS unsigned*)(K_lds + (bf) * TB + wid * 1024), 16, 0, 0); \
        __builtin_amdgcn_global_load_lds((const unsigned*)(Kh + o_ + 32 * LD), (ALAS unsigned*)(K_lds + (bf) * TB + (wid + 8) * 1024), 16, 0, 0); \
        __builtin_amdgcn_global_load_lds((const unsigned*)(Vh + o_), (ALAS unsigned*)(V_lds + (bf) * TB + wid * 1024), 16, 0, 0); \
        __builtin_amdgcn_global_load_lds((const unsigned*)(Vh + o_ + 32 * LD), (ALAS unsigned*)(V_lds + (bf) * TB + (wid + 8) * 1024), 16, 0, 0); } while (0)
    float m_reg = -1e30f, l_reg = 0.f; f32x16 o[4] = {f32x16{}, f32x16{}, f32x16{}, f32x16{}};
    const int qloc = rh * 32 + r32;
    SDMA(kc_lo, 0); asm volatile("s_waitcnt vmcnt(0)" ::: "memory"); __syncthreads();
    for (int t = 0; t < NT; ++t) {
        const int kc = kc_lo + t, cur = t & 1;
        if (t + 1 < NT) SDMA(kc + 1, cur ^ 1);
        if (kc >= my_lo && kc <= my_hi) {
            f32x16 p0, p1; qkt<HD>(p0, p1, K_lds + cur * TB, qr, r32, hi);
            const int dc = kc - c;
            if (dc <= -3) { const float bb = tab[0];
#pragma unroll
                for (int r = 0; r < 16; ++r) { p0[r] += bb; p1[r] += bb; } }
            else { const int base = (dc + 2) * 64 - qloc + 4 * hi;
#pragma unroll
                for (int r = 0; r < 16; ++r) { const int i0 = base + (r & 3) + 8 * (r >> 2), i1 = i0 + 32; p0[r] += tab[i0 > 0 ? i0 : 0]; p1[r] += tab[i1 > 0 ? i1 : 0]; } }
            float alpha; bf16x8 pa0, pa1, pa2, pa3;
            softmax_tile(p0, p1, m_reg, l_reg, alpha, pa0, pa1, pa2, pa3);
            rescale_o<4>(o, alpha, wsf, r32, hi);
            const int vb = vb0 + cur * TB;
            pv_one<4, 0>(o[0], vb, pa0, pa1, pa2, pa3); pv_one<4, 1>(o[1], vb, pa0, pa1, pa2, pa3); pv_one<4, 2>(o[2], vb, pa0, pa1, pa2, pa3); pv_one<4, 3>(o[3], vb, pa0, pa1, pa2, pa3);
        }
        asm volatile("s_waitcnt vmcnt(0)" ::: "memory");
        __syncthreads();
    }
#undef SDMA
    store_o<4>(o, l_reg, wsf, Ob + (rowbase + c * 64 + rh * 32) * LD + h * HD, r32, hi);
}

constexpr int ATTB_RC = 16, ATTB_LDS = 65536 + 2048;
__device__ __forceinline__ void attnB_unit(const int tid, int b, int kvh, int run, const bf16* Qb, const bf16* Kb, const bf16* Vb, bf16* Ob, const float* sinks, ALAS char* lds) {
    constexpr int HD = 64, LDQ = 2048, LDK = 512, TB = 8192;
    const int lane = tid & 63, r32 = lane & 31, hi = lane >> 5; const int wid = __builtin_amdgcn_readfirstlane(tid >> 6);
    ALAS char* K_lds = lds; ALAS char* V_lds = lds + 4 * TB; ALAS float* wsf = (ALAS float*)(lds + 8 * TB) + wid * 64;
    const int qh = kvh * 4 + (wid >> 1), rh = wid & 1;
    const float slope2 = __builtin_amdgcn_exp2f(-0.25f * (float)(qh + 1)) * LOG2E, sink2 = sinks[qh] * LOG2E;
    const size_t rowbase = (size_t)b * 8192;
    const int krow = 8 * wid + (lane >> 3), kchunk = (lane & 7) ^ ((krow >> 1) & 7);
    const int vkk = wid * 8 + ((lane & 31) >> 2), vkey = (vkk & ~0xC) | ((vkk & 4) << 1) | ((vkk & 8) >> 1), vcol = (lane >> 5) * 32 + (lane & 3) * 8;
    const bf16* Kh = Kb + (rowbase + krow) * LDK + kvh * HD + kchunk * 8; const bf16* Vh = Vb + (rowbase + vkey) * LDK + kvh * HD + vcol;
    const int vb0 = (int)(unsigned)(uintptr_t)V_lds + v_rd_base(lane);
    const int c_first = run * ATTB_RC, c_last = c_first + ATTB_RC - 1;
#define SDMA(kc) do { __builtin_amdgcn_global_load_lds((const unsigned*)(Kh + (size_t)(kc) * 64 * LDK), (ALAS unsigned*)(K_lds + ((kc) & 3) * TB + wid * 1024), 16, 0, 0); \
        __builtin_amdgcn_global_load_lds((const unsigned*)(Vh + (size_t)(kc) * 64 * LDK), (ALAS unsigned*)(V_lds + ((kc) & 3) * TB + wid * 1024), 16, 0, 0); } while (0)
    for (int kc = (c_first - 2 > 0 ? c_first - 2 : 0); kc <= c_first; ++kc) SDMA(kc);
    const bf16* Qw = Qb + (rowbase + rh * 32 + r32) * LDQ + qh * HD + hi * 8;
    bf16x8 qr[4], qn[4];
#pragma unroll
    for (int d0 = 0; d0 < 4; ++d0) qr[d0] = *(const bf16x8*)(Qw + (size_t)c_first * 64 * LDQ + d0 * 16);
    asm volatile("s_waitcnt vmcnt(0)" ::: "memory"); __syncthreads();
    const int qloc = rh * 32 + r32;
    for (int c = c_first; c <= c_last; ++c) {
        const bool more = c < c_last;
        if (more) { SDMA(c + 1);
#pragma unroll
            for (int d0 = 0; d0 < 4; ++d0) qn[d0] = *(const bf16x8*)(Qw + (size_t)(c + 1) * 64 * LDQ + d0 * 16); }
        float m_reg = -1e30f, l_reg = 0.f; f32x16 o[2] = {f32x16{}, f32x16{}};
        for (int kc = (c - 2 > 0 ? c - 2 : 0); kc <= c; ++kc) {
            const int slot = kc & 3;
            f32x16 p0, p1; qkt<HD>(p0, p1, K_lds + slot * TB, qr, r32, hi);
            const int base = (kc - c) * 64 - qloc + 4 * hi;
#pragma unroll
            for (int r = 0; r < 16; ++r) { const int i0 = base + (r & 3) + 8 * (r >> 2); p0[r] -= slope2 * fabsf((float)i0); p1[r] -= slope2 * fabsf((float)(i0 + 32)); }
            float alpha; bf16x8 pa0, pa1, pa2, pa3;
            softmax_tile(p0, p1, m_reg, l_reg, alpha, pa0, pa1, pa2, pa3);
            rescale_o<2>(o, alpha, wsf, r32, hi);
            const int vb = vb0 + slot * TB;
            pv_one<2, 0>(o[0], vb, pa0, pa1, pa2, pa3); pv_one<2, 1>(o[1], vb, pa0, pa1, pa2, pa3);
        }
        const float l_tot = l_reg + __builtin_amdgcn_exp2f(sink2 - m_reg);
        store_o<2>(o, l_tot, wsf, Ob + (rowbase + (size_t)c * 64 + rh * 32) * LDQ + qh * HD, r32, hi);
        if (more) {
#pragma unroll
            for (int d0 = 0; d0 < 4; ++d0) qr[d0] = qn[d0]; }
        asm volatile("s_waitcnt vmcnt(0)" ::: "memory");
        __syncthreads();
    }
#undef SDMA
}

template <int HD, int CL, bool ISA>
__device__ __forceinline__ void sample_attn_unit(const int tid, int sb, int qh, const bf16* Qb, const bf16* Kb, const bf16* Vb, bf16* Ob, const float* cache_k, const float* cache_v, const float* aux, ALAS char* lds) {
    constexpr int NK = CL + 16, NKP = NK + 1, KVW = ISA ? 2048 : 512, PAST = 1024;
    const int lane = tid & 63; const int wid = __builtin_amdgcn_readfirstlane(tid >> 6);
    const int kvh = ISA ? qh : (qh >> 2);
    ALAS float* qs = (ALAS float*)lds; ALAS float* S = qs + 16 * HD; ALAS float* inv = S + 16 * NKP;
    const size_t row0 = 32768 + (size_t)sb * 16;
    for (int i = tid; i < 16 * HD; i += 512) { const int j = i / HD, d = i % HD; qs[i] = bf2f(Qb[(row0 + j) * 2048 + qh * HD + d]); }
    __syncthreads();
    const float slope2 = __builtin_amdgcn_exp2f(-0.25f * (float)(qh + 1)) * LOG2E;
    for (int k = tid; k < NK; k += 512) {
        float acc[16];
#pragma unroll
        for (int j = 0; j < 16; ++j) acc[j] = 0.f;
        if (k < CL) { const float* kp = cache_k + ((size_t)sb * CL + k) * KVW + kvh * HD;
#pragma unroll 2
            for (int d4 = 0; d4 < HD / 4; ++d4) { const f32x4v kv = *(const f32x4v*)(kp + d4 * 4);
#pragma unroll
                for (int j = 0; j < 16; ++j) { const f32x4v q4 = *(const ALAS f32x4v*)(qs + j * HD + d4 * 4); acc[j] += (kv[0] * q4[0] + kv[1] * q4[1]) + (kv[2] * q4[2] + kv[3] * q4[3]); } } }
        else { const bf16* kp = Kb + (row0 + (k - CL)) * KVW + kvh * HD;
#pragma unroll 2
            for (int d4 = 0; d4 < HD / 4; ++d4) { const u32x2 kw = *(const u32x2*)(kp + d4 * 4);
                const float k0 = __uint_as_float(kw[0] << 16), k1 = __uint_as_float(kw[0] & 0xffff0000u), k2 = __uint_as_float(kw[1] << 16), k3 = __uint_as_float(kw[1] & 0xffff0000u);
#pragma unroll
                for (int j = 0; j < 16; ++j) { const f32x4v q4 = *(const ALAS f32x4v*)(qs + j * HD + d4 * 4); acc[j] += (k0 * q4[0] + k1 * q4[1]) + (k2 * q4[2] + k3 * q4[3]); } } }
        const int kpos = k < CL ? PAST - CL + k : PAST + (k - CL);
#pragma unroll
        for (int j = 0; j < 16; ++j) { const int rel = kpos - (PAST + j); float bias;
            if constexpr (ISA) { int idx = rel < -128 ? -128 : (rel > 128 ? 128 : rel); bias = aux[idx + 128] * LOG2E; } else { bias = -slope2 * fabsf((float)rel); }
            S[j * NKP + k] = acc[j] + bias; }
    }
    __syncthreads();
#pragma unroll
    for (int jj = 0; jj < 2; ++jj) { const int j = 2 * wid + jj;
        float m = -1e30f; for (int k = lane; k < NK; k += 64) m = fmaxf(m, S[j * NKP + k]);
        m = xl_wave_max(m);
        float s = 0.f; for (int k = lane; k < NK; k += 64) { const float e = __builtin_amdgcn_exp2f(S[j * NKP + k] - m); S[j * NKP + k] = e; s += e; }
        s = xl_wave_sum(s);
        if constexpr (!ISA) s += __builtin_amdgcn_exp2f(aux[qh] * LOG2E - m);
        if (lane == 0) inv[j] = 1.0f / s; }
    __syncthreads();
    constexpr int TPR = HD / 4;
    if (tid < 16 * TPR) { const int j = tid / TPR, d4 = (tid % TPR) * 4; f32x4v o = {0.f, 0.f, 0.f, 0.f};
        const float* vp = cache_v + (size_t)sb * CL * KVW + kvh * HD + d4;
#pragma unroll 8
        for (int k = 0; k < CL; ++k) { const float p = S[j * NKP + k]; const f32x4v v4 = *(const f32x4v*)(vp + (size_t)k * KVW); o = o + v4 * p; }
        const bf16* vn = Vb + row0 * KVW + kvh * HD + d4;
        for (int k = 0; k < 16; ++k) { const float p = S[j * NKP + CL + k]; const u32x2 vw = *(const u32x2*)(vn + (size_t)k * KVW);
            f32x4v v4 = {__uint_as_float(vw[0] << 16), __uint_as_float(vw[0] & 0xffff0000u), __uint_as_float(vw[1] << 16), __uint_as_float(vw[1] & 0xffff0000u)}; o = o + v4 * p; }
        const float il = inv[j]; u32x2 w; w[0] = cvtpk(o[0] * il, o[1] * il); w[1] = cvtpk(o[2] * il, o[3] * il);
        *(u32x2*)(Ob + (row0 + j) * 2048 + qh * HD + d4) = w; }
    __syncthreads();
}
#undef SBAR
#undef ALAS
}
constexpr int NWAVES = 8;
#ifndef MK_ONE_LAUNCH
#define MK_ONE_LAUNCH 1
#endif
constexpr int DM = 2048, FF = 8192, SEQ = 8192, NBATCH = 4, MP = NBATCH * SEQ, MS = 128, MR = MP + MS, MPAD = 33024;
constexpr int NPH = 22;
constexpr size_t MiB = 1u << 20;
constexpr size_t WS_CTL = 0, CTL_ZERO_BYTES = 1 * MiB;
constexpr size_t WS_WQA = 1 * MiB, WS_WOA = 49 * MiB, WS_WQB = 65 * MiB, WS_WOB = 89 * MiB, WS_WUP = 105 * MiB, WS_WDN = 233 * MiB;
constexpr size_t WS_XB = 361 * MiB;
constexpr size_t WS_SS0 = 490 * MiB, WS_SS1 = 495 * MiB;
constexpr size_t WS_ACT = 500 * MiB;
constexpr size_t WS_Q = WS_ACT, WS_K = WS_ACT + 129 * MiB, WS_V = WS_ACT + 258 * MiB, WS_END = WS_ACT + 516 * MiB;
static_assert((size_t)MPAD * DM * 2 == 129 * MiB && (size_t)MPAD * FF * 2 == 516 * MiB, "buffer sizes");
constexpr int CW_TMO = 0, CW_BAR = 4096;
constexpr size_t O_Y = 0, O_AKP = 67371008, O_AVP = 75759616, O_BKP = 84148224, O_BVP = 84672512, O_AKS = 85196800, O_AVS = 101974016, O_BKS = 118751232, O_BVS = 119799808, O_END = 120848384;
constexpr int RING_BYTES = 131072, MISC_OFF = RING_BYTES + 320, LDS_BYTES = 147456;

#define GAS __attribute__((address_space(1)))
#define LAS __attribute__((address_space(3)))
typedef unsigned short bf16;
typedef unsigned v4u __attribute__((ext_vector_type(4)));
typedef unsigned v2u __attribute__((ext_vector_type(2)));
typedef float f32x4 __attribute__((ext_vector_type(4)));
typedef GAS unsigned gu32;
#define RLX_AGENT __ATOMIC_RELAXED, __HIP_MEMORY_SCOPE_AGENT
#define LDS_WAIT() asm volatile("s_waitcnt lgkmcnt(0)" ::: "memory")
#define VM_WAIT() asm volatile("s_waitcnt vmcnt(0)" ::: "memory")
__device__ __forceinline__ unsigned f2bf(float f) { unsigned u = __builtin_bit_cast(unsigned, f); return (u + 0x7fffu + ((u >> 16) & 1u)) >> 16; }
__device__ __forceinline__ unsigned pk2(float lo, float hi) { return f2bf(lo) | (f2bf(hi) << 16); }
#define XB_TMO      128
#define XB_XCNT(j)  (256  + 64 * (j))
#define XB_XSUB(j)  (1280 + 64 * (j))
#define XB_XGEN(j)  (2304 + 64 * (j))
#define XB_TOP      3328
#define XB_TOPGEN   3392
#define XCD_BAR_WORDS 3456
#define XB_SPIN_CAP (1u << 18)

__device__ __forceinline__ unsigned xb_ld(unsigned* p)              { return __hip_atomic_load(p, __ATOMIC_RELAXED, __HIP_MEMORY_SCOPE_AGENT); }
__device__ __forceinline__ unsigned xb_add(unsigned* p, unsigned v) { return __hip_atomic_fetch_add(p, v, __ATOMIC_RELAXED, __HIP_MEMORY_SCOPE_AGENT); }
__device__ __forceinline__ unsigned xb_xcc_id() { return (unsigned)__builtin_amdgcn_s_getreg((3 << 11) | 20) & 0xFu; }
#define XB_SPIN(cond, bar) do { unsigned _sp = 0; while (cond) { __builtin_amdgcn_s_sleep(1); \
    if ((++_sp & 255u) == 0u) { if (xb_ld(&(bar)[XB_TMO])) break; if (_sp > XB_SPIN_CAP) { atomicAdd(&(bar)[XB_TMO], 1u); break; } } } } while (0)

struct XcdBarrier {
    unsigned* bar; unsigned x;
    volatile LAS unsigned* st;
};

__device__ __forceinline__ XcdBarrier xcd_barrier_post(unsigned* bar, volatile LAS unsigned* st) {
    XcdBarrier b; b.bar = bar; b.x = xb_xcc_id(); b.st = st;
    if (threadIdx.x == 0) (void)xb_add(&bar[XB_XCNT(b.x)], 1u);
    return b;
}
__device__ __forceinline__ void xcd_barrier_complete(unsigned* bar, unsigned x, unsigned& nloc, unsigned& nx) {
    const unsigned G = gridDim.x * gridDim.y * gridDim.z;
    unsigned sum, cnt, mine, sp = 0u;
    for (;;) {
        sum = 0u; cnt = 0u; mine = 0u;
#pragma unroll
        for (unsigned j = 0; j < 16; ++j) { const unsigned c = xb_ld(&bar[XB_XCNT(j)]); sum += c; cnt += (c > 0u) ? 1u : 0u; mine = (j == x) ? c : mine; }
        if (sum == G) break;
        __builtin_amdgcn_s_sleep(1);
        if ((++sp & 255u) == 0u) { if (xb_ld(&bar[XB_TMO])) break; if (sp > XB_SPIN_CAP) { atomicAdd(&bar[XB_TMO], 1u); break; } }
    }
    nloc = mine > 0u ? mine : 1u; nx = cnt > 0u ? cnt : 1u;
}

__device__ __forceinline__ void xcd_barrier(const XcdBarrier& b) {
    asm volatile("s_waitcnt vmcnt(0)" ::: "memory");
    __syncthreads();
    if (threadIdx.x == 0) {
        unsigned* bar = b.bar;
        __builtin_amdgcn_s_waitcnt(0);
        unsigned nloc = b.st[0], nx = b.st[1];
        if (nloc == 0u) { xcd_barrier_complete(bar, b.x, nloc, nx); b.st[0] = nloc; b.st[1] = nx; }
        const unsigned old = xb_add(&bar[XB_XSUB(b.x)], 1u);
        const unsigned gen = old / nloc;
        if (old + 1u == (gen + 1u) * nloc) {
            __builtin_amdgcn_fence(__ATOMIC_RELEASE, "agent");
            asm volatile("s_waitcnt vmcnt(0)" ::: "memory");
            const unsigned og = xb_add(&bar[XB_TOP], 1u);
            const unsigned tg = og / nx;
            if (og + 1u == (tg + 1u) * nx) xb_add(&bar[XB_TOPGEN], 1u);
            else XB_SPIN(xb_ld(&bar[XB_TOPGEN]) == tg, bar);
            __builtin_amdgcn_fence(__ATOMIC_ACQUIRE, "agent");
            xb_add(&bar[XB_XGEN(b.x)], 1u);
            asm volatile("s_waitcnt vmcnt(0)" ::: "memory");
        } else {
            XB_SPIN(xb_ld(&bar[XB_XGEN(b.x)]) == gen, bar);
            __builtin_amdgcn_fence(__ATOMIC_ACQUIRE, "agent");
            asm volatile("s_waitcnt vmcnt(0)" ::: "memory");
        }
    }
    __syncthreads();
}
struct Frame {
    LAS unsigned char* lds;
    volatile LAS unsigned* MISC;
};
enum { P_XP = 0, P_XS, P_CAK, P_CAV, P_CBK, P_CBV, P_NMIX, P_NFFN, P_NFIN, P_AWQKV, P_AWO, P_AREL, P_BWQKV, P_BWO, P_BSINK, P_WUP, P_WDN, P_OUT, P_WS, P_COUNT };
typedef const __attribute__((address_space(4))) unsigned long long* karg_t;
#define KARGS() karg_t KA = (karg_t)__builtin_amdgcn_kernarg_segment_ptr(); asm volatile("" : "+s"(KA))
#define FPTR(i) ((const float*)KA[(i)])
#define OUTP() ((float*)KA[P_OUT])
#define WSP() ((unsigned char*)KA[P_WS])
__device__ __forceinline__ int opaque_lane() { int l; asm volatile("v_mbcnt_lo_u32_b32 %0, -1, 0\n\tv_mbcnt_hi_u32_b32 %0, -1, %0" : "=v"(l)); return l; }
__device__ __forceinline__ float wave_sum(float v) {
    return xl_wave_sum(v);
}
__device__ __forceinline__ void p0_transpose_item(const float* W, const float* gain, int K, int N, bf16* WT, LAS float* scr, int item, int lane) {
    const int nblk = N / 32, kb = item / nblk, nb = item % nblk, k0 = 64 * kb, n0 = 32 * nb;
#pragma unroll 8
    for (int i = 0; i < 32; ++i) { const int kk = 2 * i + (lane >> 5); const float g = gain ? gain[k0 + kk] : 1.0f; scr[kk * 33 + (lane & 31)] = W[(size_t)(k0 + kk) * N + n0 + (lane & 31)] * g; }
    LDS_WAIT(); asm volatile("" ::: "memory");
    const int c = lane & 7;
#pragma unroll
    for (int j = 0; j < 4; ++j) { const int n = (lane >> 3) + 8 * j; const LAS float* s = scr + (8 * c) * 33 + n;
        v4u o; o.x = pk2(s[0 * 33], s[1 * 33]); o.y = pk2(s[2 * 33], s[3 * 33]); o.z = pk2(s[4 * 33], s[5 * 33]); o.w = pk2(s[6 * 33], s[7 * 33]);
        *(GAS v4u*)(WT + (size_t)(n0 + n) * K + k0 + 8 * c) = o; }
    LDS_WAIT(); asm volatile("" ::: "memory");
}
__device__ __forceinline__ void p0_prologue(Frame& F, const int wave0) {
    KARGS();
    int tid_ = (wave0 << 6) | opaque_lane(), bid_ = blockIdx.x, G_ = gridDim.x; asm volatile("" : "+v"(tid_), "+s"(bid_), "+s"(G_));
    struct { int tid, lane, wave, vcu, G; } L; L.tid = tid_; L.lane = tid_ & 63; L.wave = __builtin_amdgcn_readfirstlane(tid_ >> 6); L.G = G_; L.vcu = (G_ % 8 == 0) ? (bid_ % 8) * (G_ / 8) + bid_ / 8 : bid_;
    unsigned char* const ws = WSP(); float* const out = OUTP();
    LAS float* scr = (LAS float*)(F.lds + L.wave * 16384);
    const int gw = L.vcu * NWAVES + L.wave, NGW = L.G * NWAVES;
    constexpr int I_AQ = 32 * 192, I_O = 32 * 64, I_BQ = 32 * 96, I_UP = 32 * 256, I_DN = 128 * 64;
    constexpr int E0 = 2 * I_AQ, E1 = E0 + 2 * I_O, E2 = E1 + 2 * I_BQ, E3 = E2 + 2 * I_O, E4 = E3 + 4 * I_UP, E5 = E4 + 4 * I_DN;
    for (int it = gw; it < E5; it += NGW) {
        if (it < E0) { const int s = it / I_AQ, r = it % I_AQ; p0_transpose_item(FPTR(P_AWQKV) + (size_t)s * 2048 * 6144, FPTR(P_NMIX) + (2 * s) * 2048, 2048, 6144, (bf16*)(ws + WS_WQA + (size_t)s * 24 * MiB), scr, r, L.lane); }
        else if (it < E1) { const int q = it - E0, s = q / I_O, r = q % I_O; p0_transpose_item(FPTR(P_AWO) + (size_t)s * 2048 * 2048, nullptr, 2048, 2048, (bf16*)(ws + WS_WOA + (size_t)s * 8 * MiB), scr, r, L.lane); }
        else if (it < E2) { const int q = it - E1, s = q / I_BQ, r = q % I_BQ; p0_transpose_item(FPTR(P_BWQKV) + (size_t)s * 2048 * 3072, FPTR(P_NMIX) + (2 * s + 1) * 2048, 2048, 3072, (bf16*)(ws + WS_WQB + (size_t)s * 12 * MiB), scr, r, L.lane); }
        else if (it < E3) { const int q = it - E2, s = q / I_O, r = q % I_O; p0_transpose_item(FPTR(P_BWO) + (size_t)s * 2048 * 2048, nullptr, 2048, 2048, (bf16*)(ws + WS_WOB + (size_t)s * 8 * MiB), scr, r, L.lane); }
        else if (it < E4) { const int q = it - E3, s = q / I_UP, r = q % I_UP; p0_transpose_item(FPTR(P_WUP) + (size_t)s * 2048 * 8192, FPTR(P_NFFN) + s * 2048, 2048, 8192, (bf16*)(ws + WS_WUP + (size_t)s * 32 * MiB), scr, r, L.lane); }
        else { const int q = it - E4, s = q / I_DN, r = q % I_DN; p0_transpose_item(FPTR(P_WDN) + (size_t)s * 8192 * 2048, nullptr, 8192, 2048, (bf16*)(ws + WS_WDN + (size_t)s * 32 * MiB), scr, r, L.lane); }
    }
    bf16* XB = (bf16*)(ws + WS_XB); float* SS0 = (float*)(ws + WS_SS0); const float* const xp_ = FPTR(P_XP); const float* const xs_ = FPTR(P_XS);
    for (int m = gw; m < MPAD; m += NGW) {
        GAS v2u* o8 = (GAS v2u*)(XB + (size_t)m * DM) + L.lane;
        if (m < MR) {
            const float* xrow = m < MP ? xp_ + (size_t)m * DM : xs_ + (size_t)(m - MP) * DM;
            const GAS f32x4* xr = (const GAS f32x4*)xrow + L.lane;
            f32x4 v[8]; float s = 0.f;
#pragma unroll
            for (int j = 0; j < 8; ++j) { v[j] = xr[64 * j]; s += (v[j][0] * v[j][0] + v[j][1] * v[j][1]) + (v[j][2] * v[j][2] + v[j][3] * v[j][3]); }
            s = wave_sum(s);
#pragma unroll
            for (int j = 0; j < 8; ++j) { v2u w; w.x = pk2(v[j][0], v[j][1]); w.y = pk2(v[j][2], v[j][3]); o8[64 * j] = w; }
            if (L.lane < 32) SS0[(size_t)m * 32 + L.lane] = L.lane == 0 ? s : 0.f;
        } else {
#pragma unroll
            for (int j = 0; j < 8; ++j) { v2u w; w.x = 0u; w.y = 0u; o8[64 * j] = w; }
            if (L.lane < 32) SS0[(size_t)m * 32 + L.lane] = 0.f;
        }
    }
    {
        const float* const cak_ = FPTR(P_CAK); const float* const cav_ = FPTR(P_CAV); const float* const cbk_ = FPTR(P_CBK); const float* const cbv_ = FPTR(P_CBV);
        const size_t gt = (size_t)bid_ * (NWAVES * 64) + L.tid, NT = (size_t)L.G * NWAVES * 64;
        constexpr size_t A_BLK4 = 512 * 512, A_CP4 = 496 * 512, A_TOT = 16 * A_CP4;
        for (size_t i = gt; i < 2 * A_TOT; i += NT) { const bool isv = i >= A_TOT; const size_t q = isv ? i - A_TOT : i, blk = q / A_CP4, off = q % A_CP4;
            const f32x4* src = (const f32x4*)(isv ? cav_ : cak_) + blk * A_BLK4 + 16 * 512 + off;
            f32x4* dst = (f32x4*)(out + (isv ? O_AVS : O_AKS)) + blk * A_BLK4 + off; *dst = *src; }
        constexpr size_t B_BLK4 = 128 * 128, B_CP4 = 112 * 128, B_TOT = 16 * B_CP4;
        for (size_t i = gt; i < 2 * B_TOT; i += NT) { const bool isv = i >= B_TOT; const size_t q = isv ? i - B_TOT : i, blk = q / B_CP4, off = q % B_CP4;
            const f32x4* src = (const f32x4*)(isv ? cbv_ : cbk_) + blk * B_BLK4 + 16 * 128 + off;
            f32x4* dst = (f32x4*)(out + (isv ? O_BVS : O_BKS)) + blk * B_BLK4 + off; *dst = *src; }
    }
}
__device__ __forceinline__ void final_norm(Frame& F, const int wave0) {
    KARGS();
    int tid_ = (wave0 << 6) | opaque_lane(), bid_ = blockIdx.x, G_ = gridDim.x; asm volatile("" : "+v"(tid_), "+s"(bid_), "+s"(G_));
    struct { int tid, lane, wave, vcu, G; } L; L.tid = tid_; L.lane = tid_ & 63; L.wave = __builtin_amdgcn_readfirstlane(tid_ >> 6); L.G = G_; L.vcu = (G_ % 8 == 0) ? (bid_ % 8) * (G_ / 8) + bid_ / 8 : bid_;
    float* const out = OUTP(); const float* const nfin_ = FPTR(P_NFIN);
    const int gw = L.vcu * NWAVES + L.wave, NGW = L.G * NWAVES;
    f32x4 g[8];
#pragma unroll
    for (int j = 0; j < 8; ++j) g[j] = ((const GAS f32x4*)nfin_)[L.lane + 64 * j];
    for (int m = gw; m < MR; m += NGW) {
        GAS f32x4* xr = (GAS f32x4*)(out + (size_t)m * DM) + L.lane;
        f32x4 v[8]; float s = 0.f;
#pragma unroll
        for (int j = 0; j < 8; ++j) { v[j] = xr[64 * j]; s += (v[j][0] * v[j][0] + v[j][1] * v[j][1]) + (v[j][2] * v[j][2] + v[j][3] * v[j][3]); }
        const float rs = 1.0f / sqrtf(wave_sum(s) * (1.0f / DM) + 1e-6f);
#pragma unroll
        for (int j = 0; j < 8; ++j) xr[64 * j] = v[j] * rs * g[j];
    }
}

struct Args { const float* in[17]; float* out; unsigned char* ws; int pr_lo, pr_hi; };
template <int SITE> __global__ void __launch_bounds__(NWAVES * 64, 2) mk_fwd(Args args) {
    extern __shared__ __attribute__((aligned(16))) unsigned char lds[];
    Frame F;
    F.lds = (LAS unsigned char*)lds;
    F.MISC = (volatile LAS unsigned*)(F.lds + MISC_OFF);
    for (int u = threadIdx.x; u < (LDS_BYTES - RING_BYTES) / 4; u += NWAVES * 64) ((LAS unsigned*)(F.lds + RING_BYTES))[u] = 0u;
    __syncthreads();
    constexpr bool ALL = SITE < 0;
    const int wave0 = __builtin_amdgcn_readfirstlane(threadIdx.x >> 6);
    XcdBarrier bar; bar.bar = nullptr; bar.x = 0; bar.st = nullptr;
    if constexpr (ALL) { KARGS(); bar = xcd_barrier_post((unsigned*)(WSP() + WS_CTL) + CW_BAR, F.MISC + 8); }
#ifndef PHM
#define PHM 0xFFFF
#endif
#define ON(b) (((PHM >> (b)) & 1) && (ALL || SITE == (b)))
#define SEAM() do { if constexpr (ALL) { XcdBarrier b_ = bar; asm volatile("" : "+s"(b_.bar)); xcd_barrier(b_); } } while (0)
#define OTID(name) int name = (wave0 << 6) | opaque_lane(); asm volatile("" : "+v"(name))
#define SITE_IDS() KARGS(); OTID(otid); (void)otid; int bid = blockIdx.x, G = gridDim.x; asm volatile("" : "+s"(bid), "+s"(G)); const int vcu = (G % 8 == 0) ? (bid % 8) * (G / 8) + bid / 8 : bid; (void)vcu
    LAS char* const alds = (LAS char*)F.lds;

    if (ON(0)) { p0_prologue(F, wave0); } SEAM();

    for (int pr = args.pr_lo; pr < args.pr_hi; ++pr) {
        if (ON(1)) {
            SITE_IDS();
            unsigned char* const ws = WSP();
            pg8::Gemm g{(const bf16*)(ws + WS_XB), (const bf16*)(ws + WS_WQA + (size_t)pr * 24 * MiB), MPAD, 6144, 2048}; pg8::StaticOrder S; S.init(MPAD, 6144, G, bid);
            pg8::EpiQKV<false> E{ws, OUTP(), pr};
            pg8::gemm_phase<pg8::EpiQKV<false>, pg8::StaticOrder, true, true>(F.lds, g, S, E, otid);
        } SEAM();
        if (ON(2)) {
            SITE_IDS();
            unsigned char* const ws = WSP(); bf16* const QB = (bf16*)(ws + WS_Q); const bf16* const KB = (const bf16*)(ws + WS_K); const bf16* const VB = (const bf16*)(ws + WS_V);
            const float* rel = FPTR(P_AREL) + (size_t)pr * 16 * 257;
            for (int su = vcu; su < 128; su += G)
                att::sample_attn_unit<128, 512, true>(otid, su >> 4, su & 15, QB, KB, VB, QB, FPTR(P_CAK) + (size_t)pr * 8 * 512 * 2048, FPTR(P_CAV) + (size_t)pr * 8 * 512 * 2048, rel + (su & 15) * 257, alds);
            OTID(otid2);
            for (int u = vcu; u < 2048; u += G) { const int bh = u >> 5, qb = u & 31;
                att::attnA_unit(otid2, bh >> 4, bh & 15, qb, QB, KB, VB, QB, rel + (bh & 15) * 257, alds); }
            __syncthreads();
        } SEAM();
        if (ON(3)) {
            SITE_IDS();
            unsigned char* const ws = WSP(); float* const out = OUTP();
            pg8::Gemm g{(const bf16*)(ws + WS_Q), (const bf16*)(ws + WS_WOA + (size_t)pr * 8 * MiB), MPAD, 2048, 2048}; pg8::StaticOrder S; S.init(MPAD, 2048, G, bid);
            pg8::EpiRes E{pr == 0 ? FPTR(P_XP) : out, pr == 0 ? FPTR(P_XS) : out + (size_t)MP * DM, out, ws, 1};
            pg8::gemm_phase<pg8::EpiRes, pg8::StaticOrder, true, true>(F.lds, g, S, E, otid);
        } SEAM();
        if (ON(4)) {
            SITE_IDS();
            unsigned char* const ws = WSP();
            pg8::Gemm g{(const bf16*)(ws + WS_XB), (const bf16*)(ws + WS_WUP + (size_t)(2 * pr) * 32 * MiB), MPAD, 8192, 2048}; pg8::StaticOrder S; S.init(MPAD, 8192, G, bid);
            pg8::EpiUp E{ws};
            pg8::gemm_phase<pg8::EpiUp, pg8::StaticOrder, true, true>(F.lds, g, S, E, otid);
        } SEAM();
        if (ON(5)) {
            SITE_IDS();
            unsigned char* const ws = WSP(); float* const out = OUTP();
            pg8::Gemm g{(const bf16*)(ws + WS_ACT), (const bf16*)(ws + WS_WDN + (size_t)(2 * pr) * 32 * MiB), MPAD, 2048, 8192}; pg8::StaticOrder S; S.init(MPAD, 2048, G, bid);
            pg8::EpiRes E{out, out + (size_t)MP * DM, out, ws, 0};
            pg8::gemm_phase<pg8::EpiRes, pg8::StaticOrder, true, true>(F.lds, g, S, E, otid);
        } SEAM();
        if (ON(6)) {
            SITE_IDS();
            unsigned char* const ws = WSP();
            pg8::Gemm g{(const bf16*)(ws + WS_XB), (const bf16*)(ws + WS_WQB + (size_t)pr * 12 * MiB), MPAD, 3072, 2048}; pg8::StaticOrder S; S.init(MPAD, 3072, G, bid);
            pg8::EpiQKV<true> E{ws, OUTP(), pr};
            pg8::gemm_phase<pg8::EpiQKV<true>, pg8::StaticOrder, true, true>(F.lds, g, S, E, otid);
        } SEAM();
        if (ON(7)) {
            SITE_IDS();
            unsigned char* const ws = WSP(); bf16* const QB = (bf16*)(ws + WS_Q); const bf16* const KB = (const bf16*)(ws + WS_K); const bf16* const VB = (const bf16*)(ws + WS_V);
            const float* sinks = FPTR(P_BSINK) + pr * 32;
            for (int su = vcu; su < 256; su += G)
                att::sample_attn_unit<64, 128, false>(otid, su >> 5, su & 31, QB, KB, VB, QB, FPTR(P_CBK) + (size_t)pr * 8 * 128 * 512, FPTR(P_CBV) + (size_t)pr * 8 * 128 * 512, sinks, alds);
            OTID(otid2);
            for (int u = vcu; u < 256; u += G) { const int bk = u >> 3, run = u & 7;
                att::attnB_unit(otid2, bk >> 3, bk & 7, run, QB, KB, VB, QB, sinks, alds); }
            __syncthreads();
        } SEAM();
        if (ON(8)) {
            SITE_IDS();
            unsigned char* const ws = WSP(); float* const out = OUTP();
            pg8::Gemm g{(const bf16*)(ws + WS_Q), (const bf16*)(ws + WS_WOB + (size_t)pr * 8 * MiB), MPAD, 2048, 2048}; pg8::StaticOrder S; S.init(MPAD, 2048, G, bid);
            pg8::EpiRes E{out, out + (size_t)MP * DM, out, ws, 1};
            pg8::gemm_phase<pg8::EpiRes, pg8::StaticOrder, true, true>(F.lds, g, S, E, otid);
        } SEAM();
        if (ON(9)) {
            SITE_IDS();
            unsigned char* const ws = WSP();
            pg8::Gemm g{(const bf16*)(ws + WS_XB), (const bf16*)(ws + WS_WUP + (size_t)(2 * pr + 1) * 32 * MiB), MPAD, 8192, 2048}; pg8::StaticOrder S; S.init(MPAD, 8192, G, bid);
            pg8::EpiUp E{ws};
            pg8::gemm_phase<pg8::EpiUp, pg8::StaticOrder, true, true>(F.lds, g, S, E, otid);
        } SEAM();
        if (ON(10)) {
            SITE_IDS();
            unsigned char* const ws = WSP(); float* const out = OUTP();
            pg8::Gemm g{(const bf16*)(ws + WS_ACT), (const bf16*)(ws + WS_WDN + (size_t)(2 * pr + 1) * 32 * MiB), MPAD, 2048, 8192}; pg8::StaticOrder S; S.init(MPAD, 2048, G, bid);
            pg8::EpiRes E{out, out + (size_t)MP * DM, out, ws, 0};
            pg8::gemm_phase<pg8::EpiRes, pg8::StaticOrder, true, true>(F.lds, g, S, E, otid);
        } SEAM();
    }
    if (ON(11)) final_norm(F, wave0);
#undef ON
#undef SEAM
}

extern "C" void kernel_launch(void* const* d_in, const int* in_sizes, int n_in, void* d_out, int out_size, void* d_ws, size_t ws_size, hipStream_t stream) {
    static int grid = 0;
    if (grid == 0) {
        if (n_in != 17 || in_sizes[0] != MP * DM || (size_t)out_size != O_END || ws_size < WS_END) { fprintf(stderr, "kernel_launch: unexpected shapes (n_in %d, in0 %d, out %d, ws %zu)\n", n_in, n_in > 0 ? in_sizes[0] : -1, out_size, ws_size); grid = -1; return; }
        int dev = 0, cus = 0, per_cu = 0;
        if (hipGetDevice(&dev) != hipSuccess || hipDeviceGetAttribute(&cus, hipDeviceAttributeMultiprocessorCount, dev) != hipSuccess) { grid = -1; return; }
#if MK_ONE_LAUNCH
        if (hipFuncSetAttribute((const void*)mk_fwd<-1>, hipFuncAttributeMaxDynamicSharedMemorySize, LDS_BYTES) != hipSuccess) { fprintf(stderr, "kernel_launch: hipFuncSetAttribute failed\n"); grid = -1; return; }
        if (hipOccupancyMaxActiveBlocksPerMultiprocessor(&per_cu, (const void*)mk_fwd<-1>, NWAVES * 64, LDS_BYTES) != hipSuccess || per_cu < 1) { fprintf(stderr, "kernel_launch: occupancy query reports %d workgroups per CU\n", per_cu); grid = -1; return; }
#else
#define SETATTR(s) (hipFuncSetAttribute((const void*)mk_fwd<s>, hipFuncAttributeMaxDynamicSharedMemorySize, LDS_BYTES) == hipSuccess)
        if (!(SETATTR(0) && SETATTR(1) && SETATTR(2) && SETATTR(3) && SETATTR(4) && SETATTR(5) && SETATTR(6) && SETATTR(7) && SETATTR(8) && SETATTR(9) && SETATTR(10) && SETATTR(11))) { fprintf(stderr, "kernel_launch: hipFuncSetAttribute failed\n"); grid = -1; return; }
        per_cu = 1;
#endif
        (void)hipGetLastError();
        grid = cus;
    }
    if (grid < 0) return;
    if (hipMemsetAsync((char*)d_ws + WS_CTL, 0, CTL_ZERO_BYTES, stream) != hipSuccess) return;
    Args a{};
    for (int i = 0; i < 17; ++i) a.in[i] = (const float*)d_in[i];
    a.out = (float*)d_out; a.ws = (unsigned char*)d_ws;
#if MK_ONE_LAUNCH
    a.pr_lo = 0; a.pr_hi = 2;
    hipLaunchKernelGGL(mk_fwd<-1>, dim3(grid), dim3(NWAVES * 64), LDS_BYTES, stream, a);
#else
#define LAUNCH_SITE(s, p0, p1) do { a.pr_lo = (p0); a.pr_hi = (p1); hipLaunchKernelGGL(mk_fwd<s>, dim3(grid), dim3(NWAVES * 64), LDS_BYTES, stream, a); } while (0)
    LAUNCH_SITE(0, 0, 0);
    for (int p = 0; p < 2; ++p) { LAUNCH_SITE(1, p, p + 1); LAUNCH_SITE(2, p, p + 1); LAUNCH_SITE(3, p, p + 1); LAUNCH_SITE(4, p, p + 1); LAUNCH_SITE(5, p, p + 1);
                                  LAUNCH_SITE(6, p, p + 1); LAUNCH_SITE(7, p, p + 1); LAUNCH_SITE(8, p, p + 1); LAUNCH_SITE(9, p, p + 1); LAUNCH_SITE(10, p, p + 1); }
    LAUNCH_SITE(11, 0, 0);
#endif
    const hipError_t le = hipPeekAtLastError();
    if (le != hipSuccess) fprintf(stderr, "kernel_launch: launch failed: %s\n", hipGetErrorName(le));
}
```

```cpp
#include <hip/hip_runtime.h>
#include <cstdio>
#include <cstdint>
template <int K> __device__ __forceinline__ float xl_swz(float v) { return __builtin_bit_cast(float, __builtin_amdgcn_ds_swizzle(__builtin_bit_cast(int, v), (K << 10) | 0x1f)); }
__device__ __forceinline__ void xl_swap32(float& a, float& b) { asm volatile("s_nop 1\n\tv_permlane32_swap_b32 %0, %1" : "+v"(a), "+v"(b)); }
__device__ __forceinline__ float xl_add32(float v) { float a = v, b = v; xl_swap32(a, b); return a + b; }
__device__ __forceinline__ float xl_max32(float v) { float a = v, b = v; xl_swap32(a, b); return fmaxf(a, b); }
__device__ __forceinline__ float xl_wave_sum(float v) { v += xl_swz<1>(v); v += xl_swz<2>(v); v += xl_swz<4>(v); v += xl_swz<8>(v); v += xl_swz<16>(v); return xl_add32(v); }
__device__ __forceinline__ float xl_wave_max(float v) { v = fmaxf(v, xl_swz<1>(v)); v = fmaxf(v, xl_swz<2>(v)); v = fmaxf(v, xl_swz<4>(v)); v = fmaxf(v, xl_swz<8>(v)); v = fmaxf(v, xl_swz<16>(v)); return xl_max32(v); }
namespace pg8 {
#define PG8_LAS __attribute__((address_space(3)))
typedef unsigned short bf16_t;
typedef short bf16x8 __attribute__((ext_vector_type(8)));
typedef float f32x4 __attribute__((ext_vector_type(4)));
typedef unsigned u32x4 __attribute__((ext_vector_type(4)));
constexpr int BM = 256, BK = 64, HALF = 128, HTB = HALF * BK * 2  , STAGE_BYTES = 8 * HTB, NXCD = 8, WGM = 8;

__host__ __device__ __forceinline__ int lds_byte(int r, int c) { const int st = (r >> 4) * 2 + (c >> 5), rr = r & 15, cc = c & 31, ob = rr * 64 + cc * 2; return st * 1024 + (ob ^ (((ob >> 9) & 1) << 5)); }
__host__ __device__ __forceinline__ void stage_rc(int b, int& R, int& C) { const int st = b / 1024, sb = b % 1024, swz = sb ^ (((sb >> 9) & 1) << 5); R = (st >> 1) * 16 + swz / 64; C = (st & 1) * 32 + (swz % 64) / 2; }
__host__ __device__ __forceinline__ int perm32(int rho) { const int n = rho >> 4, i = rho & 15; return 8 * (i >> 2) + 4 * n + (i & 3); }

struct Unit { int pm, pn; };
struct Gemm { const bf16_t* A; const bf16_t* Bt; int M, N, K; };

struct StaticOrder {
    int nM, nN, nwg, G, c;
    __host__ __device__ void init(int M, int N, int G_, int c_) { nM = M / BM; nN = N / BM; nwg = nM * nN; G = G_; c = c_; }
    __host__ __device__ bool next(int i, Unit& u) const {
        const long L = (long)i * G + c; if (L >= nwg) return false;
        int wgid = (int)L; { const int q = nwg / NXCD, r = nwg % NXCD, xcd = wgid % NXCD, off = wgid / NXCD; wgid = (xcd < r ? xcd * (q + 1) : r * (q + 1) + (xcd - r) * q) + off; }
        const int nig = WGM * nN, gid = wgid / nig, fm = gid * WGM, gsz = (nM - fm) < WGM ? (nM - fm) : WGM;
        u.pm = fm + ((wgid % nig) % gsz); u.pn = (wgid % nig) / gsz; return true;
    }
    __device__ __forceinline__ void a_ready(const Unit&) const {}
    __device__ __forceinline__ void done(const Unit&) const {}
};

__device__ __forceinline__ unsigned cvt_pk_bf16(float lo, float hi) { unsigned r; asm volatile("v_cvt_pk_bf16_f32 %0, %1, %2" : "=v"(r) : "v"(lo), "v"(hi)); return r; }
typedef float f32x2 __attribute__((ext_vector_type(2)));
__device__ __forceinline__ float row_rstd(const float* SS, int row, int fq) {
    const f32x4* p = (const f32x4*)(SS + (size_t)row * 32 + fq * 8); const f32x4 a = p[0], b = p[1];
    float s = ((a[0] + a[1]) + (a[2] + a[3])) + ((b[0] + b[1]) + (b[2] + b[3]));
    s += xl_swz<16>(s); s = xl_add32(s);
    return __builtin_amdgcn_rsqf(s * (1.0f / 2048.0f) + 1e-6f);
}
constexpr int ROWS_P = 32768, ROWS_R = 32896;
constexpr size_t WS_XB_ = (size_t)361 << 20, WS_SS0_ = (size_t)490 << 20, WS_SS1_ = (size_t)495 << 20, WS_Q_ = (size_t)500 << 20, WS_K_ = (size_t)629 << 20, WS_V_ = (size_t)758 << 20;
template <bool ISB> struct EpiQKV {
    static constexpr bool PERM = true, AFTER_DRAIN = false;
    unsigned char* ws; float* out; int pr;
    __device__ __forceinline__ void operator()(const f32x4 (&acc)[2][2][4][2], const Unit& u, int wr, int wc, int fr, int fq) const {
        constexpr int nkv = ISB ? 512 : 2048, CL = ISB ? 128 : 512;
        constexpr float qscale = (ISB ? 0.125f : 0.08838834764831845f) * 1.4426950408889634f;
        constexpr size_t OKP = ISB ? 84148224 : 67371008, OVP = ISB ? 84672512 : 75759616, OKS = ISB ? 118751232 : 85196800, OVS = ISB ? 119799808 : 101974016;
        const float* SS = (const float*)(ws + WS_SS0_);
        const int colt = u.pn * BM; const int region = colt < 2048 ? 0 : (colt < 2048 + nkv ? 1 : 2);
        const int cbase = (region == 0 ? colt : (region == 1 ? colt - 2048 : colt - 2048 - nkv)) + wc * 32 + 8 * fq;
        bf16_t* const ob = (bf16_t*)(ws + (region == 0 ? WS_Q_ : (region == 1 ? WS_K_ : WS_V_))); const int ld = region == 0 ? 2048 : nkv;
        float* const stp = out + (region == 1 ? OKP : OVP) + (size_t)pr * 4 * CL * nkv; float* const sts = out + (region == 1 ? OKS : OVS) + (size_t)pr * 8 * CL * nkv;
        const float sc = region == 0 ? qscale : 1.0f;
#pragma unroll
        for (int ai = 0; ai < 2; ++ai)
#pragma unroll
            for (int m = 0; m < 4; ++m) {
                const int row = u.pm * BM + ai * HALF + wr * 64 + m * 16 + fr;
                const float rs = row_rstd(SS, row, fq) * sc;
                int srow = -1;
                if (region != 0) {
                    if (row < ROWS_P) { const int t = row & 8191, b = row >> 13; if (t >= 8192 - CL) srow = b * CL + (t - (8192 - CL)); }
                    else if (row < ROWS_R) { const int r = row - ROWS_P; srow = (r >> 4) * CL + (CL - 16 + (r & 15)); }
                }
                float* const sp = row < ROWS_P ? stp : sts;
#pragma unroll
                for (int bj = 0; bj < 2; ++bj) {
                    const f32x4 v0 = acc[ai][bj][m][0] * rs, v1 = acc[ai][bj][m][1] * rs; const int col = cbase + bj * HALF;
                    u32x4 w; w.x = cvt_pk_bf16(v0[0], v0[1]); w.y = cvt_pk_bf16(v0[2], v0[3]); w.z = cvt_pk_bf16(v1[0], v1[1]); w.w = cvt_pk_bf16(v1[2], v1[3]);
                    *(u32x4*)(ob + (size_t)row * ld + col) = w;
                    if (srow >= 0) { float* d = sp + (size_t)srow * nkv + col; *(f32x4*)d = v0; *(f32x4*)(d + 4) = v1; }
                }
            }
    }
};
__device__ __forceinline__ float bf_lo(unsigned w) { return __builtin_bit_cast(float, w << 16); }
__device__ __forceinline__ float bf_hi(unsigned w) { return __builtin_bit_cast(float, w & 0xffff0000u); }
struct EpiRes {
    static constexpr bool PERM = true, AFTER_DRAIN = false;
    unsigned char* ws; int sssel;
    __device__ __forceinline__ void operator()(const f32x4 (&acc)[2][2][4][2], const Unit& u, int wr, int wc, int fr, int fq) const {
        const int col0 = u.pn * BM + wc * 32 + 8 * fq; bf16_t* const XB = (bf16_t*)(ws + WS_XB_); float* const SSout = (float*)(ws + (sssel ? WS_SS1_ : WS_SS0_));
#pragma unroll
        for (int ai = 0; ai < 2; ++ai)
#pragma unroll
            for (int m = 0; m < 4; ++m) {
                const int row = u.pm * BM + ai * HALF + wr * 64 + m * 16 + fr;
                float ssq = 0.f;
#pragma unroll
                for (int bj = 0; bj < 2; ++bj) { u32x4* const px = (u32x4*)(XB + (size_t)row * 2048 + col0 + bj * HALF);
                    const u32x4 xo = *px; const f32x4 a0 = acc[ai][bj][m][0], a1 = acc[ai][bj][m][1];
                    u32x4 w; w.x = cvt_pk_bf16(bf_lo(xo.x) + a0[0], bf_hi(xo.x) + a0[1]); w.y = cvt_pk_bf16(bf_lo(xo.y) + a0[2], bf_hi(xo.y) + a0[3]);
                    w.z = cvt_pk_bf16(bf_lo(xo.z) + a1[0], bf_hi(xo.z) + a1[1]); w.w = cvt_pk_bf16(bf_lo(xo.w) + a1[2], bf_hi(xo.w) + a1[3]);
                    *px = w;
                    const float r0 = bf_lo(w.x), r1 = bf_hi(w.x), r2 = bf_lo(w.y), r3 = bf_hi(w.y), r4 = bf_lo(w.z), r5 = bf_hi(w.z), r6 = bf_lo(w.w), r7 = bf_hi(w.w);
                    ssq += ((r0 * r0 + r1 * r1) + (r2 * r2 + r3 * r3)) + ((r4 * r4 + r5 * r5) + (r6 * r6 + r7 * r7)); }
                ssq += xl_swz<16>(ssq); ssq = xl_add32(ssq);
                if (fq == 0) SSout[(size_t)row * 32 + u.pn * 4 + wc] = ssq;
            }
    }
};
struct EpiUp {
    static constexpr bool PERM = true, AFTER_DRAIN = false;
    unsigned char* ws;
    __device__ __forceinline__ void operator()(const f32x4 (&acc)[2][2][4][2], const Unit& u, int wr, int wc, int fr, int fq) const {
        const int col0 = u.pn * BM + wc * 32 + 8 * fq; bf16_t* const H = (bf16_t*)(ws + WS_Q_); const float* const SS = (const float*)(ws + WS_SS1_);
#pragma unroll
        for (int ai = 0; ai < 2; ++ai)
#pragma unroll
            for (int m = 0; m < 4; ++m) {
                const int row = u.pm * BM + ai * HALF + wr * 64 + m * 16 + fr;
                const float rs = row_rstd(SS, row, fq);
#pragma unroll
                for (int bj = 0; bj < 2; ++bj) {
                    f32x4 v0 = acc[ai][bj][m][0] * rs, v1 = acc[ai][bj][m][1] * rs;
#pragma unroll
                    for (int e = 0; e < 4; ++e) { const float a = fmaxf(v0[e], 0.f), b = fmaxf(v1[e], 0.f); v0[e] = a * a; v1[e] = b * b; }
                    u32x4 w; w.x = cvt_pk_bf16(v0[0], v0[1]); w.y = cvt_pk_bf16(v0[2], v0[3]); w.z = cvt_pk_bf16(v1[0], v1[1]); w.w = cvt_pk_bf16(v1[2], v1[3]);
                    *(u32x4*)(H + (size_t)row * 8192 + col0 + bj * HALF) = w;
                }
            }
    }
};
template <class Epi, class Sched, bool ALIGN_EPI = false, bool SP2 = false>
__device__ __forceinline__ void gemm_phase(PG8_LAS unsigned char* lds, const Gemm g, const Sched& S, const Epi& E, const int tid_in) {
    int tid_ = tid_in; asm volatile("" : "+v"(tid_));
    const int tid = tid_, wid = __builtin_amdgcn_readfirstlane(tid >> 6), lane = tid & 63, wr = wid >> 2, wc = wid & 3, fr = lane & 15, fq = lane >> 4;
    const int K = g.K, nt = K / BK;
    unsigned voffA[2], voffB[2];
#pragma unroll
    for (int i = 0; i < 2; ++i) { int R, C; stage_rc(tid * 16 + i * 8192, R, C); const int Rb = Epi::PERM ? ((R & ~31) + perm32(R & 31)) : R;
        voffA[i] = (unsigned)(R * K + C) * 2u; voffB[i] = (unsigned)(Rb * K + C) * 2u; }
    const size_t kstep = (size_t)(BK * 2);
    const size_t hstep = (size_t)HALF * K * 2;
    const size_t tstep = 2 * hstep;
    const unsigned ldsw = (unsigned)wid * 1024u;
    const int aoff = lds_byte(wr * 64 + fr, fq * 8), boff = lds_byte(wc * 32 + fr, fq * 8);
#define PG8_SA(b, h) (((b) * 2 + (h)) * HTB)
#define PG8_SB(b, h) ((4 + (b) * 2 + (h)) * HTB)
#define PG8_STAGE(bufoff, gbase, voff) do { _Pragma("unroll") for (int _i = 0; _i < 2; ++_i) \
        __builtin_amdgcn_global_load_lds((const unsigned*)((const char*)(gbase) + (voff)[_i]), (PG8_LAS unsigned*)(lds + (bufoff) + ldsw + _i * 8192), 16, 0, 0); } while (0)
#define PG8_LDA(dst, b, h) do { _Pragma("unroll") for (int m = 0; m < 4; ++m) _Pragma("unroll") for (int k = 0; k < 2; ++k) dst[m][k] = *(const PG8_LAS bf16x8*)(lds + PG8_SA(b, h) + aoff + m * 2048 + k * 1024); } while (0)
#define PG8_LDB(dst, b, h) do { _Pragma("unroll") for (int n = 0; n < 2; ++n) _Pragma("unroll") for (int k = 0; k < 2; ++k) dst[n][k] = *(const PG8_LAS bf16x8*)(lds + PG8_SB(b, h) + boff + n * 2048 + k * 1024); } while (0)
#define PG8_MMA(ai, bj, At, Bt) do { __builtin_amdgcn_s_setprio(1); _Pragma("unroll") for (int m = 0; m < 4; ++m) _Pragma("unroll") for (int n = 0; n < 2; ++n) _Pragma("unroll") for (int k = 0; k < 2; ++k) \
        acc[ai][bj][m][n] = __builtin_amdgcn_mfma_f32_16x16x32_bf16(Bt[n][k], At[m][k], acc[ai][bj][m][n], 0, 0, 0); __builtin_amdgcn_s_setprio(0); } while (0)
#define PG8_WAIT_V(n) asm volatile("s_waitcnt vmcnt(" #n ")" ::: "memory")
#define PG8_WAIT_L(n) asm volatile("s_waitcnt lgkmcnt(" #n ")" ::: "memory")
#define PG8_BAR __builtin_amdgcn_s_barrier()
#define PG8_SCHED __builtin_amdgcn_sched_barrier(0)
    Unit cur, nxt; int ui = 0;
    if (!S.next(0, cur)) return;
    f32x4 acc[2][2][4][2];
#pragma unroll
    for (int a = 0; a < 2; ++a)
#pragma unroll
        for (int b = 0; b < 2; ++b)
#pragma unroll
            for (int m = 0; m < 4; ++m)
#pragma unroll
                for (int n = 0; n < 2; ++n) acc[a][b][m][n] = (f32x4){0.f, 0.f, 0.f, 0.f};
    bf16x8 At[4][2], B0[2][2], B1[2][2];
    const char* cA = (const char*)g.A + (size_t)cur.pm * tstep; const char* cB = (const char*)g.Bt + (size_t)cur.pn * tstep;
    S.a_ready(cur);
    if constexpr (SP2) {
        PG8_STAGE(PG8_SB(0, 0), cB, voffB); PG8_STAGE(PG8_SB(0, 1), cB + hstep, voffB); PG8_STAGE(PG8_SA(0, 0), cA, voffA); PG8_STAGE(PG8_SA(0, 1), cA + hstep, voffA);
        if (wr == 1) PG8_BAR;
        PG8_WAIT_V(2); PG8_BAR;
        PG8_STAGE(PG8_SB(1, 0), cB + kstep, voffB); PG8_STAGE(PG8_SA(1, 0), cA + kstep, voffA); PG8_STAGE(PG8_SB(1, 1), cB + hstep + kstep, voffB);
        PG8_WAIT_V(6); PG8_BAR;
    } else {
        PG8_STAGE(PG8_SB(0, 0), cB, voffB); PG8_STAGE(PG8_SA(0, 0), cA, voffA); PG8_STAGE(PG8_SB(0, 1), cB + hstep, voffB); PG8_STAGE(PG8_SA(0, 1), cA + hstep, voffA);
        if (wr == 1) PG8_BAR;
        PG8_WAIT_V(4); PG8_BAR;
        PG8_STAGE(PG8_SB(1, 0), cB + kstep, voffB); PG8_STAGE(PG8_SA(1, 0), cA + kstep, voffA); PG8_STAGE(PG8_SB(1, 1), cB + hstep + kstep, voffB);
        PG8_WAIT_V(6); PG8_BAR;
    }
    for (;;) {
        const bool has_next = S.next(ui + 1, nxt);
        const char* nA = has_next ? (const char*)g.A + (size_t)nxt.pm * tstep : cA; const char* nB = has_next ? (const char*)g.Bt + (size_t)nxt.pn * tstep : cB;
        for (int t = 0; t < nt; t += 2) {
            const bool last = (t == nt - 2);
            const char* a1 = cA + (size_t)(t + 1) * kstep;
            const char* a2 = last ? nA : cA + (size_t)(t + 2) * kstep; const char* b2 = last ? nB : cB + (size_t)(t + 2) * kstep;
            const char* a3 = a2 + kstep; const char* b3 = b2 + kstep;
            if (last && has_next) S.a_ready(nxt);
            if constexpr (SP2) {
            PG8_LDB(B0, 0, 0); PG8_LDB(B1, 0, 1); PG8_SCHED; PG8_LDA(At, 0, 0); PG8_STAGE(PG8_SA(1, 1), a1 + hstep, voffA);
            PG8_WAIT_V(8); PG8_WAIT_L(0); PG8_BAR; PG8_MMA(0, 0, At, B0); PG8_MMA(0, 1, At, B1); PG8_BAR; PG8_SCHED;
            PG8_LDA(At, 0, 1); PG8_STAGE(PG8_SB(0, 0), b2, voffB); PG8_STAGE(PG8_SB(0, 1), b2 + hstep, voffB); PG8_STAGE(PG8_SA(0, 0), a2, voffA);
            PG8_WAIT_V(8); PG8_WAIT_L(0); PG8_BAR; PG8_MMA(1, 0, At, B0); PG8_MMA(1, 1, At, B1); PG8_BAR; PG8_SCHED;
            PG8_LDB(B0, 1, 0); PG8_LDB(B1, 1, 1); PG8_SCHED; PG8_LDA(At, 1, 0); PG8_STAGE(PG8_SA(0, 1), a2 + hstep, voffA);
            PG8_WAIT_V(8); PG8_WAIT_L(0); PG8_BAR; PG8_MMA(0, 0, At, B0); PG8_MMA(0, 1, At, B1); PG8_BAR; PG8_SCHED;
            PG8_LDA(At, 1, 1); PG8_STAGE(PG8_SB(1, 0), b3, voffB); PG8_STAGE(PG8_SB(1, 1), b3 + hstep, voffB); PG8_STAGE(PG8_SA(1, 0), a3, voffA);
            PG8_WAIT_V(8); PG8_WAIT_L(0); PG8_BAR; PG8_MMA(1, 0, At, B0); PG8_MMA(1, 1, At, B1); PG8_BAR; PG8_SCHED;
            } else {
            PG8_LDB(B0, 0, 0); PG8_SCHED; PG8_LDA(At, 0, 0); PG8_STAGE(PG8_SA(1, 1), a1 + hstep, voffA);
            PG8_WAIT_L(8); PG8_BAR; PG8_WAIT_L(0); PG8_MMA(0, 0, At, B0); PG8_BAR; PG8_SCHED;
            PG8_LDB(B1, 0, 1); PG8_STAGE(PG8_SB(0, 0), b2, voffB);
            PG8_BAR; PG8_WAIT_L(0); PG8_MMA(0, 1, At, B1); PG8_BAR;
            PG8_LDA(At, 0, 1); PG8_STAGE(PG8_SA(0, 0), a2, voffA);
            PG8_BAR; PG8_WAIT_L(0); PG8_MMA(1, 0, At, B0); PG8_BAR; PG8_SCHED;
            PG8_STAGE(PG8_SB(0, 1), b2 + hstep, voffB);
            PG8_WAIT_V(6); PG8_BAR; PG8_MMA(1, 1, At, B1); PG8_BAR;
            PG8_LDB(B0, 1, 0); PG8_SCHED; PG8_LDA(At, 1, 0); PG8_STAGE(PG8_SA(0, 1), a2 + hstep, voffA);
            PG8_WAIT_L(8); PG8_BAR; PG8_WAIT_L(0); PG8_MMA(0, 0, At, B0); PG8_BAR; PG8_SCHED;
            PG8_LDB(B1, 1, 1); PG8_STAGE(PG8_SB(1, 0), b3, voffB);
            PG8_BAR; PG8_WAIT_L(0); PG8_MMA(0, 1, At, B1); PG8_BAR;
            PG8_LDA(At, 1, 1); PG8_STAGE(PG8_SA(1, 0), a3, voffA);
            PG8_BAR; PG8_WAIT_L(0); PG8_MMA(1, 0, At, B0); PG8_BAR; PG8_SCHED;
            PG8_STAGE(PG8_SB(1, 1), b3 + hstep, voffB);
            PG8_WAIT_V(6); PG8_BAR; PG8_MMA(1, 1, At, B1); PG8_BAR;
            }
        }
        if constexpr (ALIGN_EPI) { if (wr == 0) PG8_BAR; }
        if constexpr (!Epi::AFTER_DRAIN) { E(acc, cur, wr, wc, fr, fq); S.done(cur); }
        if (!has_next) break;
#pragma unroll
        for (int a = 0; a < 2; ++a)
#pragma unroll
            for (int b = 0; b < 2; ++b)
#pragma unroll
                for (int m = 0; m < 4; ++m)
#pragma unroll
                    for (int n = 0; n < 2; ++n) acc[a][b][m][n] = (f32x4){0.f, 0.f, 0.f, 0.f};
        cur = nxt; cA = nA; cB = nB; ++ui;
        if constexpr (ALIGN_EPI) { if (wr == 1) PG8_BAR; }
    }
    PG8_WAIT_V(0);
    if constexpr (!ALIGN_EPI) { if (wr == 0) PG8_BAR; }
    PG8_BAR;
    if constexpr (Epi::AFTER_DRAIN) { E.fused(acc, cur, wr, wc, fr, fq, lds, wid, lane); S.done(cur); }
#undef PG8_SA
#undef PG8_SB
#undef PG8_STAGE
#undef PG8_LDA
#undef PG8_LDB
#undef PG8_MMA
#undef PG8_WAIT_V
#undef PG8_WAIT_L
#undef PG8_BAR
#undef PG8_SCHED
}
}
namespace att {
using bf16 = unsigned short;
using bf16x8 = __attribute__((ext_vector_type(8))) short;
using s16x4  = __attribute__((ext_vector_type(4))) short;
using f32x16 = __attribute__((ext_vector_type(16))) float;
using f32x4v = __attribute__((ext_vector_type(4))) float;
using u32x4  = __attribute__((ext_vector_type(4))) unsigned;
using u32x2  = __attribute__((ext_vector_type(2))) unsigned;
#define ALAS __attribute__((address_space(3)))
#define SBAR() __builtin_amdgcn_sched_barrier(0)
constexpr float LOG2E = 1.4426950408889634f;
constexpr float THR2 = 4.0f;
__device__ __forceinline__ int crow(int r, int hi) { return (r & 3) + 8 * (r >> 2) + 4 * hi; }
__device__ __forceinline__ unsigned cvtpk(float lo, float hi) { unsigned r; asm volatile("v_cvt_pk_bf16_f32 %0, %1, %2" : "=v"(r) : "v"(lo), "v"(hi)); return r; }
__device__ __forceinline__ float bf2f(unsigned short h) { return __uint_as_float((unsigned)h << 16); }
template <int HD> __device__ __forceinline__ int kswz(int row, int colB) {
    if constexpr (HD == 128) return row * 256 + (colB ^ ((row & 15) << 4));
    else return row * 128 + (colB ^ (((row >> 1) & 7) << 4));
}
template <int HD> __device__ __forceinline__ void qkt(f32x16& p0, f32x16& p1, const ALAS char* Ks, const bf16x8* qr, int r32, int hi) {
    p0 = f32x16{}; p1 = f32x16{};
#pragma unroll
    for (int d0 = 0; d0 < HD / 16; ++d0) { const int cb = (d0 * 16 + hi * 8) * 2;
        const bf16x8 b0 = *(const ALAS bf16x8*)(Ks + kswz<HD>(r32, cb));
        const bf16x8 b1 = *(const ALAS bf16x8*)(Ks + kswz<HD>(32 + r32, cb));
        p0 = __builtin_amdgcn_mfma_f32_32x32x16_bf16(b0, qr[d0], p0, 0, 0, 0);
        p1 = __builtin_amdgcn_mfma_f32_32x32x16_bf16(b1, qr[d0], p1, 0, 0, 0); }
}
template <int NCB> __device__ __forceinline__ int v_st(int k, int c) { const int kk = (k & ~0xC) | ((k & 4) << 1) | ((k & 8) >> 1); return ((kk >> 3) * NCB + (c >> 5)) * 512 + ((kk & 7) * 32 + (c & 31)) * 2; }
__device__ __forceinline__ int v_rd_base(int lane) { return ((lane & 3) << 3) | (((lane >> 2) & 3) << 6) | (((lane >> 4) & 1) << 5) | (((lane >> 5) & 1) << 8); }
template <int NCB> constexpr int v_rd_off(int d0, int ks, int half) { return d0 * 512 + ks * (NCB * 1024) + half * (NCB * 512); }
template <int OFF> __device__ __forceinline__ s16x4 tr_read(int vb) { s16x4 r; asm volatile("ds_read_b64_tr_b16 %0, %1 offset:%2" : "=&v"(r) : "v"(vb), "i"(OFF) : "memory"); return r; }
template <int NCB, int D0> __device__ __forceinline__ void pv_one(f32x16& od, int vb, bf16x8 pa0, bf16x8 pa1, bf16x8 pa2, bf16x8 pa3) {
    const s16x4 l0 = tr_read<v_rd_off<NCB>(D0, 0, 0)>(vb), h0 = tr_read<v_rd_off<NCB>(D0, 0, 1)>(vb), l1 = tr_read<v_rd_off<NCB>(D0, 1, 0)>(vb), h1 = tr_read<v_rd_off<NCB>(D0, 1, 1)>(vb);
    const s16x4 l2 = tr_read<v_rd_off<NCB>(D0, 2, 0)>(vb), h2 = tr_read<v_rd_off<NCB>(D0, 2, 1)>(vb), l3 = tr_read<v_rd_off<NCB>(D0, 3, 0)>(vb), h3 = tr_read<v_rd_off<NCB>(D0, 3, 1)>(vb);
    asm volatile("s_waitcnt lgkmcnt(0)" ::: "memory"); SBAR();
#define PK(L, H) (bf16x8){L[0], L[1], L[2], L[3], H[0], H[1], H[2], H[3]}
    od = __builtin_amdgcn_mfma_f32_32x32x16_bf16(pa0, PK(l0, h0), od, 0, 0, 0);
    od = __builtin_amdgcn_mfma_f32_32x32x16_bf16(pa1, PK(l1, h1), od, 0, 0, 0);
    od = __builtin_amdgcn_mfma_f32_32x32x16_bf16(pa2, PK(l2, h2), od, 0, 0, 0);
    od = __builtin_amdgcn_mfma_f32_32x32x16_bf16(pa3, PK(l3, h3), od, 0, 0, 0);
#undef PK
}
__device__ __forceinline__ void softmax_tile(f32x16& p0, f32x16& p1, float& m_reg, float& l_reg, float& alpha, bf16x8& pa0, bf16x8& pa1, bf16x8& pa2, bf16x8& pa3) {
    float pmax = p0[0];
#pragma unroll
    for (int r = 1; r < 16; ++r) pmax = fmaxf(pmax, p0[r]);
#pragma unroll
    for (int r = 0; r < 16; ++r) pmax = fmaxf(pmax, p1[r]);
    { auto rr = __builtin_amdgcn_permlane32_swap(__float_as_uint(pmax), __float_as_uint(pmax), false, false); pmax = fmaxf(__uint_as_float(rr[0]), __uint_as_float(rr[1])); }
    if (__all(pmax - m_reg <= THR2)) { alpha = 1.f; }
    else { const float mn = fmaxf(m_reg, pmax); alpha = __builtin_amdgcn_exp2f(m_reg - mn); m_reg = mn; }
    float ps = 0.f;
#pragma unroll
    for (int r = 0; r < 16; ++r) { p0[r] = __builtin_amdgcn_exp2f(p0[r] - m_reg); p1[r] = __builtin_amdgcn_exp2f(p1[r] - m_reg); }
#pragma unroll
    for (int r = 0; r < 16; ++r) ps += p0[r];
#pragma unroll
    for (int r = 0; r < 16; ++r) ps += p1[r];
    { auto rr = __builtin_amdgcn_permlane32_swap(__float_as_uint(ps), __float_as_uint(ps), false, false); ps = __uint_as_float(rr[0]) + __uint_as_float(rr[1]); }
    l_reg = l_reg * alpha + ps;
#define PK4(P, BASE, OUT) do { unsigned a0 = cvtpk(P[BASE + 0], P[BASE + 1]), a1 = cvtpk(P[BASE + 2], P[BASE + 3]);   \
    unsigned b0 = cvtpk(P[BASE + 4], P[BASE + 5]), b1 = cvtpk(P[BASE + 6], P[BASE + 7]);                              \
    auto r0 = __builtin_amdgcn_permlane32_swap(a0, b0, false, false); auto r1 = __builtin_amdgcn_permlane32_swap(a1, b1, false, false); \
    u32x4 w = {r0[0], r1[0], r0[1], r1[1]}; OUT = __builtin_bit_cast(bf16x8, w); } while (0)
    PK4(p0, 0, pa0); PK4(p0, 8, pa1); PK4(p1, 0, pa2); PK4(p1, 8, pa3);
#undef PK4
}
template <int NB> __device__ __forceinline__ void rescale_o(f32x16* o, float alpha, ALAS float* al_l, int r32, int hi) {
    if (__any(alpha < 1.f)) {
        if (hi == 0) al_l[r32] = alpha;
        asm volatile("s_waitcnt lgkmcnt(0)" ::: "memory");
#pragma unroll
        for (int r = 0; r < 16; ++r) { const float a = al_l[crow(r, hi)];
#pragma unroll
            for (int d = 0; d < NB; ++d) o[d][r] *= a; }
        asm volatile("s_waitcnt lgkmcnt(0)" ::: "memory");
    }
}
template <int NB> __device__ __forceinline__ void store_o(const f32x16* o, float l_tot, ALAS float* li_l, bf16* Ow, int r32, int hi) {
    if (hi == 0) li_l[r32] = l_tot;
    asm volatile("s_waitcnt lgkmcnt(0)" ::: "memory");
#pragma unroll
    for (int r = 0; r < 16; ++r) { const int orow = crow(r, hi); const float rl = __builtin_amdgcn_rcpf(li_l[orow]);
#pragma unroll
        for (int d0 = 0; d0 < NB; ++d0) { const unsigned w = cvtpk(o[d0][r] * rl, 0.f); Ow[(size_t)orow * 2048 + d0 * 32 + r32] = (bf16)(w & 0xffffu); } }
    asm volatile("s_waitcnt lgkmcnt(0)" ::: "memory");
}

constexpr int ATTA_LDS = 65536 + 2048 + 1040;
__device__ __forceinline__ void attnA_unit(const int tid, int b, int h, int qb, const bf16* Qb, const bf16* Kb, const bf16* Vb, bf16* Ob, const float* tabsrc, ALAS char* lds) {
    constexpr int HD = 128, LD = 2048, TB = 16384;
    const int lane = tid & 63, r32 = lane & 31, hi = lane >> 5; const int wid = __builtin_amdgcn_readfirstlane(tid >> 6);
    ALAS char* V_lds = lds; ALAS char* K_lds = lds + 2 * TB;
    ALAS float* wsf = (ALAS float*)(lds + 4 * TB) + wid * 64; ALAS float* tab = (ALAS float*)(lds + 4 * TB + 2048);
    if (tid < 257) tab[tid] = tabsrc[tid] * LOG2E;
    const int c0 = qb * 4, co = wid >> 1, c = c0 + co, rh = wid & 1;
    const size_t rowbase = (size_t)b * 8192;
    const bf16* Qw = Qb + (rowbase + c * 64 + rh * 32 + r32) * LD + h * HD + hi * 8;
    bf16x8 qr[8];
#pragma unroll
    for (int d0 = 0; d0 < 8; ++d0) qr[d0] = *(const bf16x8*)(Qw + d0 * 16);
    const int kc_lo = c0 - 8 > 0 ? c0 - 8 : 0, NT = c0 + 3 - kc_lo + 1;
    const int my_lo = c - 8 > 0 ? c - 8 : 0, my_hi = c;
    const int krow = 4 * wid + (lane >> 4), kchunk = (lane & 15) ^ (krow & 15);
    const int vkk = (wid >> 1) * 8 + ((lane & 31) >> 2), vkey = (vkk & ~0xC) | ((vkk & 4) << 1) | ((vkk & 8) >> 1), vcol = (2 * (wid & 1) + (lane >> 5)) * 32 + (lane & 3) * 8;
    const bf16* Kh = Kb + rowbase * LD + h * HD + (size_t)krow * LD + kchunk * 8; const bf16* Vh = Vb + rowbase * LD + h * HD + (size_t)vkey * LD + vcol;
    const int vb0 = (int)(unsigned)(uintptr_t)V_lds + v_rd_base(lane);
#define SDMA(kc, bf) do { const size_t o_ = (size_t)(kc) * 64 * LD; \
        __builtin_amdgcn_global_load_lds((const unsigned*)(Kh + o_), (ALAS unsigned*)(K_lds + (bf) * TB + wid * 1024), 16, 0, 0); \
        __builtin_amdgcn_global_load_lds((const unsigned*)(Kh + o_ + 32 * LD), (ALAS unsigned*)(K_lds + (bf) * TB + (wid + 8) * 1024), 16, 0, 0); \
        __builtin_amdgcn_global_load_lds((const unsigned*)(Vh + o_), (ALAS unsigned*)(V_lds + (bf) * TB + wid * 1024), 16, 0, 0); \
        __builtin_amdgcn_global_load_lds((const unsigned*)(Vh + o_ + 32 * LD), (ALAS unsigned*)(V_lds + (bf) * TB + (wid + 8) * 1024), 16, 0, 0); } while (0)
    float m_reg = -1e30f, l_reg = 0.f; f32x16 o[4] = {f32x16{}, f32x16{}, f32x16{}, f32x16{}};
    const int qloc = rh * 32 + r32;
    SDMA(kc_lo, 0); asm volatile("s_waitcnt vmcnt(0)" ::: "memory"); __syncthreads();
    for (int t = 0; t < NT; ++t) {
        const int kc = kc_lo + t, cur = t & 1;
        if (t + 1 < NT) SDMA(kc + 1, cur ^ 1);
        if (kc >= my_lo && kc <= my_hi) {
            f32x16 p0, p1; qkt<HD>(p0, p1, K_lds + cur * TB, qr, r32, hi);
            const int dc = kc - c;
            if (dc <= -3) { const float bb = tab[0];
#pragma unroll
                for (int r = 0; r < 16; ++r) { p0[r] += bb; p1[r] += bb; } }
            else { const int base = (dc + 2) * 64 - qloc + 4 * hi;
#pragma unroll
                for (int r = 0; r < 16; ++r) { const int i0 = base + (r & 3) + 8 * (r >> 2), i1 = i0 + 32; p0[r] += tab[i0 > 0 ? i0 : 0]; p1[r] += tab[i1 > 0 ? i1 : 0]; } }
            float alpha; bf16x8 pa0, pa1, pa2, pa3;
            softmax_tile(p0, p1, m_reg, l_reg, alpha, pa0, pa1, pa2, pa3);
            rescale_o<4>(o, alpha, wsf, r32, hi);
            const int vb = vb0 + cur * TB;
            pv_one<4, 0>(o[0], vb, pa0, pa1, pa2, pa3); pv_one<4, 1>(o[1], vb, pa0, pa1, pa2, pa3); pv_one<4, 2>(o[2], vb, pa0, pa1, pa2, pa3); pv_one<4, 3>(o[3], vb, pa0, pa1, pa2, pa3);
        }
        asm volatile("s_waitcnt vmcnt(0)" ::: "memory");
        __syncthreads();
    }
#undef SDMA
    store_o<4>(o, l_reg, wsf, Ob + (rowbase + c * 64 + rh * 32) * LD + h * HD, r32, hi);
}

constexpr int ATTB_RC = 16, ATTB_LDS = 65536 + 2048;
__device__ __forceinline__ void attnB_unit(const int tid, int b, int kvh, int run, const bf16* Qb, const bf16* Kb, const bf16* Vb, bf16* Ob, const float* sinks, ALAS char* lds) {
    constexpr int HD = 64, LDQ = 2048, LDK = 512, TB = 8192;
    const int lane = tid & 63, r32 = lane & 31, hi = lane >> 5; const int wid = __builtin_amdgcn_readfirstlane(tid >> 6);
    ALAS char* K_lds = lds; ALAS char* V_lds = lds + 4 * TB; ALAS float* wsf = (ALAS float*)(lds + 8 * TB) + wid * 64;
    const int qh = kvh * 4 + (wid >> 1), rh = wid & 1;
    const float slope2 = __builtin_amdgcn_exp2f(-0.25f * (float)(qh + 1)) * LOG2E, sink2 = sinks[qh] * LOG2E;
    const size_t rowbase = (size_t)b * 8192;
    const int krow = 8 * wid + (lane >> 3), kchunk = (lane & 7) ^ ((krow >> 1) & 7);
    const int vkk = wid * 8 + ((lane & 31) >> 2), vkey = (vkk & ~0xC) | ((vkk & 4) << 1) | ((vkk & 8) >> 1), vcol = (lane >> 5) * 32 + (lane & 3) * 8;
    const bf16* Kh = Kb + (rowbase + krow) * LDK + kvh * HD + kchunk * 8; const bf16* Vh = Vb + (rowbase + vkey) * LDK + kvh * HD + vcol;
    const int vb0 = (int)(unsigned)(uintptr_t)V_lds + v_rd_base(lane);
    const int c_first = run * ATTB_RC, c_last = c_first + ATTB_RC - 1;
#define SDMA(kc) do { __builtin_amdgcn_global_load_lds((const unsigned*)(Kh + (size_t)(kc) * 64 * LDK), (ALAS unsigned*)(K_lds + ((kc) & 3) * TB + wid * 1024), 16, 0, 0); \
        __builtin_amdgcn_global_load_lds((const unsigned*)(Vh + (size_t)(kc) * 64 * LDK), (ALAS unsigned*)(V_lds + ((kc) & 3) * TB + wid * 1024), 16, 0, 0); } while (0)
    for (int kc = (c_first - 2 > 0 ? c_first - 2 : 0); kc <= c_first; ++kc) SDMA(kc);
    const bf16* Qw = Qb + (rowbase + rh * 32 + r32) * LDQ + qh * HD + hi * 8;
    bf16x8 qr[4], qn[4];
#pragma unroll
    for (int d0 = 0; d0 < 4; ++d0) qr[d0] = *(const bf16x8*)(Qw + (size_t)c_first * 64 * LDQ + d0 * 16);
    asm volatile("s_waitcnt vmcnt(0)" ::: "memory"); __syncthreads();
    const int qloc = rh * 32 + r32;
    for (int c = c_first; c <= c_last; ++c) {
        const bool more = c < c_last;
        if (more) { SDMA(c + 1);
#pragma unroll
            for (int d0 = 0; d0 < 4; ++d0) qn[d0] = *(const bf16x8*)(Qw + (size_t)(c + 1) * 64 * LDQ + d0 * 16); }
        float m_reg = -1e30f, l_reg = 0.f; f32x16 o[2] = {f32x16{}, f32x16{}};
        for (int kc = (c - 2 > 0 ? c - 2 : 0); kc <= c; ++kc) {
            const int slot = kc & 3;
            f32x16 p0, p1; qkt<HD>(p0, p1, K_lds + slot * TB, qr, r32, hi);
            const int base = (kc - c) * 64 - qloc + 4 * hi;
#pragma unroll
            for (int r = 0; r < 16; ++r) { const int i0 = base + (r & 3) + 8 * (r >> 2); p0[r] -= slope2 * fabsf((float)i0); p1[r] -= slope2 * fabsf((float)(i0 + 32)); }
            float alpha; bf16x8 pa0, pa1, pa2, pa3;
            softmax_tile(p0, p1, m_reg, l_reg, alpha, pa0, pa1, pa2, pa3);
            rescale_o<2>(o, alpha, wsf, r32, hi);
            const int vb = vb0 + slot * TB;
            pv_one<2, 0>(o[0], vb, pa0, pa1, pa2, pa3); pv_one<2, 1>(o[1], vb, pa0, pa1, pa2, pa3);
        }
        const float l_tot = l_reg + __builtin_amdgcn_exp2f(sink2 - m_reg);
        store_o<2>(o, l_tot, wsf, Ob + (rowbase + (size_t)c * 64 + rh * 32) * LDQ + qh * HD, r32, hi);
        if (more) {
#pragma unroll
            for (int d0 = 0; d0 < 4; ++d0) qr[d0] = qn[d0]; }
        asm volatile("s_waitcnt vmcnt(0)" ::: "memory");
        __syncthreads();
    }
#undef SDMA
}

template <int HD, int CL, bool ISA>
__device__ __forceinline__ void sample_attn_unit(const int tid, int sb, int qh, const bf16* Qb, const bf16* Kb, const bf16* Vb, bf16* Ob, const float* cache_k, const float* cache_v, const float* aux, ALAS char* lds) {
    constexpr int NK = CL + 16, NKP = NK + 1, KVW = ISA ? 2048 : 512, PAST = 1024;
    const int lane = tid & 63; const int wid = __builtin_amdgcn_readfirstlane(tid >> 6);
    const int kvh = ISA ? qh : (qh >> 2);
    ALAS float* qs = (ALAS float*)lds; ALAS float* S = qs + 16 * HD; ALAS float* inv = S + 16 * NKP;
    const size_t row0 = 32768 + (size_t)sb * 16;
    for (int i = tid; i < 16 * HD; i += 512) { const int j = i / HD, d = i % HD; qs[i] = bf2f(Qb[(row0 + j) * 2048 + qh * HD + d]); }
    __syncthreads();
    const float slope2 = __builtin_amdgcn_exp2f(-0.25f * (float)(qh + 1)) * LOG2E;
    for (int k = tid; k < NK; k += 512) {
        float acc[16];
#pragma unroll
        for (int j = 0; j < 16; ++j) acc[j] = 0.f;
        if (k < CL) { const float* kp = cache_k + ((size_t)sb * CL + k) * KVW + kvh * HD;
#pragma unroll 2
            for (int d4 = 0; d4 < HD / 4; ++d4) { const f32x4v kv = *(const f32x4v*)(kp + d4 * 4);
#pragma unroll
                for (int j = 0; j < 16; ++j) { const f32x4v q4 = *(const ALAS f32x4v*)(qs + j * HD + d4 * 4); acc[j] += (kv[0] * q4[0] + kv[1] * q4[1]) + (kv[2] * q4[2] + kv[3] * q4[3]); } } }
        else { const bf16* kp = Kb + (row0 + (k - CL)) * KVW + kvh * HD;
#pragma unroll 2
            for (int d4 = 0; d4 < HD / 4; ++d4) { const u32x2 kw = *(const u32x2*)(kp + d4 * 4);
                const float k0 = __uint_as_float(kw[0] << 16), k1 = __uint_as_float(kw[0] & 0xffff0000u), k2 = __uint_as_float(kw[1] << 16), k3 = __uint_as_float(kw[1] & 0xffff0000u);
#pragma unroll
                for (int j = 0; j < 16; ++j) { const f32x4v q4 = *(const ALAS f32x4v*)(qs + j * HD + d4 * 4); acc[j] += (k0 * q4[0] + k1 * q4[1]) + (k2 * q4[2] + k3 * q4[3]); } } }
        const int kpos = k < CL ? PAST - CL + k : PAST + (k - CL);
#pragma unroll
        for (int j = 0; j < 16; ++j) { const int rel = kpos - (PAST + j); float bias;
            if constexpr (ISA) { int idx = rel < -128 ? -128 : (rel > 128 ? 128 : rel); bias = aux[idx + 128] * LOG2E; } else { bias = -slope2 * fabsf((float)rel); }
            S[j * NKP + k] = acc[j] + bias; }
    }
    __syncthreads();
#pragma unroll
    for (int jj = 0; jj < 2; ++jj) { const int j = 2 * wid + jj;
        float m = -1e30f; for (int k = lane; k < NK; k += 64) m = fmaxf(m, S[j * NKP + k]);
        m = xl_wave_max(m);
        float s = 0.f; for (int k = lane; k < NK; k += 64) { const float e = __builtin_amdgcn_exp2f(S[j * NKP + k] - m); S[j * NKP + k] = e; s += e; }
        s = xl_wave_sum(s);
        if constexpr (!ISA) s += __builtin_amdgcn_exp2f(aux[qh] * LOG2E - m);
        if (lane == 0) inv[j] = 1.0f / s; }
    __syncthreads();
    constexpr int TPR = HD / 4;
    if (tid < 16 * TPR) { const int j = tid / TPR, d4 = (tid % TPR) * 4; f32x4v o = {0.f, 0.f, 0.f, 0.f};
        const float* vp = cache_v + (size_t)sb * CL * KVW + kvh * HD + d4;
#pragma unroll 8
        for (int k = 0; k < CL; ++k) { const float p = S[j * NKP + k]; const f32x4v v4 = *(const f32x4v*)(vp + (size_t)k * KVW); o = o + v4 * p; }
        const bf16* vn = Vb + row0 * KVW + kvh * HD + d4;
        for (int k = 0; k < 16; ++k) { const float p = S[j * NKP + CL + k]; const u32x2 vw = *(const u32x2*)(vn + (size_t)k * KVW);
            f32x4v v4 = {__uint_as_float(vw[0] << 16), __uint_as_float(vw[0] & 0xffff0000u), __uint_as_float(vw[1] << 16), __uint_as_float(vw[1] & 0xffff0000u)}; o = o + v4 * p; }
        const float il = inv[j]; u32x2 w; w[0] = cvtpk(o[0] * il, o[1] * il); w[1] = cvtpk(o[2] * il, o[3] * il);
        *(u32x2*)(Ob + (row0 + j) * 2048 + qh * HD + d4) = w; }
    __syncthreads();
}
#undef SBAR
#undef ALAS
}
constexpr int NWAVES = 8;
#ifndef MK_ONE_LAUNCH
#define MK_ONE_LAUNCH 1
#endif
constexpr int DM = 2048, FF = 8192, SEQ = 8192, NBATCH = 4, MP = NBATCH * SEQ, MS = 128, MR = MP + MS, MPAD = 33024;
constexpr int NPH = 22;
constexpr size_t MiB = 1u << 20;
constexpr size_t WS_CTL = 0, CTL_ZERO_BYTES = 1 * MiB;
constexpr size_t WS_WQA = 1 * MiB, WS_WOA = 49 * MiB, WS_WQB = 65 * MiB, WS_WOB = 89 * MiB, WS_WUP = 105 * MiB, WS_WDN = 233 * MiB;
constexpr size_t WS_XB = 361 * MiB;
constexpr size_t WS_SS0 = 490 * MiB, WS_SS1 = 495 * MiB;
constexpr size_t WS_ACT = 500 * MiB;
constexpr size_t WS_Q = WS_ACT, WS_K = WS_ACT + 129 * MiB, WS_V = WS_ACT + 258 * MiB, WS_O = WS_ACT + 387 * MiB, WS_END = WS_ACT + 516 * MiB;
static_assert((size_t)MPAD * DM * 2 == 129 * MiB && (size_t)MPAD * FF * 2 == 516 * MiB, "buffer sizes");
constexpr int CW_TMO = 0, CW_BAR = 4096;
constexpr size_t O_Y = 0, O_AKP = 67371008, O_AVP = 75759616, O_BKP = 84148224, O_BVP = 84672512, O_AKS = 85196800, O_AVS = 101974016, O_BKS = 118751232, O_BVS = 119799808, O_END = 120848384;
constexpr int RING_BYTES = 131072, MISC_OFF = RING_BYTES + 320, LDS_BYTES = 147456;

#define GAS __attribute__((address_space(1)))
#define LAS __attribute__((address_space(3)))
typedef unsigned short bf16;
typedef unsigned v4u __attribute__((ext_vector_type(4)));
typedef unsigned v2u __attribute__((ext_vector_type(2)));
typedef float f32x4 __attribute__((ext_vector_type(4)));
typedef GAS unsigned gu32;
#define RLX_AGENT __ATOMIC_RELAXED, __HIP_MEMORY_SCOPE_AGENT
#define LDS_WAIT() asm volatile("s_waitcnt lgkmcnt(0)" ::: "memory")
#define VM_WAIT() asm volatile("s_waitcnt vmcnt(0)" ::: "memory")
__device__ __forceinline__ unsigned f2bf(float f) { unsigned u = __builtin_bit_cast(unsigned, f); return (u + 0x7fffu + ((u >> 16) & 1u)) >> 16; }
__device__ __forceinline__ unsigned pk2(float lo, float hi) { return f2bf(lo) | (f2bf(hi) << 16); }
#define XB_TMO      128
#define XB_XCNT(j)  (256  + 64 * (j))
#define XB_XSUB(j)  (1280 + 64 * (j))
#define XB_XGEN(j)  (2304 + 64 * (j))
#define XB_TOP      3328
#define XB_TOPGEN   3392
#define XCD_BAR_WORDS 3456
#define XB_SPIN_CAP (1u << 18)

__device__ __forceinline__ unsigned xb_ld(unsigned* p)              { return __hip_atomic_load(p, __ATOMIC_RELAXED, __HIP_MEMORY_SCOPE_AGENT); }
__device__ __forceinline__ unsigned xb_add(unsigned* p, unsigned v) { return __hip_atomic_fetch_add(p, v, __ATOMIC_RELAXED, __HIP_MEMORY_SCOPE_AGENT); }
__device__ __forceinline__ unsigned xb_xcc_id() { return (unsigned)__builtin_amdgcn_s_getreg((3 << 11) | 20) & 0xFu; }
#define XB_SPIN(cond, bar) do { unsigned _sp = 0; while (cond) { __builtin_amdgcn_s_sleep(1); \
    if ((++_sp & 255u) == 0u) { if (xb_ld(&(bar)[XB_TMO])) break; if (_sp > XB_SPIN_CAP) { atomicAdd(&(bar)[XB_TMO], 1u); break; } } } } while (0)

struct XcdBarrier {
    unsigned* bar; unsigned x;
    volatile LAS unsigned* st;
};

__device__ __forceinline__ XcdBarrier xcd_barrier_post(unsigned* bar, volatile LAS unsigned* st) {
    XcdBarrier b; b.bar = bar; b.x = xb_xcc_id(); b.st = st;
    if (threadIdx.x == 0) (void)xb_add(&bar[XB_XCNT(b.x)], 1u);
    return b;
}
__device__ __forceinline__ void xcd_barrier_complete(unsigned* bar, unsigned x, unsigned& nloc, unsigned& nx) {
    const unsigned G = gridDim.x * gridDim.y * gridDim.z;
    unsigned sum, cnt, mine, sp = 0u;
    for (;;) {
        sum = 0u; cnt = 0u; mine = 0u;
#pragma unroll
        for (unsigned j = 0; j < 16; ++j) { const unsigned c = xb_ld(&bar[XB_XCNT(j)]); sum += c; cnt += (c > 0u) ? 1u : 0u; mine = (j == x) ? c : mine; }
        if (sum == G) break;
        __builtin_amdgcn_s_sleep(1);
        if ((++sp & 255u) == 0u) { if (xb_ld(&bar[XB_TMO])) break; if (sp > XB_SPIN_CAP) { atomicAdd(&bar[XB_TMO], 1u); break; } }
    }
    nloc = mine > 0u ? mine : 1u; nx = cnt > 0u ? cnt : 1u;
}

__device__ __forceinline__ void xcd_barrier(const XcdBarrier& b) {
    asm volatile("s_waitcnt vmcnt(0)" ::: "memory");
    __syncthreads();
    if (threadIdx.x == 0) {
        unsigned* bar = b.bar;
        __builtin_amdgcn_s_waitcnt(0);
        unsigned nloc = b.st[0], nx = b.st[1];
        if (nloc == 0u) { xcd_barrier_complete(bar, b.x, nloc, nx); b.st[0] = nloc; b.st[1] = nx; }
        const unsigned old = xb_add(&bar[XB_XSUB(b.x)], 1u);
        const unsigned gen = old / nloc;
        if (old + 1u == (gen + 1u) * nloc) {
            __builtin_amdgcn_fence(__ATOMIC_RELEASE, "agent");
            asm volatile("s_waitcnt vmcnt(0)" ::: "memory");
            const unsigned og = xb_add(&bar[XB_TOP], 1u);
            const unsigned tg = og / nx;
            if (og + 1u == (tg + 1u) * nx) xb_add(&bar[XB_TOPGEN], 1u);
            else XB_SPIN(xb_ld(&bar[XB_TOPGEN]) == tg, bar);
            __builtin_amdgcn_fence(__ATOMIC_ACQUIRE, "agent");
            xb_add(&bar[XB_XGEN(b.x)], 1u);
            asm volatile("s_waitcnt vmcnt(0)" ::: "memory");
        } else {
            XB_SPIN(xb_ld(&bar[XB_XGEN(b.x)]) == gen, bar);
            __builtin_amdgcn_fence(__ATOMIC_ACQUIRE, "agent");
            asm volatile("s_waitcnt vmcnt(0)" ::: "memory");
        }
    }
    __syncthreads();
}
struct Frame {
    LAS unsigned char* lds;
    volatile LAS unsigned* MISC;
};
enum { P_XP = 0, P_XS, P_CAK, P_CAV, P_CBK, P_CBV, P_NMIX, P_NFFN, P_NFIN, P_AWQKV, P_AWO, P_AREL, P_BWQKV, P_BWO, P_BSINK, P_WUP, P_WDN, P_OUT, P_WS, P_COUNT };
typedef const __attribute__((address_space(4))) unsigned long long* karg_t;
#define KARGS() karg_t KA = (karg_t)__builtin_amdgcn_kernarg_segment_ptr(); asm volatile("" : "+s"(KA))
#define FPTR(i) ((const float*)KA[(i)])
#define OUTP() ((float*)KA[P_OUT])
#define WSP() ((unsigned char*)KA[P_WS])
__device__ __forceinline__ int opaque_lane() { int l; asm volatile("v_mbcnt_lo_u32_b32 %0, -1, 0\n\tv_mbcnt_hi_u32_b32 %0, -1, %0" : "=v"(l)); return l; }
__device__ __forceinline__ float wave_sum(float v) {
    return xl_wave_sum(v);
}
__device__ __forceinline__ void p0_transpose_item(const float* W, const float* gain, int K, int N, bf16* WT, LAS float* scr, int item, int lane) {
    const int nblk = N / 32, kb = item / nblk, nb = item % nblk, k0 = 64 * kb, n0 = 32 * nb;
#pragma unroll 8
    for (int i = 0; i < 32; ++i) { const int kk = 2 * i + (lane >> 5); const float g = gain ? gain[k0 + kk] : 1.0f; scr[kk * 33 + (lane & 31)] = W[(size_t)(k0 + kk) * N + n0 + (lane & 31)] * g; }
    LDS_WAIT(); asm volatile("" ::: "memory");
    const int c = lane & 7;
#pragma unroll
    for (int j = 0; j < 4; ++j) { const int n = (lane >> 3) + 8 * j; const LAS float* s = scr + (8 * c) * 33 + n;
        v4u o; o.x = pk2(s[0 * 33], s[1 * 33]); o.y = pk2(s[2 * 33], s[3 * 33]); o.z = pk2(s[4 * 33], s[5 * 33]); o.w = pk2(s[6 * 33], s[7 * 33]);
        *(GAS v4u*)(WT + (size_t)(n0 + n) * K + k0 + 8 * c) = o; }
    LDS_WAIT(); asm volatile("" ::: "memory");
}
__device__ __forceinline__ void p0_prologue(Frame& F, const int wave0) {
    KARGS();
    int tid_ = (wave0 << 6) | opaque_lane(), bid_ = blockIdx.x, G_ = gridDim.x; asm volatile("" : "+v"(tid_), "+s"(bid_), "+s"(G_));
    struct { int tid, lane, wave, vcu, G; } L; L.tid = tid_; L.lane = tid_ & 63; L.wave = __builtin_amdgcn_readfirstlane(tid_ >> 6); L.G = G_; L.vcu = (G_ % 8 == 0) ? (bid_ % 8) * (G_ / 8) + bid_ / 8 : bid_;
    unsigned char* const ws = WSP(); float* const out = OUTP();
    LAS float* scr = (LAS float*)(F.lds + L.wave * 16384);
    const int gw = L.vcu * NWAVES + L.wave, NGW = L.G * NWAVES;
    constexpr int I_AQ = 32 * 192, I_O = 32 * 64, I_BQ = 32 * 96, I_UP = 32 * 256, I_DN = 128 * 64;
    constexpr int E0 = 2 * I_AQ, E1 = E0 + 2 * I_O, E2 = E1 + 2 * I_BQ, E3 = E2 + 2 * I_O, E4 = E3 + 4 * I_UP, E5 = E4 + 4 * I_DN;
    for (int it = gw; it < E5; it += NGW) {
        if (it < E0) { const int s = it / I_AQ, r = it % I_AQ; p0_transpose_item(FPTR(P_AWQKV) + (size_t)s * 2048 * 6144, FPTR(P_NMIX) + (2 * s) * 2048, 2048, 6144, (bf16*)(ws + WS_WQA + (size_t)s * 24 * MiB), scr, r, L.lane); }
        else if (it < E1) { const int q = it - E0, s = q / I_O, r = q % I_O; p0_transpose_item(FPTR(P_AWO) + (size_t)s * 2048 * 2048, nullptr, 2048, 2048, (bf16*)(ws + WS_WOA + (size_t)s * 8 * MiB), scr, r, L.lane); }
        else if (it < E2) { const int q = it - E1, s = q / I_BQ, r = q % I_BQ; p0_transpose_item(FPTR(P_BWQKV) + (size_t)s * 2048 * 3072, FPTR(P_NMIX) + (2 * s + 1) * 2048, 2048, 3072, (bf16*)(ws + WS_WQB + (size_t)s * 12 * MiB), scr, r, L.lane); }
        else if (it < E3) { const int q = it - E2, s = q / I_O, r = q % I_O; p0_transpose_item(FPTR(P_BWO) + (size_t)s * 2048 * 2048, nullptr, 2048, 2048, (bf16*)(ws + WS_WOB + (size_t)s * 8 * MiB), scr, r, L.lane); }
        else if (it < E4) { const int q = it - E3, s = q / I_UP, r = q % I_UP; p0_transpose_item(FPTR(P_WUP) + (size_t)s * 2048 * 8192, FPTR(P_NFFN) + s * 2048, 2048, 8192, (bf16*)(ws + WS_WUP + (size_t)s * 32 * MiB), scr, r, L.lane); }
        else { const int q = it - E4, s = q / I_DN, r = q % I_DN; p0_transpose_item(FPTR(P_WDN) + (size_t)s * 8192 * 2048, nullptr, 8192, 2048, (bf16*)(ws + WS_WDN + (size_t)s * 32 * MiB), scr, r, L.lane); }
    }
    bf16* XB = (bf16*)(ws + WS_XB); float* SS0 = (float*)(ws + WS_SS0); const float* const xp_ = FPTR(P_XP); const float* const xs_ = FPTR(P_XS);
    for (int m = gw; m < MPAD; m += NGW) {
        GAS v2u* o8 = (GAS v2u*)(XB + (size_t)m * DM) + L.lane;
        if (m < MR) {
            const float* xrow = m < MP ? xp_ + (size_t)m * DM : xs_ + (size_t)(m - MP) * DM;
            const GAS f32x4* xr = (const GAS f32x4*)xrow + L.lane;
            f32x4 v[8]; float s = 0.f;
#pragma unroll
            for (int j = 0; j < 8; ++j) { v[j] = xr[64 * j]; s += (v[j][0] * v[j][0] + v[j][1] * v[j][1]) + (v[j][2] * v[j][2] + v[j][3] * v[j][3]); }
            s = wave_sum(s);
#pragma unroll
            for (int j = 0; j < 8; ++j) { v2u w; w.x = pk2(v[j][0], v[j][1]); w.y = pk2(v[j][2], v[j][3]); o8[64 * j] = w; }
            if (L.lane < 32) SS0[(size_t)m * 32 + L.lane] = L.lane == 0 ? s : 0.f;
        } else {
#pragma unroll
            for (int j = 0; j < 8; ++j) { v2u w; w.x = 0u; w.y = 0u; o8[64 * j] = w; }
            if (L.lane < 32) SS0[(size_t)m * 32 + L.lane] = 0.f;
        }
    }
    {
        const float* const cak_ = FPTR(P_CAK); const float* const cav_ = FPTR(P_CAV); const float* const cbk_ = FPTR(P_CBK); const float* const cbv_ = FPTR(P_CBV);
        const size_t gt = (size_t)bid_ * (NWAVES * 64) + L.tid, NT = (size_t)L.G * NWAVES * 64;
        constexpr size_t A_BLK4 = 512 * 512, A_CP4 = 496 * 512, A_TOT = 16 * A_CP4;
        for (size_t i = gt; i < 2 * A_TOT; i += NT) { const bool isv = i >= A_TOT; const size_t q = isv ? i - A_TOT : i, blk = q / A_CP4, off = q % A_CP4;
            const f32x4* src = (const f32x4*)(isv ? cav_ : cak_) + blk * A_BLK4 + 16 * 512 + off;
            f32x4* dst = (f32x4*)(out + (isv ? O_AVS : O_AKS)) + blk * A_BLK4 + off; *dst = *src; }
        constexpr size_t B_BLK4 = 128 * 128, B_CP4 = 112 * 128, B_TOT = 16 * B_CP4;
        for (size_t i = gt; i < 2 * B_TOT; i += NT) { const bool isv = i >= B_TOT; const size_t q = isv ? i - B_TOT : i, blk = q / B_CP4, off = q % B_CP4;
            const f32x4* src = (const f32x4*)(isv ? cbv_ : cbk_) + blk * B_BLK4 + 16 * 128 + off;
            f32x4* dst = (f32x4*)(out + (isv ? O_BVS : O_BKS)) + blk * B_BLK4 + off; *dst = *src; }
    }
}
__device__ __forceinline__ void final_norm(Frame& F, const int wave0) {
    KARGS();
    int tid_ = (wave0 << 6) | opaque_lane(), bid_ = blockIdx.x, G_ = gridDim.x; asm volatile("" : "+v"(tid_), "+s"(bid_), "+s"(G_));
    const int lane = tid_ & 63, wave = __builtin_amdgcn_readfirstlane(tid_ >> 6), vcu = (G_ % 8 == 0) ? (bid_ % 8) * (G_ / 8) + bid_ / 8 : bid_;
    float* const out = OUTP(); const float* const nfin_ = FPTR(P_NFIN); const bf16* const XB = (const bf16*)(WSP() + WS_XB);
    const int gw = vcu * NWAVES + wave, NGW = G_ * NWAVES;
    f32x4 g[4][2];
#pragma unroll
    for (int j = 0; j < 4; ++j) { g[j][0] = *(const GAS f32x4*)(nfin_ + 512 * j + 8 * lane); g[j][1] = *(const GAS f32x4*)(nfin_ + 512 * j + 8 * lane + 4); }
    for (int m = gw; m < MR; m += NGW) {
        const GAS v4u* xr = (const GAS v4u*)(XB + (size_t)m * DM) + lane;
        v4u w[4]; float s = 0.f; f32x4 v[4][2];
#pragma unroll
        for (int j = 0; j < 4; ++j) w[j] = xr[64 * j];
#pragma unroll
        for (int j = 0; j < 4; ++j) { v[j][0] = (f32x4){__uint_as_float(w[j].x << 16), __uint_as_float(w[j].x & 0xffff0000u), __uint_as_float(w[j].y << 16), __uint_as_float(w[j].y & 0xffff0000u)};
            v[j][1] = (f32x4){__uint_as_float(w[j].z << 16), __uint_as_float(w[j].z & 0xffff0000u), __uint_as_float(w[j].w << 16), __uint_as_float(w[j].w & 0xffff0000u)};
#pragma unroll
            for (int h = 0; h < 2; ++h) s += (v[j][h][0] * v[j][h][0] + v[j][h][1] * v[j][h][1]) + (v[j][h][2] * v[j][h][2] + v[j][h][3] * v[j][h][3]); }
        const float rs = 1.0f / sqrtf(wave_sum(s) * (1.0f / DM) + 1e-6f);
        GAS f32x4* yr = (GAS f32x4*)(out + (size_t)m * DM + 8 * lane);
#pragma unroll
        for (int j = 0; j < 4; ++j) { yr[128 * j] = v[j][0] * rs * g[j][0]; yr[128 * j + 1] = v[j][1] * rs * g[j][1]; }
    }
}

struct Args { const float* in[17]; float* out; unsigned char* ws; int pr_lo, pr_hi; };
template <int SITE> __global__ void __launch_bounds__(NWAVES * 64, 2) mk_fwd(Args args) {
    extern __shared__ __attribute__((aligned(16))) unsigned char lds[];
    Frame F;
    F.lds = (LAS unsigned char*)lds;
    F.MISC = (volatile LAS unsigned*)(F.lds + MISC_OFF);
    for (int u = threadIdx.x; u < (LDS_BYTES - RING_BYTES) / 4; u += NWAVES * 64) ((LAS unsigned*)(F.lds + RING_BYTES))[u] = 0u;
    __syncthreads();
    constexpr bool ALL = SITE < 0;
    const int wave0 = __builtin_amdgcn_readfirstlane(threadIdx.x >> 6);
    XcdBarrier bar; bar.bar = nullptr; bar.x = 0; bar.st = nullptr;
    if constexpr (ALL) { KARGS(); bar = xcd_barrier_post((unsigned*)(WSP() + WS_CTL) + CW_BAR, F.MISC + 8); }
#ifndef PHM
#define PHM 0xFFFF
#endif
#define ON(b) (((PHM >> (b)) & 1) && (ALL || SITE == (b)))
#define SEAM() do { if constexpr (ALL) { XcdBarrier b_ = bar; asm volatile("" : "+s"(b_.bar)); xcd_barrier(b_); } } while (0)
#define OTID(name) int name = (wave0 << 6) | opaque_lane(); asm volatile("" : "+v"(name))
#define SITE_IDS() KARGS(); OTID(otid); (void)otid; int bid = blockIdx.x, G = gridDim.x; asm volatile("" : "+s"(bid), "+s"(G)); const int vcu = (G % 8 == 0) ? (bid % 8) * (G / 8) + bid / 8 : bid; (void)vcu
    LAS char* const alds = (LAS char*)F.lds;

    if (ON(0)) { p0_prologue(F, wave0); } SEAM();

    for (int pr = args.pr_lo; pr < args.pr_hi; ++pr) {
        if (ON(1)) {
            SITE_IDS();
            unsigned char* const ws = WSP();
            pg8::Gemm g{(const bf16*)(ws + WS_XB), (const bf16*)(ws + WS_WQA + (size_t)pr * 24 * MiB), MPAD, 6144, 2048}; pg8::StaticOrder S; S.init(MPAD, 6144, G, bid);
            pg8::EpiQKV<false> E{ws, OUTP(), pr};
            pg8::gemm_phase<pg8::EpiQKV<false>, pg8::StaticOrder, true, true>(F.lds, g, S, E, otid);
        } SEAM();
        if (ON(2)) {
            SITE_IDS();
            unsigned char* const ws = WSP(); const bf16* const QB = (const bf16*)(ws + WS_Q); bf16* const OB = (bf16*)(ws + WS_O); const bf16* const KB = (const bf16*)(ws + WS_K); const bf16* const VB = (const bf16*)(ws + WS_V);
            const float* rel = FPTR(P_AREL) + (size_t)pr * 16 * 257;
            for (int su = vcu; su < 128; su += G)
                att::sample_attn_unit<128, 512, true>(otid, su >> 4, su & 15, QB, KB, VB, OB, FPTR(P_CAK) + (size_t)pr * 8 * 512 * 2048, FPTR(P_CAV) + (size_t)pr * 8 * 512 * 2048, rel + (su & 15) * 257, alds);
            OTID(otid2);
            for (int u = vcu; u < 2048; u += G) { const int bh = u >> 5, qb = u & 31;
                att::attnA_unit(otid2, bh >> 4, bh & 15, qb, QB, KB, VB, OB, rel + (bh & 15) * 257, alds); }
            __syncthreads();
        } SEAM();
        if (ON(3)) {
            SITE_IDS();
            unsigned char* const ws = WSP();
            pg8::Gemm g{(const bf16*)(ws + WS_O), (const bf16*)(ws + WS_WOA + (size_t)pr * 8 * MiB), MPAD, 2048, 2048}; pg8::StaticOrder S; S.init(MPAD, 2048, G, bid);
            pg8::EpiRes E{ws, 1};
            pg8::gemm_phase<pg8::EpiRes, pg8::StaticOrder, true, true>(F.lds, g, S, E, otid);
        } SEAM();
        if (ON(4)) {
            SITE_IDS();
            unsigned char* const ws = WSP();
            pg8::Gemm g{(const bf16*)(ws + WS_XB), (const bf16*)(ws + WS_WUP + (size_t)(2 * pr) * 32 * MiB), MPAD, 8192, 2048}; pg8::StaticOrder S; S.init(MPAD, 8192, G, bid);
            pg8::EpiUp E{ws};
            pg8::gemm_phase<pg8::EpiUp, pg8::StaticOrder, true, true>(F.lds, g, S, E, otid);
        } SEAM();
        if (ON(5)) {
            SITE_IDS();
            unsigned char* const ws = WSP();
            pg8::Gemm g{(const bf16*)(ws + WS_ACT), (const bf16*)(ws + WS_WDN + (size_t)(2 * pr) * 32 * MiB), MPAD, 2048, 8192}; pg8::StaticOrder S; S.init(MPAD, 2048, G, bid);
            pg8::EpiRes E{ws, 0};
            pg8::gemm_phase<pg8::EpiRes, pg8::StaticOrder, true, true>(F.lds, g, S, E, otid);
        } SEAM();
        if (ON(6)) {
            SITE_IDS();
            unsigned char* const ws = WSP();
            pg8::Gemm g{(const bf16*)(ws + WS_XB), (const bf16*)(ws + WS_WQB + (size_t)pr * 12 * MiB), MPAD, 3072, 2048}; pg8::StaticOrder S; S.init(MPAD, 3072, G, bid);
            pg8::EpiQKV<true> E{ws, OUTP(), pr};
            pg8::gemm_phase<pg8::EpiQKV<true>, pg8::StaticOrder, true, true>(F.lds, g, S, E, otid);
        } SEAM();
        if (ON(7)) {
            SITE_IDS();
            unsigned char* const ws = WSP(); const bf16* const QB = (const bf16*)(ws + WS_Q); bf16* const OB = (bf16*)(ws + WS_O); const bf16* const KB = (const bf16*)(ws + WS_K); const bf16* const VB = (const bf16*)(ws + WS_V);
            const float* sinks = FPTR(P_BSINK) + pr * 32;
            for (int su = vcu; su < 256; su += G)
                att::sample_attn_unit<64, 128, false>(otid, su >> 5, su & 31, QB, KB, VB, OB, FPTR(P_CBK) + (size_t)pr * 8 * 128 * 512, FPTR(P_CBV) + (size_t)pr * 8 * 128 * 512, sinks, alds);
            OTID(otid2);
            for (int u = vcu; u < 256; u += G) { const int bk = u >> 3, run = u & 7;
                att::attnB_unit(otid2, bk >> 3, bk & 7, run, QB, KB, VB, OB, sinks, alds); }
            __syncthreads();
        } SEAM();
        if (ON(8)) {
            SITE_IDS();
            unsigned char* const ws = WSP();
            pg8::Gemm g{(const bf16*)(ws + WS_O), (const bf16*)(ws + WS_WOB + (size_t)pr * 8 * MiB), MPAD, 2048, 2048}; pg8::StaticOrder S; S.init(MPAD, 2048, G, bid);
            pg8::EpiRes E{ws, 1};
            pg8::gemm_phase<pg8::EpiRes, pg8::StaticOrder, true, true>(F.lds, g, S, E, otid);
        } SEAM();
        if (ON(9)) {
            SITE_IDS();
            unsigned char* const ws = WSP();
            pg8::Gemm g{(const bf16*)(ws + WS_XB), (const bf16*)(ws + WS_WUP + (size_t)(2 * pr + 1) * 32 * MiB), MPAD, 8192, 2048}; pg8::StaticOrder S; S.init(MPAD, 8192, G, bid);
            pg8::EpiUp E{ws};
            pg8::gemm_phase<pg8::EpiUp, pg8::StaticOrder, true, true>(F.lds, g, S, E, otid);
        } SEAM();
        if (ON(10)) {
            SITE_IDS();
            unsigned char* const ws = WSP();
            pg8::Gemm g{(const bf16*)(ws + WS_ACT), (const bf16*)(ws + WS_WDN + (size_t)(2 * pr + 1) * 32 * MiB), MPAD, 2048, 8192}; pg8::StaticOrder S; S.init(MPAD, 2048, G, bid);
            pg8::EpiRes E{ws, 0};
            pg8::gemm_phase<pg8::EpiRes, pg8::StaticOrder, true, true>(F.lds, g, S, E, otid);
        } SEAM();
    }
    if (ON(11)) final_norm(F, wave0);
#undef ON
#undef SEAM
}

extern "C" void kernel_launch(void* const* d_in, const int* in_sizes, int n_in, void* d_out, int out_size, void* d_ws, size_t ws_size, hipStream_t stream) {
    static int grid = 0;
    if (grid == 0) {
        if (n_in != 17 || in_sizes[0] != MP * DM || (size_t)out_size != O_END || ws_size < WS_END) { fprintf(stderr, "kernel_launch: unexpected shapes (n_in %d, in0 %d, out %d, ws %zu)\n", n_in, n_in > 0 ? in_sizes[0] : -1, out_size, ws_size); grid = -1; return; }
        int dev = 0, cus = 0, per_cu = 0;
        if (hipGetDevice(&dev) != hipSuccess || hipDeviceGetAttribute(&cus, hipDeviceAttributeMultiprocessorCount, dev) != hipSuccess) { grid = -1; return; }
#if MK_ONE_LAUNCH
        if (hipFuncSetAttribute((const void*)mk_fwd<-1>, hipFuncAttributeMaxDynamicSharedMemorySize, LDS_BYTES) != hipSuccess) { fprintf(stderr, "kernel_launch: hipFuncSetAttribute failed\n"); grid = -1; return; }
        if (hipOccupancyMaxActiveBlocksPerMultiprocessor(&per_cu, (const void*)mk_fwd<-1>, NWAVES * 64, LDS_BYTES) != hipSuccess || per_cu < 1) { fprintf(stderr, "kernel_launch: occupancy query reports %d workgroups per CU\n", per_cu); grid = -1; return; }
#else
#define SETATTR(s) (hipFuncSetAttribute((const void*)mk_fwd<s>, hipFuncAttributeMaxDynamicSharedMemorySize, LDS_BYTES) == hipSuccess)
        if (!(SETATTR(0) && SETATTR(1) && SETATTR(2) && SETATTR(3) && SETATTR(4) && SETATTR(5) && SETATTR(6) && SETATTR(7) && SETATTR(8) && SETATTR(9) && SETATTR(10) && SETATTR(11))) { fprintf(stderr, "kernel_launch: hipFuncSetAttribute failed\n"); grid = -1; return; }
        per_cu = 1;
#endif
        (void)hipGetLastError();
        grid = cus;
    }
    if (grid < 0) return;
    if (hipMemsetAsync((char*)d_ws + WS_CTL, 0, CTL_ZERO_BYTES, stream) != hipSuccess) return;
    Args a{};
    for (int i = 0; i < 17; ++i) a.in[i] = (const float*)d_in[i];
    a.out = (float*)d_out; a.ws = (unsigned char*)d_ws;
#if MK_ONE_LAUNCH
    a.pr_lo = 0; a.pr_hi = 2;
    hipLaunchKernelGGL(mk_fwd<-1>, dim3(grid), dim3(NWAVES * 64), LDS_BYTES, stream, a);
#else
#define LAUNCH_SITE(s, p0, p1) do { a.pr_lo = (p0); a.pr_hi = (p1); hipLaunchKernelGGL(mk_fwd<s>, dim3(grid), dim3(NWAVES * 64), LDS_BYTES, stream, a); } while (0)
    LAUNCH_SITE(0, 0, 0);
    for (int p = 0; p < 2; ++p) { LAUNCH_SITE(1, p, p + 1); LAUNCH_SITE(2, p, p + 1); LAUNCH_SITE(3, p, p + 1); LAUNCH_SITE(4, p, p + 1); LAUNCH_SITE(5, p, p + 1);
                                  LAUNCH_SITE(6, p, p + 1); LAUNCH_SITE(7, p, p + 1); LAUNCH_SITE(8, p, p + 1); LAUNCH_SITE(9, p, p + 1); LAUNCH_SITE(10, p, p + 1); }
    LAUNCH_SITE(11, 0, 0);
#endif
    const hipError_t le = hipPeekAtLastError();
    if (le != hipSuccess) fprintf(stderr, "kernel_launch: launch failed: %s\n", hipGetErrorName(le));
}
```

```cpp
#include <hip/hip_runtime.h>
#include <cstdio>
#include <cstdint>
template <int K> __device__ __forceinline__ float xl_swz(float v) { return __builtin_bit_cast(float, __builtin_amdgcn_ds_swizzle(__builtin_bit_cast(int, v), (K << 10) | 0x1f)); }
__device__ __forceinline__ void xl_swap32(float& a, float& b) { asm volatile("s_nop 1\n\tv_permlane32_swap_b32 %0, %1" : "+v"(a), "+v"(b)); }
__device__ __forceinline__ float xl_add32(float v) { float a = v, b = v; xl_swap32(a, b); return a + b; }
__device__ __forceinline__ float xl_max32(float v) { float a = v, b = v; xl_swap32(a, b); return fmaxf(a, b); }
__device__ __forceinline__ float xl_wave_sum(float v) { v += xl_swz<1>(v); v += xl_swz<2>(v); v += xl_swz<4>(v); v += xl_swz<8>(v); v += xl_swz<16>(v); return xl_add32(v); }
__device__ __forceinline__ float xl_wave_max(float v) { v = fmaxf(v, xl_swz<1>(v)); v = fmaxf(v, xl_swz<2>(v)); v = fmaxf(v, xl_swz<4>(v)); v = fmaxf(v, xl_swz<8>(v)); v = fmaxf(v, xl_swz<16>(v)); return xl_max32(v); }
__host__ __device__ __forceinline__ size_t samp_toff(int r, int c) { return ((size_t)(((c >> 5) * 8 + (r >> 4)) * 64 + ((c >> 3) & 3) * 16 + (r & 15))) * 8 + (c & 7); }
namespace pg8 {
#define PG8_LAS __attribute__((address_space(3)))
typedef unsigned short bf16_t;
typedef short bf16x8 __attribute__((ext_vector_type(8)));
typedef float f32x4 __attribute__((ext_vector_type(4)));
typedef unsigned u32x4 __attribute__((ext_vector_type(4)));
constexpr int BM = 256, BK = 64, HALF = 128, HTB = HALF * BK * 2  , STAGE_BYTES = 8 * HTB, NXCD = 8, WGM = 8;

__host__ __device__ __forceinline__ int lds_byte(int r, int c) { const int st = (r >> 4) * 2 + (c >> 5), rr = r & 15, cc = c & 31, ob = rr * 64 + cc * 2; return st * 1024 + (ob ^ (((ob >> 9) & 1) << 5)); }
__host__ __device__ __forceinline__ void stage_rc(int b, int& R, int& C) { const int st = b / 1024, sb = b % 1024, swz = sb ^ (((sb >> 9) & 1) << 5); R = (st >> 1) * 16 + swz / 64; C = (st & 1) * 32 + (swz % 64) / 2; }
__host__ __device__ __forceinline__ int perm32(int rho) { const int n = rho >> 4, i = rho & 15; return 8 * (i >> 2) + 4 * n + (i & 3); }

struct Unit { int pm, pn; };
struct Gemm { const bf16_t* A; const bf16_t* Bt; int M, N, K; };

struct StaticOrder {
    int nM, nN, nwg, G, c, wgm, rev;
    __host__ __device__ void init(int M, int N, int G_, int c_, int wgm_ = WGM, int rev_ = 0) { nM = M / BM; nN = N / BM; nwg = nM * nN; G = G_; c = c_; wgm = wgm_; rev = rev_; }
    __host__ __device__ bool next(int i, Unit& u) const {
        const int nr = (nwg + G - 1) / G; if (i >= nr) return false; const long L = (long)(rev ? nr - 1 - i : i) * G + c; if (L >= nwg) return false;
        int wgid = (int)L; { const int q = nwg / NXCD, r = nwg % NXCD, xcd = wgid % NXCD, off = wgid / NXCD; wgid = (xcd < r ? xcd * (q + 1) : r * (q + 1) + (xcd - r) * q) + off; }
        const int nig = wgm * nN, gid = wgid / nig, fm = gid * wgm, gsz = (nM - fm) < wgm ? (nM - fm) : wgm;
        u.pm = fm + ((wgid % nig) % gsz); u.pn = (wgid % nig) / gsz; return true;
    }
    __device__ __forceinline__ void a_ready(const Unit&) const {}
    __device__ __forceinline__ void done(const Unit&) const {}
};

__device__ __forceinline__ unsigned cvt_pk_bf16(float lo, float hi) { unsigned r; asm volatile("v_cvt_pk_bf16_f32 %0, %1, %2" : "=v"(r) : "v"(lo), "v"(hi)); return r; }
typedef float f32x2 __attribute__((ext_vector_type(2)));
__device__ __forceinline__ float row_rstd(const float* SS, int row, int fq) {
    const f32x4* p = (const f32x4*)(SS + (size_t)row * 32 + fq * 8); const f32x4 a = p[0], b = p[1];
    float s = ((a[0] + a[1]) + (a[2] + a[3])) + ((b[0] + b[1]) + (b[2] + b[3]));
    s += xl_swz<16>(s); s = xl_add32(s);
    return __builtin_amdgcn_rsqf(s * (1.0f / 2048.0f) + 1e-6f);
}
constexpr int ROWS_P = 32768, ROWS_R = 32896;
constexpr size_t WS_XB_ = (size_t)361 << 20, WS_SS0_ = (size_t)490 << 20, WS_SS1_ = (size_t)495 << 20, WS_Q_ = (size_t)500 << 20, WS_K_ = (size_t)629 << 20, WS_V_ = (size_t)758 << 20;
template <bool ISB> struct EpiQKV {
    static constexpr bool PERM = true, AFTER_DRAIN = false;
    unsigned char* ws; float* out; int pr;
    __device__ __forceinline__ void operator()(const f32x4 (&acc)[2][2][4][2], const Unit& u, int wr, int wc, int fr, int fq) const {
        constexpr int nkv = ISB ? 512 : 2048;
        constexpr float qscale = (ISB ? 0.125f : 0.08838834764831845f) * 1.4426950408889634f;
        const float* SS = (const float*)(ws + WS_SS0_);
        const int colt = u.pn * BM; const int region = colt < 2048 ? 0 : (colt < 2048 + nkv ? 1 : 2);
        const int cbase = (region == 0 ? colt : (region == 1 ? colt - 2048 : colt - 2048 - nkv)) + wc * 32 + 8 * fq;
        bf16_t* const ob = (bf16_t*)(ws + (region == 0 ? WS_Q_ : (region == 1 ? WS_K_ : WS_V_))); const int ld = region == 0 ? 2048 : nkv;
        const float sc = region == 0 ? qscale : 1.0f;
#pragma unroll
        for (int ai = 0; ai < 2; ++ai)
#pragma unroll
            for (int m = 0; m < 4; ++m) {
                const int row = u.pm * BM + ai * HALF + wr * 64 + m * 16 + fr;
                const float rs = row_rstd(SS, row, fq) * sc;
#pragma unroll
                for (int bj = 0; bj < 2; ++bj) {
                    const f32x4 v0 = acc[ai][bj][m][0] * rs, v1 = acc[ai][bj][m][1] * rs; const int col = cbase + bj * HALF;
                    u32x4 w; w.x = cvt_pk_bf16(v0[0], v0[1]); w.y = cvt_pk_bf16(v0[2], v0[3]); w.z = cvt_pk_bf16(v1[0], v1[1]); w.w = cvt_pk_bf16(v1[2], v1[3]);
                    *(u32x4*)(ob + (size_t)row * ld + col) = w;
                }
            }
    }
};
__device__ __forceinline__ float bf_lo(unsigned w) { return __builtin_bit_cast(float, w << 16); }
__device__ __forceinline__ float bf_hi(unsigned w) { return __builtin_bit_cast(float, w & 0xffff0000u); }
struct EpiRes {
    static constexpr bool PERM = true, AFTER_DRAIN = false;
    unsigned char* ws; int sssel;
    __device__ __forceinline__ void operator()(const f32x4 (&acc)[2][2][4][2], const Unit& u, int wr, int wc, int fr, int fq) const {
        const int col0 = u.pn * BM + wc * 32 + 8 * fq; bf16_t* const XB = (bf16_t*)(ws + WS_XB_); float* const SSout = (float*)(ws + (sssel ? WS_SS1_ : WS_SS0_));
#pragma unroll
        for (int ai = 0; ai < 2; ++ai)
#pragma unroll
            for (int m = 0; m < 4; ++m) {
                const int row = u.pm * BM + ai * HALF + wr * 64 + m * 16 + fr;
                float ssq = 0.f;
#pragma unroll
                for (int bj = 0; bj < 2; ++bj) { u32x4* const px = (u32x4*)(XB + (size_t)row * 2048 + col0 + bj * HALF);
                    const u32x4 xo = *px; const f32x4 a0 = acc[ai][bj][m][0], a1 = acc[ai][bj][m][1];
                    u32x4 w; w.x = cvt_pk_bf16(bf_lo(xo.x) + a0[0], bf_hi(xo.x) + a0[1]); w.y = cvt_pk_bf16(bf_lo(xo.y) + a0[2], bf_hi(xo.y) + a0[3]);
                    w.z = cvt_pk_bf16(bf_lo(xo.z) + a1[0], bf_hi(xo.z) + a1[1]); w.w = cvt_pk_bf16(bf_lo(xo.w) + a1[2], bf_hi(xo.w) + a1[3]);
                    *px = w;
                    const float r0 = bf_lo(w.x), r1 = bf_hi(w.x), r2 = bf_lo(w.y), r3 = bf_hi(w.y), r4 = bf_lo(w.z), r5 = bf_hi(w.z), r6 = bf_lo(w.w), r7 = bf_hi(w.w);
                    ssq += ((r0 * r0 + r1 * r1) + (r2 * r2 + r3 * r3)) + ((r4 * r4 + r5 * r5) + (r6 * r6 + r7 * r7)); }
                ssq += xl_swz<16>(ssq); ssq = xl_add32(ssq);
                if (fq == 0) SSout[(size_t)row * 32 + u.pn * 4 + wc] = ssq;
            }
    }
};
struct EpiUp {
    static constexpr bool PERM = true, AFTER_DRAIN = false;
    unsigned char* ws;
    __device__ __forceinline__ void operator()(const f32x4 (&acc)[2][2][4][2], const Unit& u, int wr, int wc, int fr, int fq) const {
        const int col0 = u.pn * BM + wc * 32 + 8 * fq; bf16_t* const H = (bf16_t*)(ws + WS_Q_); const float* const SS = (const float*)(ws + WS_SS1_);
#pragma unroll
        for (int ai = 0; ai < 2; ++ai)
#pragma unroll
            for (int m = 0; m < 4; ++m) {
                const int row = u.pm * BM + ai * HALF + wr * 64 + m * 16 + fr;
                const float rs = row_rstd(SS, row, fq);
#pragma unroll
                for (int bj = 0; bj < 2; ++bj) {
                    f32x4 v0 = acc[ai][bj][m][0] * rs, v1 = acc[ai][bj][m][1] * rs;
#pragma unroll
                    for (int e = 0; e < 4; ++e) { const float a = fmaxf(v0[e], 0.f), b = fmaxf(v1[e], 0.f); v0[e] = a * a; v1[e] = b * b; }
                    u32x4 w; w.x = cvt_pk_bf16(v0[0], v0[1]); w.y = cvt_pk_bf16(v0[2], v0[3]); w.z = cvt_pk_bf16(v1[0], v1[1]); w.w = cvt_pk_bf16(v1[2], v1[3]);
                    { const int col = col0 + bj * HALF; __builtin_nontemporal_store(w, (u32x4*)(H + (size_t)(col >> 6) * ((size_t)ROWS_P * 64) + (size_t)row * 64 + (col & 63))); }
                }
            }
    }
};
struct Tail { unsigned* tk; unsigned* fc; volatile PG8_LAS unsigned* slot; unsigned* st; };
template <class Epi, class Sched, bool ALIGN_EPI = false, bool SP2 = false, bool ATILED = false>
__device__ __forceinline__ void gemm_phase(PG8_LAS unsigned char* lds, const Gemm g, const Sched& S, const Epi& E, const int tid_in, const Tail T);
template <class Epi, class Sched, bool ALIGN_EPI, bool SP2, bool ATILED>
__device__ __forceinline__ void gemm_phase(PG8_LAS unsigned char* lds, const Gemm g, const Sched& S, const Epi& E, const int tid_in, const Tail T) {
    int tid_ = tid_in; asm volatile("" : "+v"(tid_));
    const int tid = tid_, wid = __builtin_amdgcn_readfirstlane(tid >> 6), lane = tid & 63, wr = wid >> 2, wc = wid & 3, fr = lane & 15, fq = lane >> 4;
    const int K = g.K, nt = K / BK;
    unsigned voffA[2], voffB[2];
#pragma unroll
    for (int i = 0; i < 2; ++i) { int R, C; stage_rc(tid * 16 + i * 8192, R, C); const int Rb = Epi::PERM ? ((R & ~31) + perm32(R & 31)) : R;
        voffA[i] = ATILED ? (unsigned)(R * BK + C) * 2u : (unsigned)(R * K + C) * 2u; voffB[i] = (unsigned)(Rb * K + C) * 2u; }
    const size_t kstep = (size_t)(BK * 2);
    const size_t hstep = (size_t)HALF * K * 2;
    const size_t tstep = 2 * hstep;
    const size_t kstepA = ATILED ? (size_t)g.M * BK * 2 : kstep, hstepA = ATILED ? (size_t)HALF * BK * 2 : hstep, tstepA = 2 * hstepA;
    const unsigned ldsw = (unsigned)wid * 1024u;
    const int aoff = lds_byte(wr * 64 + fr, fq * 8), boff = lds_byte(wc * 32 + fr, fq * 8);
#define PG8_SA(b, h) (((b) * 2 + (h)) * HTB)
#define PG8_SB(b, h) ((4 + (b) * 2 + (h)) * HTB)
#define PG8_STAGE(bufoff, gbase, voff) do { _Pragma("unroll") for (int _i = 0; _i < 2; ++_i) \
        __builtin_amdgcn_global_load_lds((const unsigned*)((const char*)(gbase) + (voff)[_i]), (PG8_LAS unsigned*)(lds + (bufoff) + ldsw + _i * 8192), 16, 0, 0); } while (0)
#define PG8_LDA(dst, b, h) do { _Pragma("unroll") for (int m = 0; m < 4; ++m) _Pragma("unroll") for (int k = 0; k < 2; ++k) dst[m][k] = *(const PG8_LAS bf16x8*)(lds + PG8_SA(b, h) + aoff + m * 2048 + k * 1024); } while (0)
#define PG8_LDB(dst, b, h) do { _Pragma("unroll") for (int n = 0; n < 2; ++n) _Pragma("unroll") for (int k = 0; k < 2; ++k) dst[n][k] = *(const PG8_LAS bf16x8*)(lds + PG8_SB(b, h) + boff + n * 2048 + k * 1024); } while (0)
#define PG8_MMA(ai, bj, At, Bt) do { __builtin_amdgcn_s_setprio(1); _Pragma("unroll") for (int m = 0; m < 4; ++m) _Pragma("unroll") for (int n = 0; n < 2; ++n) _Pragma("unroll") for (int k = 0; k < 2; ++k) \
        acc[ai][bj][m][n] = __builtin_amdgcn_mfma_f32_16x16x32_bf16(Bt[n][k], At[m][k], acc[ai][bj][m][n], 0, 0, 0); __builtin_amdgcn_s_setprio(0); } while (0)
#define PG8_WAIT_V(n) asm volatile("s_waitcnt vmcnt(" #n ")" ::: "memory")
#define PG8_WAIT_L(n) asm volatile("s_waitcnt lgkmcnt(" #n ")" ::: "memory")
#define PG8_BAR __builtin_amdgcn_s_barrier()
#define PG8_SCHED __builtin_amdgcn_sched_barrier(0)
    Unit cur, nxt; int ui = 0;
    if (!S.next(0, cur)) return;
    f32x4 acc[2][2][4][2];
#pragma unroll
    for (int a = 0; a < 2; ++a)
#pragma unroll
        for (int b = 0; b < 2; ++b)
#pragma unroll
            for (int m = 0; m < 4; ++m)
#pragma unroll
                for (int n = 0; n < 2; ++n) acc[a][b][m][n] = (f32x4){0.f, 0.f, 0.f, 0.f};
    bf16x8 At[4][2], B0[2][2], B1[2][2];
    const char* cA = (const char*)g.A + (size_t)cur.pm * tstepA; const char* cB = (const char*)g.Bt + (size_t)cur.pn * tstep;
    S.a_ready(cur);
    if constexpr (SP2) {
        PG8_STAGE(PG8_SB(0, 0), cB, voffB); PG8_STAGE(PG8_SB(0, 1), cB + hstep, voffB); PG8_STAGE(PG8_SA(0, 0), cA, voffA); PG8_STAGE(PG8_SA(0, 1), cA + hstepA, voffA);
        if (wr == 1) PG8_BAR;
        PG8_WAIT_V(2); PG8_BAR;
        PG8_STAGE(PG8_SB(1, 0), cB + kstep, voffB); PG8_STAGE(PG8_SA(1, 0), cA + kstepA, voffA); PG8_STAGE(PG8_SB(1, 1), cB + hstep + kstep, voffB);
        PG8_WAIT_V(6); PG8_BAR;
    } else {
        PG8_STAGE(PG8_SB(0, 0), cB, voffB); PG8_STAGE(PG8_SA(0, 0), cA, voffA); PG8_STAGE(PG8_SB(0, 1), cB + hstep, voffB); PG8_STAGE(PG8_SA(0, 1), cA + hstepA, voffA);
        if (wr == 1) PG8_BAR;
        PG8_WAIT_V(4); PG8_BAR;
        PG8_STAGE(PG8_SB(1, 0), cB + kstep, voffB); PG8_STAGE(PG8_SA(1, 0), cA + kstepA, voffA); PG8_STAGE(PG8_SB(1, 1), cB + hstep + kstep, voffB);
        PG8_WAIT_V(6); PG8_BAR;
    }
    for (;;) {
        const bool has_next = S.next(ui + 1, nxt);
        const char* nA = has_next ? (const char*)g.A + (size_t)nxt.pm * tstepA : cA; const char* nB = has_next ? (const char*)g.Bt + (size_t)nxt.pn * tstep : cB;
        for (int t = 0; t < nt; t += 2) {
            const bool last = (t == nt - 2);
            const char* a1 = cA + (size_t)(t + 1) * kstepA;
            const char* a2 = last ? nA : cA + (size_t)(t + 2) * kstepA; const char* b2 = last ? nB : cB + (size_t)(t + 2) * kstep;
            const char* a3 = a2 + kstepA; const char* b3 = b2 + kstep;
            if (last && has_next) S.a_ready(nxt);
            if constexpr (SP2) {
            PG8_LDB(B0, 0, 0); PG8_LDB(B1, 0, 1); PG8_SCHED; PG8_LDA(At, 0, 0); PG8_STAGE(PG8_SA(1, 1), a1 + hstepA, voffA);
            PG8_WAIT_V(8); PG8_WAIT_L(0); PG8_BAR; PG8_MMA(0, 0, At, B0); PG8_MMA(0, 1, At, B1); PG8_BAR; PG8_SCHED;
            PG8_LDA(At, 0, 1); PG8_STAGE(PG8_SB(0, 0), b2, voffB); PG8_STAGE(PG8_SB(0, 1), b2 + hstep, voffB); PG8_STAGE(PG8_SA(0, 0), a2, voffA);
            PG8_WAIT_V(8); PG8_WAIT_L(0); PG8_BAR; PG8_MMA(1, 0, At, B0); PG8_MMA(1, 1, At, B1); PG8_BAR; PG8_SCHED;
            PG8_LDB(B0, 1, 0); PG8_LDB(B1, 1, 1); PG8_SCHED; PG8_LDA(At, 1, 0); PG8_STAGE(PG8_SA(0, 1), a2 + hstepA, voffA);
            PG8_WAIT_V(8); PG8_WAIT_L(0); PG8_BAR; PG8_MMA(0, 0, At, B0); PG8_MMA(0, 1, At, B1); PG8_BAR; PG8_SCHED;
            PG8_LDA(At, 1, 1); PG8_STAGE(PG8_SB(1, 0), b3, voffB); PG8_STAGE(PG8_SB(1, 1), b3 + hstep, voffB); PG8_STAGE(PG8_SA(1, 0), a3, voffA);
            PG8_WAIT_V(8); PG8_WAIT_L(0); PG8_BAR; PG8_MMA(1, 0, At, B0); PG8_MMA(1, 1, At, B1); PG8_BAR; PG8_SCHED;
            } else {
            PG8_LDB(B0, 0, 0); PG8_SCHED; PG8_LDA(At, 0, 0); PG8_STAGE(PG8_SA(1, 1), a1 + hstepA, voffA);
            PG8_WAIT_L(8); PG8_BAR; PG8_WAIT_L(0); PG8_MMA(0, 0, At, B0); PG8_BAR; PG8_SCHED;
            PG8_LDB(B1, 0, 1); PG8_STAGE(PG8_SB(0, 0), b2, voffB);
            PG8_BAR; PG8_WAIT_L(0); PG8_MMA(0, 1, At, B1); PG8_BAR;
            PG8_LDA(At, 0, 1); PG8_STAGE(PG8_SA(0, 0), a2, voffA);
            PG8_BAR; PG8_WAIT_L(0); PG8_MMA(1, 0, At, B0); PG8_BAR; PG8_SCHED;
            PG8_STAGE(PG8_SB(0, 1), b2 + hstep, voffB);
            PG8_WAIT_V(6); PG8_BAR; PG8_MMA(1, 1, At, B1); PG8_BAR;
            PG8_LDB(B0, 1, 0); PG8_SCHED; PG8_LDA(At, 1, 0); PG8_STAGE(PG8_SA(0, 1), a2 + hstepA, voffA);
            PG8_WAIT_L(8); PG8_BAR; PG8_WAIT_L(0); PG8_MMA(0, 0, At, B0); PG8_BAR; PG8_SCHED;
            PG8_LDB(B1, 1, 1); PG8_STAGE(PG8_SB(1, 0), b3, voffB);
            PG8_BAR; PG8_WAIT_L(0); PG8_MMA(0, 1, At, B1); PG8_BAR;
            PG8_LDA(At, 1, 1); PG8_STAGE(PG8_SA(1, 0), a3, voffA);
            PG8_BAR; PG8_WAIT_L(0); PG8_MMA(1, 0, At, B0); PG8_BAR; PG8_SCHED;
            PG8_STAGE(PG8_SB(1, 1), b3 + hstep, voffB);
            PG8_WAIT_V(6); PG8_BAR; PG8_MMA(1, 1, At, B1); PG8_BAR;
            }
        }
        if constexpr (ALIGN_EPI) { if (wr == 0) PG8_BAR; }
        unsigned tk1_ = 0u, fc1_ = 0u, st1_ = 0u;
        if (!has_next && tid == 0) { tk1_ = __hip_atomic_fetch_add((__attribute__((address_space(1))) unsigned*)T.tk, 1u, __ATOMIC_RELAXED, __HIP_MEMORY_SCOPE_AGENT); fc1_ = __hip_atomic_load((__attribute__((address_space(1))) unsigned*)T.fc, __ATOMIC_RELAXED, __HIP_MEMORY_SCOPE_AGENT);
            if (T.st) st1_ = __hip_atomic_load((__attribute__((address_space(1))) unsigned*)T.st, __ATOMIC_RELAXED, __HIP_MEMORY_SCOPE_AGENT); }
        if constexpr (!Epi::AFTER_DRAIN) { E(acc, cur, wr, wc, fr, fq); S.done(cur); }
        if (!has_next && tid == 0) { T.slot[0] = tk1_; T.slot[2] = fc1_; T.slot[3] = st1_; }
        if (!has_next) break;
#pragma unroll
        for (int a = 0; a < 2; ++a)
#pragma unroll
            for (int b = 0; b < 2; ++b)
#pragma unroll
                for (int m = 0; m < 4; ++m)
#pragma unroll
                    for (int n = 0; n < 2; ++n) acc[a][b][m][n] = (f32x4){0.f, 0.f, 0.f, 0.f};
        cur = nxt; cA = nA; cB = nB; ++ui;
        if constexpr (ALIGN_EPI) { if (wr == 1) PG8_BAR; }
    }
    PG8_WAIT_V(0);
    if constexpr (!ALIGN_EPI) { if (wr == 0) PG8_BAR; }
    PG8_BAR;
    if constexpr (Epi::AFTER_DRAIN) { E.fused(acc, cur, wr, wc, fr, fq, lds, wid, lane); S.done(cur); }
#undef PG8_SA
#undef PG8_SB
#undef PG8_STAGE
#undef PG8_LDA
#undef PG8_LDB
#undef PG8_MMA
#undef PG8_WAIT_V
#undef PG8_WAIT_L
#undef PG8_BAR
#undef PG8_SCHED
}
}
namespace att {
using bf16 = unsigned short;
using bf16x8 = __attribute__((ext_vector_type(8))) short;
using s16x4  = __attribute__((ext_vector_type(4))) short;
using f32x16 = __attribute__((ext_vector_type(16))) float;
using f32x4v = __attribute__((ext_vector_type(4))) float;
using u32x4  = __attribute__((ext_vector_type(4))) unsigned;
using u32x2  = __attribute__((ext_vector_type(2))) unsigned;
#define ALAS __attribute__((address_space(3)))
#define SBAR() __builtin_amdgcn_sched_barrier(0)
constexpr float LOG2E = 1.4426950408889634f;
constexpr float THR2 = 10.0f;
__device__ __forceinline__ int crow(int r, int hi) { return (r & 3) + 8 * (r >> 2) + 4 * hi; }
__device__ __forceinline__ unsigned cvtpk(float lo, float hi) { unsigned r; asm volatile("v_cvt_pk_bf16_f32 %0, %1, %2" : "=v"(r) : "v"(lo), "v"(hi)); return r; }
__device__ __forceinline__ float bf2f(unsigned short h) { return __uint_as_float((unsigned)h << 16); }
template <int HD> __device__ __forceinline__ int kswz(int row, int colB) {
    if constexpr (HD == 128) return row * 256 + (colB ^ ((row & 15) << 4));
    else return row * 128 + (colB ^ (((row >> 1) & 7) << 4));
}
template <int HD> __device__ __forceinline__ void qkt(f32x16& p0, f32x16& p1, const ALAS char* Ks, const bf16x8* qr, int r32, int hi) {
    p0 = f32x16{}; p1 = f32x16{};
#pragma unroll
    for (int d0 = 0; d0 < HD / 16; ++d0) { const int cb = (d0 * 16 + hi * 8) * 2;
        const bf16x8 b0 = *(const ALAS bf16x8*)(Ks + kswz<HD>(r32, cb));
        const bf16x8 b1 = *(const ALAS bf16x8*)(Ks + kswz<HD>(32 + r32, cb));
        p0 = __builtin_amdgcn_mfma_f32_32x32x16_bf16(b0, qr[d0], p0, 0, 0, 0);
        p1 = __builtin_amdgcn_mfma_f32_32x32x16_bf16(b1, qr[d0], p1, 0, 0, 0); }
}
template <int NCB> __device__ __forceinline__ int v_st(int k, int c) { const int kk = (k & ~0xC) | ((k & 4) << 1) | ((k & 8) >> 1); return ((kk >> 3) * NCB + (c >> 5)) * 512 + ((kk & 7) * 32 + (c & 31)) * 2; }
__device__ __forceinline__ int v_rd_base(int lane) { return ((lane & 3) << 3) | (((lane >> 2) & 3) << 6) | (((lane >> 4) & 1) << 5) | (((lane >> 5) & 1) << 8); }
template <int NCB> constexpr int v_rd_off(int d0, int ks, int half) { return d0 * 512 + ks * (NCB * 1024) + half * (NCB * 512); }
template <int OFF> __device__ __forceinline__ s16x4 tr_read(int vb) { s16x4 r; asm volatile("ds_read_b64_tr_b16 %0, %1 offset:%2" : "=&v"(r) : "v"(vb), "i"(OFF) : "memory"); return r; }
template <int NCB, int D0> __device__ __forceinline__ void pv_one(f32x16& od, int vb, bf16x8 pa0, bf16x8 pa1, bf16x8 pa2, bf16x8 pa3) {
    const s16x4 l0 = tr_read<v_rd_off<NCB>(D0, 0, 0)>(vb), h0 = tr_read<v_rd_off<NCB>(D0, 0, 1)>(vb), l1 = tr_read<v_rd_off<NCB>(D0, 1, 0)>(vb), h1 = tr_read<v_rd_off<NCB>(D0, 1, 1)>(vb);
    const s16x4 l2 = tr_read<v_rd_off<NCB>(D0, 2, 0)>(vb), h2 = tr_read<v_rd_off<NCB>(D0, 2, 1)>(vb), l3 = tr_read<v_rd_off<NCB>(D0, 3, 0)>(vb), h3 = tr_read<v_rd_off<NCB>(D0, 3, 1)>(vb);
    asm volatile("s_waitcnt lgkmcnt(0)" ::: "memory"); SBAR();
#define PK(L, H) (bf16x8){L[0], L[1], L[2], L[3], H[0], H[1], H[2], H[3]}
    od = __builtin_amdgcn_mfma_f32_32x32x16_bf16(pa0, PK(l0, h0), od, 0, 0, 0);
    od = __builtin_amdgcn_mfma_f32_32x32x16_bf16(pa1, PK(l1, h1), od, 0, 0, 0);
    od = __builtin_amdgcn_mfma_f32_32x32x16_bf16(pa2, PK(l2, h2), od, 0, 0, 0);
    od = __builtin_amdgcn_mfma_f32_32x32x16_bf16(pa3, PK(l3, h3), od, 0, 0, 0);
#undef PK
}
__device__ __forceinline__ void softmax_tile(f32x16& p0, f32x16& p1, float& m_reg, float& l_reg, float& alpha, bf16x8& pa0, bf16x8& pa1, bf16x8& pa2, bf16x8& pa3) {
    float pmax = p0[0];
#pragma unroll
    for (int r = 1; r < 16; ++r) pmax = fmaxf(pmax, p0[r]);
#pragma unroll
    for (int r = 0; r < 16; ++r) pmax = fmaxf(pmax, p1[r]);
    { auto rr = __builtin_amdgcn_permlane32_swap(__float_as_uint(pmax), __float_as_uint(pmax), false, false); pmax = fmaxf(__uint_as_float(rr[0]), __uint_as_float(rr[1])); }
    if (__all(pmax - m_reg <= THR2)) { alpha = 1.f; }
    else { const float mn = fmaxf(m_reg, pmax); alpha = __builtin_amdgcn_exp2f(m_reg - mn); m_reg = mn; }
    float ps = 0.f;
#pragma unroll
    for (int r = 0; r < 16; ++r) { p0[r] = __builtin_amdgcn_exp2f(p0[r] - m_reg); p1[r] = __builtin_amdgcn_exp2f(p1[r] - m_reg); }
#pragma unroll
    for (int r = 0; r < 16; ++r) ps += p0[r];
#pragma unroll
    for (int r = 0; r < 16; ++r) ps += p1[r];
    { auto rr = __builtin_amdgcn_permlane32_swap(__float_as_uint(ps), __float_as_uint(ps), false, false); ps = __uint_as_float(rr[0]) + __uint_as_float(rr[1]); }
    l_reg = l_reg * alpha + ps;
#define PK4(P, BASE, OUT) do { unsigned a0 = cvtpk(P[BASE + 0], P[BASE + 1]), a1 = cvtpk(P[BASE + 2], P[BASE + 3]);   \
    unsigned b0 = cvtpk(P[BASE + 4], P[BASE + 5]), b1 = cvtpk(P[BASE + 6], P[BASE + 7]);                              \
    auto r0 = __builtin_amdgcn_permlane32_swap(a0, b0, false, false); auto r1 = __builtin_amdgcn_permlane32_swap(a1, b1, false, false); \
    u32x4 w = {r0[0], r1[0], r0[1], r1[1]}; OUT = __builtin_bit_cast(bf16x8, w); } while (0)
    PK4(p0, 0, pa0); PK4(p0, 8, pa1); PK4(p1, 0, pa2); PK4(p1, 8, pa3);
#undef PK4
}
template <int NB> __device__ __forceinline__ void rescale_o(f32x16* o, float alpha, ALAS float* al_l, int r32, int hi) {
    if (__any(alpha < 1.f && alpha > 0.f)) {
        if (hi == 0) al_l[r32] = alpha;
        asm volatile("s_waitcnt lgkmcnt(0)" ::: "memory");
#pragma unroll
        for (int r = 0; r < 16; ++r) { const float a = al_l[crow(r, hi)];
#pragma unroll
            for (int d = 0; d < NB; ++d) o[d][r] *= a; }
        asm volatile("s_waitcnt lgkmcnt(0)" ::: "memory");
    }
}
template <int NB> __device__ __forceinline__ void store_o(const f32x16* o, float l_tot, ALAS float* li_l, ALAS char* stg, bf16* Ow, int lane, int r32, int hi) {
    if (hi == 0) li_l[r32] = l_tot;
    asm volatile("s_waitcnt lgkmcnt(0)" ::: "memory");
#pragma unroll
    for (int r = 0; r < 16; ++r) { const int orow = crow(r, hi); const float rl = __builtin_amdgcn_rcpf(li_l[orow]);
#pragma unroll
        for (int d0 = 0; d0 < NB; ++d0) { const unsigned w = cvtpk(o[d0][r] * rl, 0.f); *(ALAS unsigned short*)(stg + orow * (64 * NB) + (d0 * 32 + r32) * 2) = (unsigned short)(w & 0xffffu); } }
    asm volatile("s_waitcnt lgkmcnt(0)" ::: "memory");
    constexpr int CPR = 4 * NB, RPI = 64 / CPR;
#pragma unroll
    for (int i = 0; i < 32 / RPI; ++i) { const int row = i * RPI + lane / CPR, ch = lane % CPR;
        const u32x4 v = *(const ALAS u32x4*)(stg + row * (64 * NB) + ch * 16); *(u32x4*)(Ow + (size_t)row * 2048 + ch * 8) = v; }
    asm volatile("s_waitcnt lgkmcnt(0)" ::: "memory");
}

constexpr int ATTA_LDS = 98304 + 2048 + 1040;
__device__ __forceinline__ void attnA_unit(const int tid, int b, int h, int qb, const bf16* Qb, const bf16* Kb, const bf16* Vb, bf16* Ob, const float* tabsrc, ALAS char* lds) {
    constexpr int HD = 128, LD = 2048, TB = 16384;
    const int lane = tid & 63, r32 = lane & 31, hi = lane >> 5; const int wid = __builtin_amdgcn_readfirstlane(tid >> 6);
    ALAS char* V_lds = lds; ALAS char* K_lds = lds + 3 * TB;
    ALAS float* wsf = (ALAS float*)(lds + 6 * TB) + wid * 64; ALAS float* tab = (ALAS float*)(lds + 6 * TB + 2048);
    if (tid < 257) tab[tid] = tabsrc[tid] * LOG2E;
    const int c0 = qb * 4, co = wid >> 1, c = c0 + co, rh = wid & 1;
    const size_t rowbase = (size_t)b * 8192;
    const bf16* Qw = Qb + (rowbase + c * 64 + rh * 32 + r32) * LD + h * HD + hi * 8;
    bf16x8 qr[8];
#pragma unroll
    for (int d0 = 0; d0 < 8; ++d0) qr[d0] = *(const bf16x8*)(Qw + d0 * 16);
    const int kc_lo = c0 - 8 > 0 ? c0 - 8 : 0, NT = c0 + 3 - kc_lo + 1;
    const int my_lo = c - 8 > 0 ? c - 8 : 0, my_hi = c;
    const int krow = 4 * wid + (lane >> 4), kchunk = (lane & 15) ^ (krow & 15);
    const int vkk = (wid >> 1) * 8 + ((lane & 31) >> 2), vkey = (vkk & ~0xC) | ((vkk & 4) << 1) | ((vkk & 8) >> 1), vcol = (2 * (wid & 1) + (lane >> 5)) * 32 + (lane & 3) * 8;
    const bf16* Kh = Kb + rowbase * LD + h * HD + (size_t)krow * LD + kchunk * 8; const bf16* Vh = Vb + rowbase * LD + h * HD + (size_t)vkey * LD + vcol;
    const int vb0 = (int)(unsigned)(uintptr_t)V_lds + v_rd_base(lane);
#define SDMA(kc, bf) do { const size_t o_ = (size_t)(kc) * 64 * LD; \
        __builtin_amdgcn_global_load_lds((const unsigned*)(Kh + o_), (ALAS unsigned*)(K_lds + (bf) * TB + wid * 1024), 16, 0, 0); \
        __builtin_amdgcn_global_load_lds((const unsigned*)(Kh + o_ + 32 * LD), (ALAS unsigned*)(K_lds + (bf) * TB + (wid + 8) * 1024), 16, 0, 0); \
        __builtin_amdgcn_global_load_lds((const unsigned*)(Vh + o_), (ALAS unsigned*)(V_lds + (bf) * TB + wid * 1024), 16, 0, 0); \
        __builtin_amdgcn_global_load_lds((const unsigned*)(Vh + o_ + 32 * LD), (ALAS unsigned*)(V_lds + (bf) * TB + (wid + 8) * 1024), 16, 0, 0); } while (0)
    float m_reg = -1e30f, l_reg = 0.f; f32x16 o[4] = {f32x16{}, f32x16{}, f32x16{}, f32x16{}};
    const int qloc = rh * 32 + r32;
    SDMA(kc_lo, 0); if (NT > 1) { SDMA(kc_lo + 1, 1); asm volatile("s_waitcnt vmcnt(4)" ::: "memory"); } else { asm volatile("s_waitcnt vmcnt(0)" ::: "memory"); }
    __syncthreads();
    int cur = 0;
    for (int t = 0; t < NT; ++t) {
        const int kc = kc_lo + t; const int nx2 = cur == 0 ? 2 : cur - 1;
        if (t + 2 < NT) SDMA(kc + 2, nx2);
        if (kc >= my_lo && kc <= my_hi) {
            f32x16 p0, p1; qkt<HD>(p0, p1, K_lds + cur * TB, qr, r32, hi);
            const int dc = kc - c;
            if (dc <= -3) { const float bb = tab[0];
#pragma unroll
                for (int r = 0; r < 16; ++r) { p0[r] += bb; p1[r] += bb; } }
            else { const int base = (dc + 2) * 64 - qloc + 4 * hi;
#pragma unroll
                for (int r = 0; r < 16; ++r) { const int i0 = base + (r & 3) + 8 * (r >> 2), i1 = i0 + 32; p0[r] += tab[i0 > 0 ? i0 : 0]; p1[r] += tab[i1 > 0 ? i1 : 0]; } }
            float alpha; bf16x8 pa0, pa1, pa2, pa3;
            softmax_tile(p0, p1, m_reg, l_reg, alpha, pa0, pa1, pa2, pa3);
            rescale_o<4>(o, alpha, wsf, r32, hi);
            const int vb = vb0 + cur * TB;
            pv_one<4, 0>(o[0], vb, pa0, pa1, pa2, pa3); pv_one<4, 1>(o[1], vb, pa0, pa1, pa2, pa3); pv_one<4, 2>(o[2], vb, pa0, pa1, pa2, pa3); pv_one<4, 3>(o[3], vb, pa0, pa1, pa2, pa3);
        }
        if (t + 2 < NT) { asm volatile("s_waitcnt vmcnt(4)" ::: "memory"); } else { asm volatile("s_waitcnt vmcnt(0)" ::: "memory"); }
        __syncthreads();
        cur = cur == 2 ? 0 : cur + 1;
    }
#undef SDMA
    store_o<4>(o, l_reg, wsf, lds + wid * 8192, Ob + (rowbase + c * 64 + rh * 32) * LD + h * HD, lane, r32, hi);
    asm volatile("s_waitcnt lgkmcnt(0)" ::: "memory");
    __builtin_amdgcn_s_barrier();
    asm volatile("" ::: "memory");
}

constexpr int ATTB_RC = 16, ATTB_LDS = 65536 + 2048 + 32768;
__device__ __forceinline__ void attnB_unit(const int tid, int b, int kvh, int run, const bf16* Qb, const bf16* Kb, const bf16* Vb, bf16* Ob, const float* sinks, ALAS char* lds) {
    constexpr int HD = 64, LDQ = 2048, LDK = 512, TB = 8192;
    const int lane = tid & 63, r32 = lane & 31, hi = lane >> 5; const int wid = __builtin_amdgcn_readfirstlane(tid >> 6);
    ALAS char* K_lds = lds; ALAS char* V_lds = lds + 4 * TB; ALAS float* wsf = (ALAS float*)(lds + 8 * TB) + wid * 64;
    const int qh = kvh * 4 + (wid >> 1), rh = wid & 1;
    const float slope2 = __builtin_amdgcn_exp2f(-0.25f * (float)(qh + 1)) * LOG2E, sink2 = sinks[qh] * LOG2E;
    const size_t rowbase = (size_t)b * 8192;
    const int krow = 8 * wid + (lane >> 3), kchunk = (lane & 7) ^ ((krow >> 1) & 7);
    const int vkk = wid * 8 + ((lane & 31) >> 2), vkey = (vkk & ~0xC) | ((vkk & 4) << 1) | ((vkk & 8) >> 1), vcol = (lane >> 5) * 32 + (lane & 3) * 8;
    const bf16* Kh = Kb + (rowbase + krow) * LDK + kvh * HD + kchunk * 8; const bf16* Vh = Vb + (rowbase + vkey) * LDK + kvh * HD + vcol;
    const int vb0 = (int)(unsigned)(uintptr_t)V_lds + v_rd_base(lane);
    const int c_first = run * ATTB_RC, c_last = c_first + ATTB_RC - 1;
#define SDMA(kc) do { __builtin_amdgcn_global_load_lds((const unsigned*)(Kh + (size_t)(kc) * 64 * LDK), (ALAS unsigned*)(K_lds + ((kc) & 3) * TB + wid * 1024), 16, 0, 0); \
        __builtin_amdgcn_global_load_lds((const unsigned*)(Vh + (size_t)(kc) * 64 * LDK), (ALAS unsigned*)(V_lds + ((kc) & 3) * TB + wid * 1024), 16, 0, 0); } while (0)
    for (int kc = (c_first - 2 > 0 ? c_first - 2 : 0); kc <= c_first; ++kc) SDMA(kc);
    const bf16* Qw = Qb + (rowbase + rh * 32 + r32) * LDQ + qh * HD + hi * 8;
    bf16x8 qr[4], qn[4];
#pragma unroll
    for (int d0 = 0; d0 < 4; ++d0) qr[d0] = *(const bf16x8*)(Qw + (size_t)c_first * 64 * LDQ + d0 * 16);
    asm volatile("s_waitcnt vmcnt(0)" ::: "memory"); __syncthreads();
    const int qloc = rh * 32 + r32;
    for (int c = c_first; c <= c_last; ++c) {
        const bool more = c < c_last;
        if (more) { SDMA(c + 1);
#pragma unroll
            for (int d0 = 0; d0 < 4; ++d0) qn[d0] = *(const bf16x8*)(Qw + (size_t)(c + 1) * 64 * LDQ + d0 * 16); }
        float m_reg = -1e30f, l_reg = 0.f; f32x16 o[2] = {f32x16{}, f32x16{}};
        for (int kc = (c - 2 > 0 ? c - 2 : 0); kc <= c; ++kc) {
            const int slot = kc & 3;
            f32x16 p0, p1; qkt<HD>(p0, p1, K_lds + slot * TB, qr, r32, hi);
            const int base = (kc - c) * 64 - qloc + 4 * hi;
#pragma unroll
            for (int r = 0; r < 16; ++r) { const int i0 = base + (r & 3) + 8 * (r >> 2); p0[r] -= slope2 * fabsf((float)i0); p1[r] -= slope2 * fabsf((float)(i0 + 32)); }
            float alpha; bf16x8 pa0, pa1, pa2, pa3;
            softmax_tile(p0, p1, m_reg, l_reg, alpha, pa0, pa1, pa2, pa3);
            rescale_o<2>(o, alpha, wsf, r32, hi);
            const int vb = vb0 + slot * TB;
            pv_one<2, 0>(o[0], vb, pa0, pa1, pa2, pa3); pv_one<2, 1>(o[1], vb, pa0, pa1, pa2, pa3);
        }
        if (more) {
#pragma unroll
            for (int d0 = 0; d0 < 4; ++d0) qr[d0] = qn[d0]; }
        const float l_tot = l_reg + __builtin_amdgcn_exp2f(sink2 - m_reg);
        store_o<2>(o, l_tot, wsf, lds + 8 * TB + 2048 + wid * 4096, Ob + (rowbase + (size_t)c * 64 + rh * 32) * LDQ + qh * HD, lane, r32, hi);
        asm volatile("s_waitcnt vmcnt(4) lgkmcnt(0)" ::: "memory");
        __builtin_amdgcn_s_barrier();
        asm volatile("" ::: "memory");
    }
#undef SDMA
}

template <int HD, int CL, bool ISA>
__device__ __forceinline__ void sample_attn_unit(const int tid, int sb, int qh, const bf16* Qb, const bf16* Kb, const bf16* Vb, bf16* Ob, const float* cache_k, const float* cache_v, const float* aux, ALAS char* lds) {
    constexpr int NK = CL + 16, NKP = NK + 1, KVW = ISA ? 2048 : 512, PAST = 1024;
    const int lane = tid & 63; const int wid = __builtin_amdgcn_readfirstlane(tid >> 6);
    const int kvh = ISA ? qh : (qh >> 2);
    ALAS float* qs = (ALAS float*)lds; ALAS float* S = qs + 16 * HD; ALAS float* inv = S + 16 * NKP;
    const size_t row0 = 32768 + (size_t)sb * 16;
    for (int i = tid; i < 16 * HD; i += 512) { const int j = i / HD, d = i % HD; qs[i] = bf2f(Qb[(row0 + j) * 2048 + qh * HD + d]); }
    __syncthreads();
    const float slope2 = __builtin_amdgcn_exp2f(-0.25f * (float)(qh + 1)) * LOG2E;
    for (int k = tid; k < NK; k += 512) {
        float acc[16];
#pragma unroll
        for (int j = 0; j < 16; ++j) acc[j] = 0.f;
        if (k < CL) { const float* kp = cache_k + ((size_t)sb * CL + k) * KVW + kvh * HD;
#pragma unroll 8
            for (int d4 = 0; d4 < HD / 4; ++d4) { const f32x4v kv = *(const f32x4v*)(kp + d4 * 4);
#pragma unroll
                for (int j = 0; j < 16; ++j) { const f32x4v q4 = *(const ALAS f32x4v*)(qs + j * HD + d4 * 4); acc[j] += (kv[0] * q4[0] + kv[1] * q4[1]) + (kv[2] * q4[2] + kv[3] * q4[3]); } } }
        else { const bf16* kp = Kb + (row0 + (k - CL)) * KVW + kvh * HD;
#pragma unroll 2
            for (int d4 = 0; d4 < HD / 4; ++d4) { const u32x2 kw = *(const u32x2*)(kp + d4 * 4);
                const float k0 = __uint_as_float(kw[0] << 16), k1 = __uint_as_float(kw[0] & 0xffff0000u), k2 = __uint_as_float(kw[1] << 16), k3 = __uint_as_float(kw[1] & 0xffff0000u);
#pragma unroll
                for (int j = 0; j < 16; ++j) { const f32x4v q4 = *(const ALAS f32x4v*)(qs + j * HD + d4 * 4); acc[j] += (k0 * q4[0] + k1 * q4[1]) + (k2 * q4[2] + k3 * q4[3]); } } }
        const int kpos = k < CL ? PAST - CL + k : PAST + (k - CL);
#pragma unroll
        for (int j = 0; j < 16; ++j) { const int rel = kpos - (PAST + j); float bias;
            if constexpr (ISA) { int idx = rel < -128 ? -128 : (rel > 128 ? 128 : rel); bias = aux[idx + 128] * LOG2E; } else { bias = -slope2 * fabsf((float)rel); }
            S[j * NKP + k] = acc[j] + bias; }
    }
    __syncthreads();
#pragma unroll
    for (int jj = 0; jj < 2; ++jj) { const int j = 2 * wid + jj;
        float m = -1e30f; for (int k = lane; k < NK; k += 64) m = fmaxf(m, S[j * NKP + k]);
        m = xl_wave_max(m);
        float s = 0.f; for (int k = lane; k < NK; k += 64) { const float e = __builtin_amdgcn_exp2f(S[j * NKP + k] - m); S[j * NKP + k] = e; s += e; }
        s = xl_wave_sum(s);
        if constexpr (!ISA) s += __builtin_amdgcn_exp2f(aux[qh] * LOG2E - m);
        if (lane == 0) inv[j] = 1.0f / s; }
    __syncthreads();
    constexpr int TPR = HD / 4, RG = 64 / TPR, RPL = 16 / RG, KPW = (NK + 7) / 8;
    ALAS float* red = (ALAS float*)(lds + 49152);
    { const int d4 = (lane & (TPR - 1)) * 4, rg = lane / TPR; f32x4v acc[RPL];
#pragma unroll
        for (int r = 0; r < RPL; ++r) acc[r] = (f32x4v){0.f, 0.f, 0.f, 0.f};
        const int k0 = wid * KPW, k1 = (k0 + KPW < NK) ? k0 + KPW : NK;
        const float* vp = cache_v + (size_t)sb * CL * KVW + kvh * HD + d4; const bf16* vn = Vb + row0 * KVW + kvh * HD + d4;
        const ALAS float* Sp = S + (rg * RPL) * NKP;
#pragma unroll 6
        for (int k = k0; k < k1; ++k) { f32x4v v4;
            if (k < CL) v4 = *(const f32x4v*)(vp + (size_t)k * KVW);
            else { const u32x2 vw = *(const u32x2*)(vn + (size_t)(k - CL) * KVW); v4 = (f32x4v){__uint_as_float(vw[0] << 16), __uint_as_float(vw[0] & 0xffff0000u), __uint_as_float(vw[1] << 16), __uint_as_float(vw[1] & 0xffff0000u)}; }
#pragma unroll
            for (int r = 0; r < RPL; ++r) acc[r] = acc[r] + v4 * Sp[r * NKP + k]; }
#pragma unroll
        for (int r = 0; r < RPL; ++r) *(ALAS f32x4v*)(red + (wid * 16 + rg * RPL + r) * HD + d4) = acc[r]; }
    __syncthreads();
    if (tid < 16 * TPR) { const int j = tid / TPR, d4 = (tid % TPR) * 4; f32x4v o = {0.f, 0.f, 0.f, 0.f};
#pragma unroll
        for (int w = 0; w < 8; ++w) o = o + *(const ALAS f32x4v*)(red + (w * 16 + j) * HD + d4);
        const float il = inv[j]; u32x2 w; w[0] = cvtpk(o[0] * il, o[1] * il); w[1] = cvtpk(o[2] * il, o[3] * il);
        *(u32x2*)(Ob + samp_toff(sb * 16 + j, qh * HD + d4)) = w; }
    __syncthreads();
}
#undef SBAR
#undef ALAS
}
namespace mini {
typedef unsigned short bf16_t;
typedef short bf16x8 __attribute__((ext_vector_type(8)));
typedef float f32x4 __attribute__((ext_vector_type(4)));
typedef unsigned u32x4 __attribute__((ext_vector_type(4)));
#define MLAS __attribute__((address_space(3)))
constexpr int SROW0 = 32768;
constexpr size_t WS_SSS_ = ((size_t)499 << 20) + (512 << 10), WS_Q_ = (size_t)500 << 20, WS_K_ = (size_t)629 << 20, WS_V_ = (size_t)758 << 20;
constexpr size_t WS_XBS_ = (size_t)1016 << 20, WS_OS_ = WS_XBS_ + (512 << 10), WS_HS_ = (size_t)1017 << 20;
__host__ __device__ __forceinline__ size_t toff(int r, int c) { return samp_toff(r, c); }
__device__ __forceinline__ unsigned cvt_pk_bf16(float lo, float hi) { unsigned r; asm volatile("v_cvt_pk_bf16_f32 %0, %1, %2" : "=v"(r) : "v"(lo), "v"(hi)); return r; }
__device__ __forceinline__ float bf_lo(unsigned w) { return __builtin_bit_cast(float, w << 16); }
__device__ __forceinline__ float bf_hi(unsigned w) { return __builtin_bit_cast(float, w & 0xffff0000u); }
__device__ __forceinline__ float srow_rstd(const unsigned char* ws, int sel, int r) {
    const f32x4* p = (const f32x4*)(ws + WS_SSS_) + (size_t)(sel * 128 + r) * 32; float s = 0.f;
#pragma unroll
    for (int q = 0; q < 32; ++q) { const f32x4 t = p[q]; s += (t[0] + t[1]) + (t[2] + t[3]); }
    return __builtin_amdgcn_rsqf(s * (1.0f / 2048.0f) + 1e-6f);
}
template <bool ISB> struct EpiQKV {
    unsigned char* ws; float* out; int pr;
    __device__ __forceinline__ void operator()(int r, int col, const float (&v)[8]) const {
        constexpr int nkv = ISB ? 512 : 2048, CL = ISB ? 128 : 512;
        constexpr float qscale = (ISB ? 0.125f : 0.08838834764831845f) * 1.4426950408889634f;
        constexpr size_t OKS = ISB ? 118751232 : 85196800, OVS = ISB ? 119799808 : 101974016;
        const int region = col < 2048 ? 0 : (col < 2048 + nkv ? 1 : 2);
        const float rs = srow_rstd(ws, 0, r) * (region == 0 ? qscale : 1.0f);
        const int c = region == 0 ? col : (region == 1 ? col - 2048 : col - 2048 - nkv), ld = region == 0 ? 2048 : nkv;
        bf16_t* const ob = (bf16_t*)(ws + (region == 0 ? WS_Q_ : (region == 1 ? WS_K_ : WS_V_)));
        float x[8];
#pragma unroll
        for (int e = 0; e < 8; ++e) x[e] = v[e] * rs;
        u32x4 w; w.x = cvt_pk_bf16(x[0], x[1]); w.y = cvt_pk_bf16(x[2], x[3]); w.z = cvt_pk_bf16(x[4], x[5]); w.w = cvt_pk_bf16(x[6], x[7]);
        *(u32x4*)(ob + (size_t)(SROW0 + r) * ld + c) = w;
        if (region != 0) { float* d = out + (region == 1 ? OKS : OVS) + (size_t)pr * 8 * CL * nkv + (size_t)((r >> 4) * CL + (CL - 16 + (r & 15))) * nkv + c;
            *(f32x4*)d = (f32x4){x[0], x[1], x[2], x[3]}; *(f32x4*)(d + 4) = (f32x4){x[4], x[5], x[6], x[7]}; }
    }
};
struct EpiRes {
    unsigned char* ws; int sssel;
    __device__ __forceinline__ void operator()(int r, int col, const float (&v)[8]) const {
        u32x4* const px = (u32x4*)((bf16_t*)(ws + WS_XBS_) + toff(r, col)); const u32x4 xo = *px;
        u32x4 w; w.x = cvt_pk_bf16(bf_lo(xo.x) + v[0], bf_hi(xo.x) + v[1]); w.y = cvt_pk_bf16(bf_lo(xo.y) + v[2], bf_hi(xo.y) + v[3]);
        w.z = cvt_pk_bf16(bf_lo(xo.z) + v[4], bf_hi(xo.z) + v[5]); w.w = cvt_pk_bf16(bf_lo(xo.w) + v[6], bf_hi(xo.w) + v[7]);
        *px = w;
        const float r0 = bf_lo(w.x), r1 = bf_hi(w.x), r2 = bf_lo(w.y), r3 = bf_hi(w.y), r4 = bf_lo(w.z), r5 = bf_hi(w.z), r6 = bf_lo(w.w), r7 = bf_hi(w.w);
        float ssq = ((r0 * r0 + r1 * r1) + (r2 * r2 + r3 * r3)) + ((r4 * r4 + r5 * r5) + (r6 * r6 + r7 * r7));
        ssq += xl_swz<1>(ssq);
        if ((col & 15) == 0) ((float*)(ws + WS_SSS_))[(size_t)(sssel * 128 + r) * 128 + (col >> 4)] = ssq;
    }
};
struct EpiUp {
    unsigned char* ws;
    __device__ __forceinline__ void operator()(int r, int col, const float (&v)[8]) const {
        const float rs = srow_rstd(ws, 1, r); float x[8];
#pragma unroll
        for (int e = 0; e < 8; ++e) { const float a = fmaxf(v[e] * rs, 0.f); x[e] = a * a; }
        u32x4 w; w.x = cvt_pk_bf16(x[0], x[1]); w.y = cvt_pk_bf16(x[2], x[3]); w.z = cvt_pk_bf16(x[4], x[5]); w.w = cvt_pk_bf16(x[6], x[7]);
        *(u32x4*)((bf16_t*)(ws + WS_HS_) + toff(r, col)) = w;
    }
};
template <class Epi, int NT, int DEPTH>
__device__ __forceinline__ void task(const int tid, const bf16_t* A, const bf16_t* Bt, const int K, const int c0, MLAS float* red, const Epi& E) {
    const int lane = tid & 63, i = lane & 15, kq = lane >> 4; const int wid = __builtin_amdgcn_readfirstlane(tid >> 6);
    const int ks = K >> 3, nsteps = ks >> 5;
    const bf16_t* ap = A + (size_t)(wid * nsteps) * 8 * 512 + lane * 8;
    const bf16_t* bp = Bt + (size_t)(c0 + i) * K + wid * ks + 8 * kq;
    f32x4 acc[8][NT];
#pragma unroll
    for (int m = 0; m < 8; ++m)
#pragma unroll
        for (int n = 0; n < NT; ++n) acc[m][n] = (f32x4){0.f, 0.f, 0.f, 0.f};
    bf16x8 af[DEPTH][8], bfr[DEPTH][NT];
#define MLOAD(d, s) do { _Pragma("unroll") for (int m = 0; m < 8; ++m) af[d][m] = *(const bf16x8*)(ap + (size_t)((s) * 8 + m) * 512); \
        _Pragma("unroll") for (int n = 0; n < NT; ++n) bfr[d][n] = *(const bf16x8*)(bp + (size_t)(16 * n) * K + 32 * (s)); } while (0)
#define MMMA(d) do { _Pragma("unroll") for (int m = 0; m < 8; ++m) _Pragma("unroll") for (int n = 0; n < NT; ++n) acc[m][n] = __builtin_amdgcn_mfma_f32_16x16x32_bf16(af[d][m], bfr[d][n], acc[m][n], 0, 0, 0); } while (0)
#pragma unroll
    for (int d = 0; d < DEPTH - 1; ++d) MLOAD(d, d);
    __builtin_amdgcn_sched_barrier(0);
    for (int s = 0; s < nsteps; s += DEPTH) {
#pragma unroll
        for (int d = 0; d < DEPTH; ++d) {
            if (s + d + DEPTH - 1 < nsteps) MLOAD((d + DEPTH - 1) % DEPTH, s + d + DEPTH - 1);
            __builtin_amdgcn_sched_barrier(0);
            MMMA(d);
            __builtin_amdgcn_sched_barrier(0);
        }
    }
#undef MLOAD
#undef MMMA
    constexpr int NC = 16 * NT, CG = 2 * NT;
    MLAS float* mine = red + wid * (128 * NC);
#pragma unroll
    for (int m = 0; m < 8; ++m)
#pragma unroll
        for (int n = 0; n < NT; ++n)
#pragma unroll
            for (int r = 0; r < 4; ++r) mine[(16 * m + 4 * kq + r) * NC + 16 * n + i] = acc[m][n][r];
    __syncthreads();
    if (tid < 128 * CG) { const int row = tid / CG, cg = tid % CG; float v[8];
#pragma unroll
        for (int e = 0; e < 8; ++e) v[e] = 0.f;
#pragma unroll
        for (int w = 0; w < 8; ++w) { const f32x4 p = *(const MLAS f32x4*)(red + w * (128 * NC) + row * NC + 8 * cg), q = *(const MLAS f32x4*)(red + w * (128 * NC) + row * NC + 8 * cg + 4);
            v[0] += p[0]; v[1] += p[1]; v[2] += p[2]; v[3] += p[3]; v[4] += q[0]; v[5] += q[1]; v[6] += q[2]; v[7] += q[3]; }
        E(row, c0 + 8 * cg, v); }
    __syncthreads();
}
#undef MLAS
}
constexpr int NWAVES = 8;
#ifndef MK_ONE_LAUNCH
#define MK_ONE_LAUNCH 1
#endif
constexpr int DM = 2048, FF = 8192, SEQ = 8192, NBATCH = 4, MP = NBATCH * SEQ, MS = 128, MR = MP + MS, MPAD = 33024;
constexpr int NPH = 22;
constexpr size_t MiB = 1u << 20;
constexpr size_t WS_CTL = 0, CTL_ZERO_BYTES = 1 * MiB;
constexpr size_t WS_WQA = 1 * MiB, WS_WOA = 49 * MiB, WS_WQB = 65 * MiB, WS_WOB = 89 * MiB, WS_WUP = 105 * MiB, WS_WDN = 233 * MiB;
constexpr size_t WS_XB = 361 * MiB;
constexpr size_t WS_SS0 = 490 * MiB, WS_SS1 = 495 * MiB;
constexpr size_t WS_SSS = 499 * MiB + 512 * 1024;
constexpr size_t WS_ACT = 500 * MiB;
constexpr size_t WS_Q = WS_ACT, WS_K = WS_ACT + 129 * MiB, WS_V = WS_ACT + 258 * MiB, WS_O = WS_ACT + 387 * MiB;
constexpr size_t WS_XBS = 1016 * MiB, WS_OS = WS_XBS + 512 * 1024, WS_HS = 1017 * MiB, WS_END = 1019 * MiB;
static_assert((size_t)MPAD * DM * 2 == 129 * MiB && (size_t)MPAD * FF * 2 == 516 * MiB, "buffer sizes");
constexpr int CW_TMO = 0, CW_BAR = 4096, CW_TKT = 16384, CW_CPY = 20480;
constexpr size_t O_Y = 0, O_AKP = 67371008, O_AVP = 75759616, O_BKP = 84148224, O_BVP = 84672512, O_AKS = 85196800, O_AVS = 101974016, O_BKS = 118751232, O_BVS = 119799808, O_END = 120848384;
constexpr int RING_BYTES = 131072, MISC_OFF = RING_BYTES + 320, LDS_BYTES = 147456;

#define GAS __attribute__((address_space(1)))
#define LAS __attribute__((address_space(3)))
typedef unsigned short bf16;
typedef unsigned v4u __attribute__((ext_vector_type(4)));
typedef unsigned v2u __attribute__((ext_vector_type(2)));
typedef float f32x4 __attribute__((ext_vector_type(4)));
typedef GAS unsigned gu32;
#define RLX_AGENT __ATOMIC_RELAXED, __HIP_MEMORY_SCOPE_AGENT
#define LDS_WAIT() asm volatile("s_waitcnt lgkmcnt(0)" ::: "memory")
#define VM_WAIT() asm volatile("s_waitcnt vmcnt(0)" ::: "memory")
__device__ __forceinline__ unsigned f2bf(float f) { unsigned u = __builtin_bit_cast(unsigned, f); return (u + 0x7fffu + ((u >> 16) & 1u)) >> 16; }
__device__ __forceinline__ unsigned pk2(float lo, float hi) { return f2bf(lo) | (f2bf(hi) << 16); }
#define XB_TMO      128
#define XB_XCNT(j)  (256  + 64 * (j))
#define XB_XSUB(j)  (1280 + 64 * (j))
#define XB_XGEN(j)  (2304 + 64 * (j))
#define XB_TOP      3328
#define XB_TOPGEN   3392
#define XCD_BAR_WORDS 3456
#define XB_SPIN_CAP (1u << 18)

__device__ __forceinline__ unsigned xb_ld(unsigned* p)              { return __hip_atomic_load(p, __ATOMIC_RELAXED, __HIP_MEMORY_SCOPE_AGENT); }
__device__ __forceinline__ unsigned xb_add(unsigned* p, unsigned v) { return __hip_atomic_fetch_add(p, v, __ATOMIC_RELAXED, __HIP_MEMORY_SCOPE_AGENT); }
__device__ __forceinline__ unsigned xb_xcc_id() { return (unsigned)__builtin_amdgcn_s_getreg((3 << 11) | 20) & 0xFu; }
#define XB_SPIN(cond, bar) do { unsigned _sp = 0; while (cond) { __builtin_amdgcn_s_sleep(1); \
    if ((++_sp & 255u) == 0u) { if (xb_ld(&(bar)[XB_TMO])) break; if (_sp > XB_SPIN_CAP) { atomicAdd(&(bar)[XB_TMO], 1u); break; } } } } while (0)

struct XcdBarrier {
    unsigned* bar; unsigned x;
    volatile LAS unsigned* st;
};

__device__ __forceinline__ XcdBarrier xcd_barrier_post(unsigned* bar, volatile LAS unsigned* st) {
    XcdBarrier b; b.bar = bar; b.x = xb_xcc_id(); b.st = st;
    if (threadIdx.x == 0) (void)xb_add(&bar[XB_XCNT(b.x)], 1u);
    return b;
}
__device__ __forceinline__ void xcd_barrier_complete(unsigned* bar, unsigned x, unsigned& nloc, unsigned& nx) {
    const unsigned G = gridDim.x * gridDim.y * gridDim.z;
    unsigned sum, cnt, mine, sp = 0u;
    for (;;) {
        sum = 0u; cnt = 0u; mine = 0u;
#pragma unroll
        for (unsigned j = 0; j < 16; ++j) { const unsigned c = xb_ld(&bar[XB_XCNT(j)]); sum += c; cnt += (c > 0u) ? 1u : 0u; mine = (j == x) ? c : mine; }
        if (sum == G) break;
        __builtin_amdgcn_s_sleep(1);
        if ((++sp & 255u) == 0u) { if (xb_ld(&bar[XB_TMO])) break; if (sp > XB_SPIN_CAP) { atomicAdd(&bar[XB_TMO], 1u); break; } }
    }
    nloc = mine > 0u ? mine : 1u; nx = cnt > 0u ? cnt : 1u;
}

__device__ __forceinline__ void xcd_barrier(const XcdBarrier& b) {
    asm volatile("s_waitcnt vmcnt(0)" ::: "memory");
    __syncthreads();
    if (threadIdx.x == 0) {
        unsigned* bar = b.bar;
        __builtin_amdgcn_s_waitcnt(0);
        unsigned nloc = b.st[0], nx = b.st[1];
        if (nloc == 0u) { xcd_barrier_complete(bar, b.x, nloc, nx); b.st[0] = nloc; b.st[1] = nx; }
        const unsigned old = xb_add(&bar[XB_XSUB(b.x)], 1u);
        const unsigned gen = old / nloc;
        if (old + 1u == (gen + 1u) * nloc) {
            __builtin_amdgcn_fence(__ATOMIC_RELEASE, "agent");
            asm volatile("s_waitcnt vmcnt(0)" ::: "memory");
            const unsigned og = xb_add(&bar[XB_TOP], 1u);
            const unsigned tg = og / nx;
            if (og + 1u == (tg + 1u) * nx) xb_add(&bar[XB_TOPGEN], 1u);
            else XB_SPIN(xb_ld(&bar[XB_TOPGEN]) == tg, bar);
            __builtin_amdgcn_fence(__ATOMIC_ACQUIRE, "agent");
            xb_add(&bar[XB_XGEN(b.x)], 1u);
            asm volatile("s_waitcnt vmcnt(0)" ::: "memory");
        } else {
            XB_SPIN(xb_ld(&bar[XB_XGEN(b.x)]) == gen, bar);
            __builtin_amdgcn_fence(__ATOMIC_ACQUIRE, "agent");
            asm volatile("s_waitcnt vmcnt(0)" ::: "memory");
        }
    }
    __syncthreads();
}
struct Frame {
    LAS unsigned char* lds;
    volatile LAS unsigned* MISC;
};
enum { P_XP = 0, P_XS, P_CAK, P_CAV, P_CBK, P_CBV, P_NMIX, P_NFFN, P_NFIN, P_AWQKV, P_AWO, P_AREL, P_BWQKV, P_BWO, P_BSINK, P_WUP, P_WDN, P_OUT, P_WS, P_COUNT };
typedef const __attribute__((address_space(4))) unsigned long long* karg_t;
#define KARGS() karg_t KA = (karg_t)__builtin_amdgcn_kernarg_segment_ptr(); asm volatile("" : "+s"(KA))
#define FPTR(i) ((const float*)(const GAS float*)KA[(i)])
#define OUTP() ((float*)(GAS float*)KA[P_OUT])
#define WSP() ((unsigned char*)(GAS unsigned char*)KA[P_WS])
__device__ __forceinline__ int opaque_lane() { int l; asm volatile("v_mbcnt_lo_u32_b32 %0, -1, 0\n\tv_mbcnt_hi_u32_b32 %0, -1, %0" : "=v"(l)); return l; }
__device__ __forceinline__ float wave_sum(float v) {
    return xl_wave_sum(v);
}
struct WItem { const float* W; const float* gain; bf16* WT; int K, N, r; };
#define P0_LOAD(R, GV, T) do { const int nblk_ = (T).N / 32, k0_ = 64 * ((T).r / nblk_), n0_ = 32 * ((T).r % nblk_); const float* wp_ = (T).W + (size_t)(k0_ + (lane >> 5)) * (T).N + n0_ + (lane & 31); \
        GV = (T).gain ? (T).gain[k0_ + lane] : 1.0f; \
        _Pragma("unroll") for (int i = 0; i < 32; ++i) R[i] = __builtin_nontemporal_load(wp_ + (size_t)(2 * i) * (T).N); } while (0)
#define P0_PROC(R, GV, T) do { const int nblk_ = (T).N / 32, k0_ = 64 * ((T).r / nblk_), n0_ = 32 * ((T).r % nblk_); \
        _Pragma("unroll") for (int i = 0; i < 32; ++i) { const float g0_ = __builtin_bit_cast(float, __builtin_amdgcn_readlane(__builtin_bit_cast(int, GV), 2 * i)), g1_ = __builtin_bit_cast(float, __builtin_amdgcn_readlane(__builtin_bit_cast(int, GV), 2 * i + 1)); \
            scr[(2 * i + (lane >> 5)) * 33 + (lane & 31)] = R[i] * ((lane >> 5) ? g1_ : g0_); } \
        LDS_WAIT(); asm volatile("" ::: "memory"); \
        { const int c_ = lane & 7; _Pragma("unroll") for (int j = 0; j < 4; ++j) { const int n_ = (lane >> 3) + 8 * j; const LAS float* s_ = scr + (8 * c_) * 33 + n_; \
            v4u o_; o_.x = pk2(s_[0 * 33], s_[1 * 33]); o_.y = pk2(s_[2 * 33], s_[3 * 33]); o_.z = pk2(s_[4 * 33], s_[5 * 33]); o_.w = pk2(s_[6 * 33], s_[7 * 33]); \
            *(GAS v4u*)((T).WT + (size_t)(n0_ + n_) * (T).K + k0_ + 8 * c_) = o_; } } \
        LDS_WAIT(); asm volatile("" ::: "memory"); } while (0)
__device__ __forceinline__ WItem witem(karg_t KA, unsigned char* ws, const int kind, const int s, const int r) { WItem t; t.r = r;
    if (kind == 0)      { t.W = FPTR(P_AWQKV) + (size_t)s * 2048 * 6144; t.gain = FPTR(P_NMIX) + (2 * s) * 2048;     t.K = 2048; t.N = 6144; t.WT = (bf16*)(ws + WS_WQA + (size_t)s * 24 * MiB); }
    else if (kind == 1) { t.W = FPTR(P_AWO) + (size_t)s * 2048 * 2048;   t.gain = nullptr;                            t.K = 2048; t.N = 2048; t.WT = (bf16*)(ws + WS_WOA + (size_t)s * 8 * MiB); }
    else if (kind == 2) { t.W = FPTR(P_BWQKV) + (size_t)s * 2048 * 3072; t.gain = FPTR(P_NMIX) + (2 * s + 1) * 2048; t.K = 2048; t.N = 3072; t.WT = (bf16*)(ws + WS_WQB + (size_t)s * 12 * MiB); }
    else if (kind == 3) { t.W = FPTR(P_BWO) + (size_t)s * 2048 * 2048;   t.gain = nullptr;                            t.K = 2048; t.N = 2048; t.WT = (bf16*)(ws + WS_WOB + (size_t)s * 8 * MiB); }
    else if (kind == 4) { t.W = FPTR(P_WUP) + (size_t)s * 2048 * 8192;   t.gain = FPTR(P_NFFN) + s * 2048;            t.K = 2048; t.N = 8192; t.WT = (bf16*)(ws + WS_WUP + (size_t)s * 32 * MiB); }
    else                { t.W = FPTR(P_WDN) + (size_t)s * 8192 * 2048;   t.gain = nullptr;                            t.K = 8192; t.N = 2048; t.WT = (bf16*)(ws + WS_WDN + (size_t)s * 32 * MiB); }
    return t; }
constexpr int I_AQ = 32 * 192, I_O = 32 * 64, I_BQ = 32 * 96, I_UP = 32 * 256, I_DN = 128 * 64;
constexpr int P0_ITEMS = I_AQ + I_O;
__device__ __forceinline__ WItem p0_decode(karg_t KA, unsigned char* ws, const int it) {
    if (it < I_AQ) return witem(KA, ws, 0, 0, it);
    return witem(KA, ws, 1, 0, it - I_AQ); }
constexpr int FW_A0 = I_UP, FW_A1 = FW_A0 + I_DN,
              FW_B0 = FW_A1 + I_BQ, FW_B1 = FW_B0 + I_O, FW_B2 = FW_B1 + I_UP, FW_B3 = FW_B2 + I_DN, FW_B4 = FW_B3 + I_AQ, FW_B5 = FW_B4 + I_O, FW_B6 = FW_B5 + I_UP, FW_B7 = FW_B6 + I_DN,
              FW_B8 = FW_B7 + I_BQ, FW_B9 = FW_B8 + I_O, FW_B10 = FW_B9 + I_UP, FW_B11 = FW_B10 + I_DN;
constexpr int FW_TASK_ITEMS = 16, FW_TASKS = FW_B11 / FW_TASK_ITEMS;
static_assert(FW_B11 % FW_TASK_ITEMS == 0 && FW_B11 + P0_ITEMS == 2 * I_AQ + 4 * I_O + 2 * I_BQ + 4 * I_UP + 4 * I_DN, "deferred weight items");
__device__ __forceinline__ WItem fw_decode(karg_t KA, unsigned char* ws, const int it) {
    if (it < FW_A0) return witem(KA, ws, 4, 0, it);
    if (it < FW_A1) return witem(KA, ws, 5, 0, it - FW_A0);
    if (it < FW_B0) return witem(KA, ws, 2, 0, it - FW_A1);
    if (it < FW_B1) return witem(KA, ws, 3, 0, it - FW_B0);
    if (it < FW_B2) return witem(KA, ws, 4, 1, it - FW_B1);
    if (it < FW_B3) return witem(KA, ws, 5, 1, it - FW_B2);
    if (it < FW_B4) return witem(KA, ws, 0, 1, it - FW_B3);
    if (it < FW_B5) return witem(KA, ws, 1, 1, it - FW_B4);
    if (it < FW_B6) return witem(KA, ws, 4, 2, it - FW_B5);
    if (it < FW_B7) return witem(KA, ws, 5, 2, it - FW_B6);
    if (it < FW_B8) return witem(KA, ws, 2, 1, it - FW_B7);
    if (it < FW_B9) return witem(KA, ws, 3, 1, it - FW_B8);
    if (it < FW_B10) return witem(KA, ws, 4, 3, it - FW_B9);
    return witem(KA, ws, 5, 3, it - FW_B10); }
__device__ __forceinline__ unsigned fill_must(const int pr, const int site) {
    constexpr int T = FW_TASK_ITEMS;
    const int m0 = site <= 2 ? 0 : site == 3 ? FW_A0 / T : site == 4 ? FW_A1 / T : site <= 6 ? FW_B0 / T : site == 7 ? FW_B1 / T : site == 8 ? FW_B2 / T : site == 9 ? FW_B3 / T : FW_B4 / T;
    const int m1 = site <= 1 ? FW_B4 / T : site == 2 ? FW_B5 / T : site == 3 ? FW_B6 / T : site == 4 ? FW_B7 / T : site <= 6 ? FW_B8 / T : site == 7 ? FW_B9 / T : site == 8 ? FW_B10 / T : FW_B11 / T;
    return (unsigned)(pr == 0 ? m0 : m1); }
__device__ __forceinline__ void fill_weight_task(Frame& F, karg_t KA, const int tid, const int t) {
#if defined(PROBE_DUMMY_FILL) && PROBE_DUMMY_FILL == 1
    __builtin_amdgcn_s_sleep(127); return;
#endif
    const int lane = tid & 63, wave = __builtin_amdgcn_readfirstlane(tid >> 6);
    unsigned char* const ws = WSP();
    LAS float* scr = (LAS float*)(F.lds + wave * 16384);
    float ra[32], rb[32]; float ga = 1.f, gb = 1.f;
    const WItem ta = fw_decode(KA, ws, FW_TASK_ITEMS * t + wave), tb = fw_decode(KA, ws, FW_TASK_ITEMS * t + 8 + wave);
    P0_LOAD(ra, ga, ta); P0_LOAD(rb, gb, tb);
    P0_PROC(ra, ga, ta); P0_PROC(rb, gb, tb);
}
__device__ __forceinline__ void p0_prologue(Frame& F, const int wave0) {
    KARGS();
    int tid_ = (wave0 << 6) | opaque_lane(), bid_ = blockIdx.x, G_ = gridDim.x; asm volatile("" : "+v"(tid_), "+s"(bid_), "+s"(G_));
    const int lane = tid_ & 63, wave = __builtin_amdgcn_readfirstlane(tid_ >> 6), vcu = (G_ % 8 == 0) ? (bid_ % 8) * (G_ / 8) + bid_ / 8 : bid_;
    unsigned char* const ws = WSP(); float* const out = OUTP();
    LAS float* scr = (LAS float*)(F.lds + wave * 16384);
    const int gw = vcu * NWAVES + wave, NGW = G_ * NWAVES;
#ifdef PROBE_DUMMY_FILL
    constexpr int E5 = P0_ITEMS + FW_B11;
    auto decode = [&](int it) -> WItem { return it < P0_ITEMS ? p0_decode(KA, ws, it) : fw_decode(KA, ws, it - P0_ITEMS); };
#else
    constexpr int E5 = P0_ITEMS;
    auto decode = [&](int it) -> WItem { return p0_decode(KA, ws, it); };
#endif
    {
        float ra[32], rb[32]; float ga = 1.f, gb = 1.f; WItem ta, tb;
        int it = gw;
        if (it < E5) { ta = decode(it); P0_LOAD(ra, ga, ta); }
        while (it < E5) {
            const int it2 = it + NGW, it3 = it2 + NGW;
            if (it2 < E5) { tb = decode(it2); P0_LOAD(rb, gb, tb); }
            P0_PROC(ra, ga, ta);
            if (it3 < E5) { ta = decode(it3); P0_LOAD(ra, ga, ta); }
            if (it2 < E5) { P0_PROC(rb, gb, tb); }
            it = it3;
        }
    }
    bf16* XB = (bf16*)(ws + WS_XB); float* SS0 = (float*)(ws + WS_SS0); const float* const xp_ = FPTR(P_XP); const float* const xs_ = FPTR(P_XS);
    for (int m0 = gw; m0 < MPAD; m0 += 2 * NGW) {
        f32x4 v[2][8];
#pragma unroll
        for (int h = 0; h < 2; ++h) { const int m = m0 + h * NGW;
            if (m < MR) { const float* xrow = m < MP ? xp_ + (size_t)m * DM : xs_ + (size_t)(m - MP) * DM; const GAS f32x4* xr = (const GAS f32x4*)xrow + lane;
#pragma unroll
                for (int j = 0; j < 8; ++j) v[h][j] = __builtin_nontemporal_load(xr + 64 * j); }
            else {
#pragma unroll
                for (int j = 0; j < 8; ++j) v[h][j] = (f32x4){0.f, 0.f, 0.f, 0.f}; } }
#pragma unroll
        for (int h = 0; h < 2; ++h) { const int m = m0 + h * NGW;
            if (m < MPAD) { float s = 0.f;
#pragma unroll
                for (int j = 0; j < 8; ++j) s += (v[h][j][0] * v[h][j][0] + v[h][j][1] * v[h][j][1]) + (v[h][j][2] * v[h][j][2] + v[h][j][3] * v[h][j][3]);
                s = wave_sum(s);
                if (m >= MP && m < MR) {
                    bf16* const xbs = (bf16*)(ws + WS_XBS);
#pragma unroll
                    for (int j = 0; j < 8; ++j) { v2u w; w.x = pk2(v[h][j][0], v[h][j][1]); w.y = pk2(v[h][j][2], v[h][j][3]); *(GAS v2u*)(xbs + samp_toff(m - MP, 4 * lane + 256 * j)) = w; }
                } else {
                GAS v2u* o8 = (GAS v2u*)(XB + (size_t)m * DM) + lane;
#pragma unroll
                for (int j = 0; j < 8; ++j) { v2u w; w.x = pk2(v[h][j][0], v[h][j][1]); w.y = pk2(v[h][j][2], v[h][j][3]); o8[64 * j] = w; } }
                if (lane < 32) SS0[(size_t)m * 32 + lane] = lane == 0 ? s : 0.f;
                if (m >= MP && m < MR) { ((float*)(ws + WS_SSS))[(size_t)(m - MP) * 128 + lane] = lane == 0 ? s : 0.f; ((float*)(ws + WS_SSS))[(size_t)(m - MP) * 128 + 64 + lane] = 0.f; } } }
    }
}
constexpr int CPY_A_TASKS = 992, CPY_TASKS = 1048, CPY_CHUNK4 = 8192;
__device__ __forceinline__ void copy_task(const float* cak_, const float* cav_, const float* cbk_, const float* cbv_, float* out, const int t, const int tid) {
    constexpr size_t A_BLK4 = 512 * 512, A_CP4 = 496 * 512, A_TOT = 16 * A_CP4, B_BLK4 = 128 * 128, B_CP4 = 112 * 128, B_TOT = 16 * B_CP4;
    static_assert(2 * A_TOT == (size_t)CPY_A_TASKS * CPY_CHUNK4 && 2 * B_TOT == (size_t)(CPY_TASKS - CPY_A_TASKS) * CPY_CHUNK4, "copy tasks");
    const bool isa = t < CPY_A_TASKS; const size_t base = (size_t)(isa ? t : t - CPY_A_TASKS) * CPY_CHUNK4 + tid;
    const size_t TOT = isa ? A_TOT : B_TOT, CP4 = isa ? A_CP4 : B_CP4, BLK4 = isa ? A_BLK4 : B_BLK4, SKIP = isa ? 16 * 512 : 16 * 128;
    const f32x4* const sk = (const f32x4*)(isa ? cak_ : cbk_); const f32x4* const sv = (const f32x4*)(isa ? cav_ : cbv_);
    f32x4* const dk = (f32x4*)(out + (isa ? O_AKS : O_BKS)); f32x4* const dv = (f32x4*)(out + (isa ? O_AVS : O_BVS));
#pragma unroll 1
    for (int bq = 0; bq < CPY_CHUNK4 / 4096; ++bq) { f32x4 v[8];
#pragma unroll
        for (int e = 0; e < 8; ++e) { const size_t i = base + (size_t)(bq * 8 + e) * 512; const bool isv = i >= TOT; const size_t q = isv ? i - TOT : i, blk = q / CP4, off = q % CP4;
            v[e] = __builtin_nontemporal_load((isv ? sv : sk) + blk * BLK4 + SKIP + off); }
#pragma unroll
        for (int e = 0; e < 8; ++e) { const size_t i = base + (size_t)(bq * 8 + e) * 512; const bool isv = i >= TOT; const size_t q = isv ? i - TOT : i, blk = q / CP4, off = q % CP4;
            __builtin_nontemporal_store(v[e], (isv ? dv : dk) + blk * BLK4 + off); } }
}
#ifndef FILL_WQ
#define FILL_WQ 450u
#endif
#ifndef FILL_MOD
#define FILL_MOD 1u
#endif
#ifndef FILL_CQ
#define FILL_CQ 90u
#endif
constexpr unsigned FILL_TOTAL = FW_TASKS + CPY_TASKS, FILL_NONE = 0xfffffffeu, FILL_DONE = 0xffffffffu;
constexpr int ST_A_TASKS = 256, ST_B_TASKS = 16, CW_ST = CW_CPY + 256;
__device__ __forceinline__ void state_task(unsigned char* ws, float* out, const int pr, const bool isb, const int t, const int tid) {
    const int kv = isb ? t >> 3 : t >> 7, rem = isb ? (t & 7) : (t & 127), b = isb ? rem >> 1 : rem >> 5, r0 = isb ? (rem & 1) * 64 : (rem & 31) * 16;
    const size_t W = isb ? 512 : 2048, CLr = isb ? 128 : 512, srow = (size_t)b * 8192 + (8192 - CLr) + r0;
    const bf16* const src = (const bf16*)(ws + (kv ? WS_V : WS_K)) + srow * W;
    float* const dst = out + (isb ? (kv ? O_BVP : O_BKP) : (kv ? O_AVP : O_AKP)) + (size_t)pr * 4 * CLr * W + ((size_t)b * CLr + r0) * W;
    v4u w[8];
#pragma unroll
    for (int j = 0; j < 8; ++j) w[j] = *(const GAS v4u*)(src + 8 * (tid + 512 * j));
#pragma unroll
    for (int j = 0; j < 8; ++j) { GAS f32x4* const d = (GAS f32x4*)(dst + 8 * (tid + 512 * j));
        d[0] = (f32x4){__uint_as_float(w[j].x << 16), __uint_as_float(w[j].x & 0xffff0000u), __uint_as_float(w[j].y << 16), __uint_as_float(w[j].y & 0xffff0000u)};
        d[1] = (f32x4){__uint_as_float(w[j].z << 16), __uint_as_float(w[j].z & 0xffff0000u), __uint_as_float(w[j].w << 16), __uint_as_float(w[j].w & 0xffff0000u)}; }
}
__device__ __forceinline__ void fill_run(Frame& F, karg_t KA, const int tid, const unsigned t, const int st_pr, const bool st_b) {
    if (t >= FW_TASKS + CPY_TASKS) state_task(WSP(), OUTP(), st_pr, st_b, (int)(t - (FW_TASKS + CPY_TASKS)), tid);
    else if (t < (unsigned)FW_TASKS) fill_weight_task(F, KA, tid, (int)t);
    else copy_task(FPTR(P_CAK), FPTR(P_CAV), FPTR(P_CBK), FPTR(P_CBV), OUTP(), (int)(t - FW_TASKS), tid);
}
__device__ __forceinline__ void fill_until(Frame& F, karg_t KA, const int tid, const unsigned must, const unsigned mustc) {
    gu32* const ck = (gu32*)(WSP() + WS_CTL) + CW_CPY; gu32* const cc = ck + 64;
    for (;;) {
        if (tid == 0) { unsigned r = FILL_NONE;
            if (__hip_atomic_load(ck, RLX_AGENT) < must) { r = __hip_atomic_fetch_add(ck, 1u, RLX_AGENT); if (r >= (unsigned)FW_TASKS) r = FILL_NONE; }
            if (r == FILL_NONE && __hip_atomic_load(cc, RLX_AGENT) < mustc) { r = __hip_atomic_fetch_add(cc, 1u, RLX_AGENT); r = r < (unsigned)CPY_TASKS ? r + FW_TASKS : FILL_NONE; }
            F.MISC[17] = r; }
        __syncthreads();
        const unsigned t = F.MISC[17]; if (t >= FILL_TOTAL) break;
        fill_run(F, KA, tid, t, 0, false); __syncthreads();
    }
}
__device__ __forceinline__ void xcd_barrier_fill(const XcdBarrier& b, Frame& F, karg_t KA, const int tid, const unsigned must, const unsigned wq, const unsigned cq, const int st_mode, const int st_pr, const bool st_b) {
    gu32* const sc = (gu32*)(WSP() + WS_CTL) + CW_ST + 64 * (2 * st_pr + (st_b ? 1 : 0)); const unsigned st_n = st_b ? (unsigned)ST_B_TASKS : (unsigned)ST_A_TASKS;
    if (st_mode == 2 && F.MISC[19] < st_n) {
        for (;;) {
            if (tid == 0) { unsigned r = FILL_NONE; if (__hip_atomic_load(sc, RLX_AGENT) < st_n) { r = __hip_atomic_fetch_add(sc, 1u, RLX_AGENT); r = r < st_n ? r + FILL_TOTAL : FILL_NONE; } F.MISC[17] = r; }
            __syncthreads();
            const unsigned t = F.MISC[17]; if (t == FILL_NONE) break;
            fill_run(F, KA, tid, t, st_pr, st_b); __syncthreads();
        }
    }
    if (must != 0u && F.MISC[18] < must) fill_until(F, KA, tid, must, 0u);
    asm volatile("s_waitcnt vmcnt(0)" ::: "memory");
    __syncthreads();
    unsigned gen = 0u; bool open = false;
    if (tid == 0) {
        unsigned* bar = b.bar;
        __builtin_amdgcn_s_waitcnt(0);
        unsigned nloc = b.st[0], nx = b.st[1];
        if (nloc == 0u) { xcd_barrier_complete(bar, b.x, nloc, nx); b.st[0] = nloc; b.st[1] = nx; }
        const unsigned old = xb_add(&bar[XB_XSUB(b.x)], 1u);
        gen = old / nloc;
        if (old + 1u == (gen + 1u) * nloc) {
            __builtin_amdgcn_fence(__ATOMIC_RELEASE, "agent");
            asm volatile("s_waitcnt vmcnt(0)" ::: "memory");
            const unsigned og = xb_add(&bar[XB_TOP], 1u);
            const unsigned tg = og / nx;
            if (og + 1u == (tg + 1u) * nx) xb_add(&bar[XB_TOPGEN], 1u);
            else XB_SPIN(xb_ld(&bar[XB_TOPGEN]) == tg, bar);
            __builtin_amdgcn_fence(__ATOMIC_ACQUIRE, "agent");
            xb_add(&bar[XB_XGEN(b.x)], 1u);
            asm volatile("s_waitcnt vmcnt(0)" ::: "memory");
            open = true;
        }
    }
    gu32* const ck = (gu32*)(WSP() + WS_CTL) + CW_CPY; gu32* const cc = ck + 64;
    for (;;) {
        if (tid == 0) {
            unsigned r = FILL_DONE;
            if (!open) {
                unsigned* bar = b.bar;
                if (xb_ld(&bar[XB_XGEN(b.x)]) == gen) {
                    r = FILL_NONE;
                    if (st_mode == 1 && __hip_atomic_load(sc, RLX_AGENT) < st_n) { r = __hip_atomic_fetch_add(sc, 1u, RLX_AGENT); r = r < st_n ? r + FILL_TOTAL : FILL_NONE; }
                    if (r == FILL_NONE && __hip_atomic_load(ck, RLX_AGENT) < wq) { r = __hip_atomic_fetch_add(ck, 1u, RLX_AGENT); if (r >= (unsigned)FW_TASKS) r = FILL_NONE; }
                    if (r == FILL_NONE && __hip_atomic_load(cc, RLX_AGENT) < cq) { r = __hip_atomic_fetch_add(cc, 1u, RLX_AGENT); r = r < (unsigned)CPY_TASKS ? r + FW_TASKS : FILL_NONE; }
                    if (r == FILL_NONE) { XB_SPIN(xb_ld(&bar[XB_XGEN(b.x)]) == gen, bar); r = FILL_DONE; }
                }
                if (r == FILL_DONE) { __builtin_amdgcn_fence(__ATOMIC_ACQUIRE, "agent"); asm volatile("s_waitcnt vmcnt(0)" ::: "memory"); }
            }
            F.MISC[17] = r;
        }
        __syncthreads();
        const unsigned t = F.MISC[17]; if (t == FILL_DONE) break;
        fill_run(F, KA, tid, t, st_pr, st_b); __syncthreads();
    }
}
__device__ __forceinline__ void final_norm(Frame& F, const int wave0) {
    KARGS();
    int tid_ = (wave0 << 6) | opaque_lane(), bid_ = blockIdx.x, G_ = gridDim.x; asm volatile("" : "+v"(tid_), "+s"(bid_), "+s"(G_));
    const int lane = tid_ & 63, wave = __builtin_amdgcn_readfirstlane(tid_ >> 6), vcu = (G_ % 8 == 0) ? (bid_ % 8) * (G_ / 8) + bid_ / 8 : bid_;
    float* const out = OUTP(); const float* const nfin_ = FPTR(P_NFIN); const bf16* const XB = (const bf16*)(WSP() + WS_XB);
    const int gw = vcu * NWAVES + wave, NGW = G_ * NWAVES;
    f32x4 g[4][2];
#pragma unroll
    for (int j = 0; j < 4; ++j) { g[j][0] = *(const GAS f32x4*)(nfin_ + 512 * j + 8 * lane); g[j][1] = *(const GAS f32x4*)(nfin_ + 512 * j + 8 * lane + 4); }
    for (int m = gw; m < MR; m += NGW) {
        v4u w[4]; float s = 0.f; f32x4 v[4][2];
        if (m < MP) { const GAS v4u* xr = (const GAS v4u*)(XB + (size_t)m * DM) + lane;
#pragma unroll
            for (int j = 0; j < 4; ++j) w[j] = xr[64 * j]; }
        else { const bf16* const xbs = (const bf16*)(WSP() + WS_XBS);
#pragma unroll
            for (int j = 0; j < 4; ++j) w[j] = *(const GAS v4u*)(xbs + samp_toff(m - MP, 8 * lane + 512 * j)); }
#pragma unroll
        for (int j = 0; j < 4; ++j) { v[j][0] = (f32x4){__uint_as_float(w[j].x << 16), __uint_as_float(w[j].x & 0xffff0000u), __uint_as_float(w[j].y << 16), __uint_as_float(w[j].y & 0xffff0000u)};
            v[j][1] = (f32x4){__uint_as_float(w[j].z << 16), __uint_as_float(w[j].z & 0xffff0000u), __uint_as_float(w[j].w << 16), __uint_as_float(w[j].w & 0xffff0000u)};
#pragma unroll
            for (int h = 0; h < 2; ++h) s += (v[j][h][0] * v[j][h][0] + v[j][h][1] * v[j][h][1]) + (v[j][h][2] * v[j][h][2] + v[j][h][3] * v[j][h][3]); }
        const float rs = 1.0f / sqrtf(wave_sum(s) * (1.0f / DM) + 1e-6f);
        GAS f32x4* yr = (GAS f32x4*)(out + (size_t)m * DM + 8 * lane);
#pragma unroll
        for (int j = 0; j < 4; ++j) { yr[128 * j] = v[j][0] * rs * g[j][0]; yr[128 * j + 1] = v[j][1] * rs * g[j][1]; }
    }
}

#ifndef WGM_BIG
#define WGM_BIG 4
#endif
#ifndef GP_ALIGN
#define GP_ALIGN true
#endif
#ifndef GP_SP2
#define GP_SP2 true
#endif
struct Args { const float* in[17]; float* out; unsigned char* ws; int pr_lo, pr_hi; };
template <int SITE> __global__ void __launch_bounds__(NWAVES * 64, 2) mk_fwd(Args args) {
    extern __shared__ __attribute__((aligned(16))) unsigned char lds[];
    Frame F;
    F.lds = (LAS unsigned char*)lds;
    F.MISC = (volatile LAS unsigned*)(F.lds + MISC_OFF);
    for (int u = threadIdx.x; u < (LDS_BYTES - RING_BYTES) / 4; u += NWAVES * 64) ((LAS unsigned*)(F.lds + RING_BYTES))[u] = 0u;
    __syncthreads();
    constexpr bool ALL = SITE < 0;
    const int wave0 = __builtin_amdgcn_readfirstlane(threadIdx.x >> 6);
    XcdBarrier bar; bar.bar = nullptr; bar.x = 0; bar.st = nullptr;
    if constexpr (ALL) { KARGS(); bar = xcd_barrier_post((unsigned*)(WSP() + WS_CTL) + CW_BAR, F.MISC + 8); }
#ifndef PHM
#define PHM 0xFFFF
#endif
#define ON(b) (((PHM >> (b)) & 1) && (ALL || SITE == (b)))
#ifdef TS_DIAG
    volatile LAS unsigned long long* const TSW = (volatile LAS unsigned long long*)(F.lds + MISC_OFF + 128);
    if (wave0 == 0 && opaque_lane() == 0) TSW[0] = __builtin_amdgcn_s_memrealtime();
#ifndef TS_BLOCK
#define TS_BLOCK 0
#endif
#ifndef TS_B
#define TS_B (-1)
#endif
#define TS_MARK(cat) do { if (((cat) == TS_A || (cat) == TS_B || true) && wave0 == 0 && opaque_lane() == 0) { const unsigned long long now_ = __builtin_amdgcn_s_memrealtime(), d_ = now_ - TSW[0]; if ((cat) == TS_A) TSW[1] += d_; if ((cat) == TS_B) TSW[2] += d_; TSW[0] = now_; } } while (0)
#else
#define TS_MARK(cat) do {} while (0)
#endif
#define SEAM(site) do { if constexpr (ALL) { KARGS(); OTID(ftid); XcdBarrier b_ = bar; asm volatile("" : "+s"(b_.bar)); { const unsigned e1_ = (unsigned)(((site) ? pr_ * 10 : 0) + (site) + 1); const bool el_ = (((blockIdx.x >> 3) + e1_) & (FILL_MOD - 1u)) == 0u;     \
        constexpr bool att_ = (site) == 2 || (site) == 7;     \
        xcd_barrier_fill(b_, F, KA, ftid, fill_must((site) ? pr_ : 0, (site)), att_ ? (unsigned)FW_TASKS : (el_ ? e1_ * FILL_WQ : 0u), att_ ? (unsigned)CPY_TASKS : (el_ ? e1_ * FILL_CQ : 0u), att_ ? 1 : (((site) == 3 || (site) == 8) ? 2 : 0), pr_, (site) == 7 || (site) == 8); } TS_MARK(8); } } while (0)
#define OTID(name) int name = (wave0 << 6) | opaque_lane(); asm volatile("" : "+v"(name))
#define DYN_TASKS(tidv, TKT, NTASKS, ...) do { gu32* const tk_ = (gu32*)(ws + WS_CTL) + CW_TKT + 64 * (TKT); \
        for (;;) { if ((tidv) == 0) { const unsigned tk1_ = __hip_atomic_fetch_add(tk_, 1u, __ATOMIC_RELAXED, __HIP_MEMORY_SCOPE_AGENT), fc1_ = __hip_atomic_load((gu32*)(ws + WS_CTL) + CW_CPY, RLX_AGENT); F.MISC[16] = tk1_; F.MISC[18] = fc1_; }     \
            __syncthreads(); const int t = (int)F.MISC[16]; if (t >= (NTASKS)) break; __VA_ARGS__; __syncthreads(); } } while (0)
#define DYN_TASKS_PRE(tidv, TKT, NTASKS, ...) do { gu32* const tk_ = (gu32*)(ws + WS_CTL) + CW_TKT + 64 * (TKT); \
        for (bool first_ = true;; first_ = false) { if ((tidv) == 0 && !first_) { const unsigned tk1_ = __hip_atomic_fetch_add(tk_, 1u, __ATOMIC_RELAXED, __HIP_MEMORY_SCOPE_AGENT), fc1_ = __hip_atomic_load((gu32*)(ws + WS_CTL) + CW_CPY, RLX_AGENT); F.MISC[16] = tk1_; F.MISC[18] = fc1_; }     \
            __syncthreads(); const int t = (int)F.MISC[16]; if (t >= (NTASKS)) break; __VA_ARGS__; __syncthreads(); } } while (0)
#define SITE_IDS() KARGS(); OTID(otid); (void)otid; int bid = blockIdx.x, G = gridDim.x; asm volatile("" : "+s"(bid), "+s"(G)); const int vcu = (G % 8 == 0) ? (bid % 8) * (G / 8) + bid / 8 : bid; (void)vcu
    LAS char* const alds = (LAS char*)F.lds;

    { const int pr_ = 0; if (ON(0)) { p0_prologue(F, wave0); TS_MARK(0); } SEAM(0); }

    for (int pr = args.pr_lo; pr < args.pr_hi; ++pr) { const int pr_ = pr;
        if (ON(1)) {
            SITE_IDS(); const int TKT_ID = pr * 12 + 1; (void)TKT_ID;
            unsigned char* const ws = WSP();
            pg8::Gemm g{(const bf16*)(ws + WS_XB), (const bf16*)(ws + WS_WQA + (size_t)pr * 24 * MiB), MP, 6144, 2048}; pg8::StaticOrder S; S.init(MP, 6144, G, bid, WGM_BIG);
            pg8::EpiQKV<false> E{ws, OUTP(), pr};
            pg8::gemm_phase<pg8::EpiQKV<false>, pg8::StaticOrder, GP_ALIGN, GP_SP2>(F.lds, g, S, E, otid, pg8::Tail{(unsigned*)(ws + WS_CTL) + CW_TKT + 64 * TKT_ID, (unsigned*)(ws + WS_CTL) + CW_CPY, (volatile PG8_LAS unsigned*)(F.MISC + 16), nullptr});
            { mini::EpiQKV<false> ME{ws, OUTP(), pr}; OTID(mtid);
              DYN_TASKS_PRE(mtid, TKT_ID, 6144 / 32, mini::task<mini::EpiQKV<false>, 2, 2>(mtid, (const bf16*)(ws + WS_XBS), g.Bt, 2048, 32 * t, (LAS float*)F.lds, ME)); }
        TS_MARK(1); } SEAM(1);
        if (ON(2)) {
            SITE_IDS(); const int TKT_ID = pr * 12 + 2; (void)TKT_ID;
            unsigned char* const ws = WSP(); const bf16* const QB = (const bf16*)(ws + WS_Q); bf16* const OB = (bf16*)(ws + WS_O); const bf16* const KB = (const bf16*)(ws + WS_K); const bf16* const VB = (const bf16*)(ws + WS_V);
            const float* rel = FPTR(P_AREL) + (size_t)pr * 16 * 257;
            for (int u = vcu; u < 2048; u += G) { const int bh = u >> 5, qb = u & 31;
                att::attnA_unit(otid, bh >> 4, bh & 15, qb, QB, KB, VB, OB, rel + (bh & 15) * 257, alds); }
            __syncthreads();
            OTID(otid2);
            DYN_TASKS(otid2, TKT_ID, 128, att::sample_attn_unit<128, 512, true>(otid2, t >> 4, t & 15, QB, KB, VB, (bf16*)(ws + WS_OS), FPTR(P_CAK) + (size_t)pr * 8 * 512 * 2048, FPTR(P_CAV) + (size_t)pr * 8 * 512 * 2048, rel + (t & 15) * 257, alds));
            __syncthreads();
        TS_MARK(2); } SEAM(2);
        if (ON(3)) {
            SITE_IDS(); const int TKT_ID = pr * 12 + 3; (void)TKT_ID;
            unsigned char* const ws = WSP();
            pg8::Gemm g{(const bf16*)(ws + WS_O), (const bf16*)(ws + WS_WOA + (size_t)pr * 8 * MiB), MP, 2048, 2048}; pg8::StaticOrder S; S.init(MP, 2048, G, bid, 4);
            pg8::EpiRes E{ws, 1};
            pg8::gemm_phase<pg8::EpiRes, pg8::StaticOrder, GP_ALIGN, GP_SP2>(F.lds, g, S, E, otid, pg8::Tail{(unsigned*)(ws + WS_CTL) + CW_TKT + 64 * TKT_ID, (unsigned*)(ws + WS_CTL) + CW_CPY, (volatile PG8_LAS unsigned*)(F.MISC + 16), (unsigned*)(ws + WS_CTL) + CW_ST + 64 * (2 * pr + 0)});
            { mini::EpiRes ME{ws, 1}; OTID(mtid);
              DYN_TASKS_PRE(mtid, TKT_ID, 2048 / 16, mini::task<mini::EpiRes, 1, 4>(mtid, (const bf16*)(ws + WS_OS), g.Bt, 2048, 16 * t, (LAS float*)F.lds, ME)); }
        TS_MARK(4); } SEAM(3);
        if (ON(4)) {
            SITE_IDS(); const int TKT_ID = pr * 12 + 4; (void)TKT_ID;
            unsigned char* const ws = WSP();
            pg8::Gemm g{(const bf16*)(ws + WS_XB), (const bf16*)(ws + WS_WUP + (size_t)(2 * pr) * 32 * MiB), MP, 8192, 2048}; pg8::StaticOrder S; S.init(MP, 8192, G, bid, WGM_BIG);
            pg8::EpiUp E{ws};
            pg8::gemm_phase<pg8::EpiUp, pg8::StaticOrder, GP_ALIGN, GP_SP2>(F.lds, g, S, E, otid, pg8::Tail{(unsigned*)(ws + WS_CTL) + CW_TKT + 64 * TKT_ID, (unsigned*)(ws + WS_CTL) + CW_CPY, (volatile PG8_LAS unsigned*)(F.MISC + 16), nullptr});
            { mini::EpiUp ME{ws}; OTID(mtid);
              DYN_TASKS_PRE(mtid, TKT_ID, 8192 / 32, mini::task<mini::EpiUp, 2, 2>(mtid, (const bf16*)(ws + WS_XBS), g.Bt, 2048, 32 * t, (LAS float*)F.lds, ME)); }
        TS_MARK(5); } SEAM(4);
        if (ON(5)) {
            SITE_IDS(); const int TKT_ID = pr * 12 + 5; (void)TKT_ID;
            unsigned char* const ws = WSP();
            pg8::Gemm g{(const bf16*)(ws + WS_ACT), (const bf16*)(ws + WS_WDN + (size_t)(2 * pr) * 32 * MiB), MP, 2048, 8192}; pg8::StaticOrder S; S.init(MP, 2048, G, bid, 4, 0);
            pg8::EpiRes E{ws, 0};
            pg8::gemm_phase<pg8::EpiRes, pg8::StaticOrder, GP_ALIGN, GP_SP2, true>(F.lds, g, S, E, otid, pg8::Tail{(unsigned*)(ws + WS_CTL) + CW_TKT + 64 * TKT_ID, (unsigned*)(ws + WS_CTL) + CW_CPY, (volatile PG8_LAS unsigned*)(F.MISC + 16), nullptr});
            { mini::EpiRes ME{ws, 0}; OTID(mtid);
              DYN_TASKS_PRE(mtid, TKT_ID, 2048 / 16, mini::task<mini::EpiRes, 1, 4>(mtid, (const bf16*)(ws + WS_HS), g.Bt, 8192, 16 * t, (LAS float*)F.lds, ME)); }
        TS_MARK(6); } SEAM(5);
        if (ON(6)) {
            SITE_IDS(); const int TKT_ID = pr * 12 + 6; (void)TKT_ID;
            unsigned char* const ws = WSP();
            pg8::Gemm g{(const bf16*)(ws + WS_XB), (const bf16*)(ws + WS_WQB + (size_t)pr * 12 * MiB), MP, 3072, 2048}; pg8::StaticOrder S; S.init(MP, 3072, G, bid, WGM_BIG);
            pg8::EpiQKV<true> E{ws, OUTP(), pr};
            pg8::gemm_phase<pg8::EpiQKV<true>, pg8::StaticOrder, GP_ALIGN, GP_SP2>(F.lds, g, S, E, otid, pg8::Tail{(unsigned*)(ws + WS_CTL) + CW_TKT + 64 * TKT_ID, (unsigned*)(ws + WS_CTL) + CW_CPY, (volatile PG8_LAS unsigned*)(F.MISC + 16), nullptr});
            { mini::EpiQKV<true> ME{ws, OUTP(), pr}; OTID(mtid);
              DYN_TASKS_PRE(mtid, TKT_ID, 3072 / 16, mini::task<mini::EpiQKV<true>, 1, 4>(mtid, (const bf16*)(ws + WS_XBS), g.Bt, 2048, 16 * t, (LAS float*)F.lds, ME)); }
        TS_MARK(1); } SEAM(6);
        if (ON(7)) {
            SITE_IDS(); const int TKT_ID = pr * 12 + 7; (void)TKT_ID;
            unsigned char* const ws = WSP(); const bf16* const QB = (const bf16*)(ws + WS_Q); bf16* const OB = (bf16*)(ws + WS_O); const bf16* const KB = (const bf16*)(ws + WS_K); const bf16* const VB = (const bf16*)(ws + WS_V);
            const float* sinks = FPTR(P_BSINK) + pr * 32;
            for (int u = vcu; u < 256; u += G) { const int bk = u >> 3, run = u & 7;
                att::attnB_unit(otid, bk >> 3, bk & 7, run, QB, KB, VB, OB, sinks, alds); }
            __syncthreads();
            OTID(otid2);
            DYN_TASKS(otid2, TKT_ID, 256, att::sample_attn_unit<64, 128, false>(otid2, t >> 5, t & 31, QB, KB, VB, (bf16*)(ws + WS_OS), FPTR(P_CBK) + (size_t)pr * 8 * 128 * 512, FPTR(P_CBV) + (size_t)pr * 8 * 128 * 512, sinks, alds));
            __syncthreads();
        TS_MARK(3); } SEAM(7);
        if (ON(8)) {
            SITE_IDS(); const int TKT_ID = pr * 12 + 8; (void)TKT_ID;
            unsigned char* const ws = WSP();
            pg8::Gemm g{(const bf16*)(ws + WS_O), (const bf16*)(ws + WS_WOB + (size_t)pr * 8 * MiB), MP, 2048, 2048}; pg8::StaticOrder S; S.init(MP, 2048, G, bid, 4);
            pg8::EpiRes E{ws, 1};
            pg8::gemm_phase<pg8::EpiRes, pg8::StaticOrder, GP_ALIGN, GP_SP2>(F.lds, g, S, E, otid, pg8::Tail{(unsigned*)(ws + WS_CTL) + CW_TKT + 64 * TKT_ID, (unsigned*)(ws + WS_CTL) + CW_CPY, (volatile PG8_LAS unsigned*)(F.MISC + 16), (unsigned*)(ws + WS_CTL) + CW_ST + 64 * (2 * pr + 1)});
            { mini::EpiRes ME{ws, 1}; OTID(mtid);
              DYN_TASKS_PRE(mtid, TKT_ID, 2048 / 16, mini::task<mini::EpiRes, 1, 4>(mtid, (const bf16*)(ws + WS_OS), g.Bt, 2048, 16 * t, (LAS float*)F.lds, ME)); }
        TS_MARK(4); } SEAM(8);
        if (ON(9)) {
            SITE_IDS(); const int TKT_ID = pr * 12 + 9; (void)TKT_ID;
            unsigned char* const ws = WSP();
            pg8::Gemm g{(const bf16*)(ws + WS_XB), (const bf16*)(ws + WS_WUP + (size_t)(2 * pr + 1) * 32 * MiB), MP, 8192, 2048}; pg8::StaticOrder S; S.init(MP, 8192, G, bid, WGM_BIG);
            pg8::EpiUp E{ws};
            pg8::gemm_phase<pg8::EpiUp, pg8::StaticOrder, GP_ALIGN, GP_SP2>(F.lds, g, S, E, otid, pg8::Tail{(unsigned*)(ws + WS_CTL) + CW_TKT + 64 * TKT_ID, (unsigned*)(ws + WS_CTL) + CW_CPY, (volatile PG8_LAS unsigned*)(F.MISC + 16), nullptr});
            { mini::EpiUp ME{ws}; OTID(mtid);
              DYN_TASKS_PRE(mtid, TKT_ID, 8192 / 32, mini::task<mini::EpiUp, 2, 2>(mtid, (const bf16*)(ws + WS_XBS), g.Bt, 2048, 32 * t, (LAS float*)F.lds, ME)); }
        TS_MARK(5); } SEAM(9);
        if (ON(10)) {
            SITE_IDS(); const int TKT_ID = pr * 12 + 10; (void)TKT_ID;
            unsigned char* const ws = WSP();
            pg8::Gemm g{(const bf16*)(ws + WS_ACT), (const bf16*)(ws + WS_WDN + (size_t)(2 * pr + 1) * 32 * MiB), MP, 2048, 8192}; pg8::StaticOrder S; S.init(MP, 2048, G, bid, 4, 0);
            pg8::EpiRes E{ws, 0};
            pg8::gemm_phase<pg8::EpiRes, pg8::StaticOrder, GP_ALIGN, GP_SP2, true>(F.lds, g, S, E, otid, pg8::Tail{(unsigned*)(ws + WS_CTL) + CW_TKT + 64 * TKT_ID, (unsigned*)(ws + WS_CTL) + CW_CPY, (volatile PG8_LAS unsigned*)(F.MISC + 16), nullptr});
            { mini::EpiRes ME{ws, 0}; OTID(mtid);
              DYN_TASKS_PRE(mtid, TKT_ID, 2048 / 16, mini::task<mini::EpiRes, 1, 4>(mtid, (const bf16*)(ws + WS_HS), g.Bt, 8192, 16 * t, (LAS float*)F.lds, ME)); }
        TS_MARK(6); } SEAM(10);
    }
    if (ON(11)) { final_norm(F, wave0); if constexpr (ALL) { KARGS(); OTID(ftid); __syncthreads(); fill_until(F, KA, ftid, FW_TASKS, CPY_TASKS); } }
#ifdef TS_DIAG
    TS_MARK(7);
    if constexpr (ALL) { { XcdBarrier b_ = bar; xcd_barrier(b_); } KARGS(); float* const out = OUTP(); __syncthreads(); const float va = (float)TSW[1] * 0.001f;
        OTID(dtid); if (blockIdx.x == TS_BLOCK && dtid == 0) out[(size_t)MP * DM] = va; }
#endif
#undef ON
#undef SEAM
}

extern "C" void kernel_launch(void* const* d_in, const int* in_sizes, int n_in, void* d_out, int out_size, void* d_ws, size_t ws_size, hipStream_t stream) {
    static int grid = 0;
    if (grid == 0) {
        if (n_in != 17 || in_sizes[0] != MP * DM || (size_t)out_size != O_END || ws_size < WS_END) { fprintf(stderr, "kernel_launch: unexpected shapes (n_in %d, in0 %d, out %d, ws %zu)\n", n_in, n_in > 0 ? in_sizes[0] : -1, out_size, ws_size); grid = -1; return; }
        int dev = 0, cus = 0, per_cu = 0;
        if (hipGetDevice(&dev) != hipSuccess || hipDeviceGetAttribute(&cus, hipDeviceAttributeMultiprocessorCount, dev) != hipSuccess) { grid = -1; return; }
#if MK_ONE_LAUNCH
        if (hipFuncSetAttribute((const void*)mk_fwd<-1>, hipFuncAttributeMaxDynamicSharedMemorySize, LDS_BYTES) != hipSuccess) { fprintf(stderr, "kernel_launch: hipFuncSetAttribute failed\n"); grid = -1; return; }
        if (hipOccupancyMaxActiveBlocksPerMultiprocessor(&per_cu, (const void*)mk_fwd<-1>, NWAVES * 64, LDS_BYTES) != hipSuccess || per_cu < 1) { fprintf(stderr, "kernel_launch: occupancy query reports %d workgroups per CU\n", per_cu); grid = -1; return; }
#else
#define SETATTR(s) (hipFuncSetAttribute((const void*)mk_fwd<s>, hipFuncAttributeMaxDynamicSharedMemorySize, LDS_BYTES) == hipSuccess)
        if (!(SETATTR(0) && SETATTR(1) && SETATTR(2) && SETATTR(3) && SETATTR(4) && SETATTR(5) && SETATTR(6) && SETATTR(7) && SETATTR(8) && SETATTR(9) && SETATTR(10) && SETATTR(11))) { fprintf(stderr, "kernel_launch: hipFuncSetAttribute failed\n"); grid = -1; return; }
        per_cu = 1;
#endif
        (void)hipGetLastError();
        grid = cus;
    }
    if (grid < 0) return;
    if (hipMemsetAsync((char*)d_ws + WS_CTL, 0, CTL_ZERO_BYTES, stream) != hipSuccess) return;
    Args a{};
    for (int i = 0; i < 17; ++i) a.in[i] = (const float*)d_in[i];
    a.out = (float*)d_out; a.ws = (unsigned char*)d_ws;
#if MK_ONE_LAUNCH
    a.pr_lo = 0; a.pr_hi = 2;
    hipLaunchKernelGGL(mk_fwd<-1>, dim3(grid), dim3(NWAVES * 64), LDS_BYTES, stream, a);
#else
#define LAUNCH_SITE(s, p0, p1) do { a.pr_lo = (p0); a.pr_hi = (p1); hipLaunchKernelGGL(mk_fwd<s>, dim3(grid), dim3(NWAVES * 64), LDS_BYTES, stream, a); } while (0)
    LAUNCH_SITE(0, 0, 0);
    for (int p = 0; p < 2; ++p) { LAUNCH_SITE(1, p, p + 1); LAUNCH_SITE(2, p, p + 1); LAUNCH_SITE(3, p, p + 1); LAUNCH_SITE(4, p, p + 1); LAUNCH_SITE(5, p, p + 1);
                                  LAUNCH_SITE(6, p, p + 1); LAUNCH_SITE(7, p, p + 1); LAUNCH_SITE(8, p, p + 1); LAUNCH_SITE(9, p, p + 1); LAUNCH_SITE(10, p, p + 1); }
    LAUNCH_SITE(11, 0, 0);
#endif
    const hipError_t le = hipPeekAtLastError();
    if (le != hipSuccess) fprintf(stderr, "kernel_launch: launch failed: %s\n", hipGetErrorName(le));
}
```

```cpp
#include <hip/hip_runtime.h>
#include <cstdio>
#include <cstdint>
template <int K> __device__ __forceinline__ float xl_swz(float v) { return __builtin_bit_cast(float, __builtin_amdgcn_ds_swizzle(__builtin_bit_cast(int, v), (K << 10) | 0x1f)); }
__device__ __forceinline__ void xl_swap32(float& a, float& b) { asm volatile("s_nop 1\n\tv_permlane32_swap_b32 %0, %1" : "+v"(a), "+v"(b)); }
__device__ __forceinline__ float xl_add32(float v) { float a = v, b = v; xl_swap32(a, b); return a + b; }
__device__ __forceinline__ float xl_max32(float v) { float a = v, b = v; xl_swap32(a, b); return fmaxf(a, b); }
__device__ __forceinline__ float xl_wave_sum(float v) { v += xl_swz<1>(v); v += xl_swz<2>(v); v += xl_swz<4>(v); v += xl_swz<8>(v); v += xl_swz<16>(v); return xl_add32(v); }
__device__ __forceinline__ float xl_wave_max(float v) { v = fmaxf(v, xl_swz<1>(v)); v = fmaxf(v, xl_swz<2>(v)); v = fmaxf(v, xl_swz<4>(v)); v = fmaxf(v, xl_swz<8>(v)); v = fmaxf(v, xl_swz<16>(v)); return xl_max32(v); }
__host__ __device__ __forceinline__ size_t samp_toff(int r, int c) { return ((size_t)(((c >> 5) * 8 + (r >> 4)) * 64 + ((c >> 3) & 3) * 16 + (r & 15))) * 8 + (c & 7); }
namespace pg8 {
#define PG8_LAS __attribute__((address_space(3)))
typedef unsigned short bf16_t;
typedef short bf16x8 __attribute__((ext_vector_type(8)));
typedef float f32x4 __attribute__((ext_vector_type(4)));
typedef unsigned u32x4 __attribute__((ext_vector_type(4)));
constexpr int BM = 256, BK = 64, HALF = 128, HTB = HALF * BK * 2  , STAGE_BYTES = 8 * HTB, NXCD = 8, WGM = 8;

__host__ __device__ __forceinline__ int lds_byte(int r, int c) { const int st = (r >> 4) * 2 + (c >> 5), rr = r & 15, cc = c & 31, ob = rr * 64 + cc * 2; return st * 1024 + (ob ^ (((ob >> 9) & 1) << 5)); }
__host__ __device__ __forceinline__ void stage_rc(int b, int& R, int& C) { const int st = b / 1024, sb = b % 1024, swz = sb ^ (((sb >> 9) & 1) << 5); R = (st >> 1) * 16 + swz / 64; C = (st & 1) * 32 + (swz % 64) / 2; }
__host__ __device__ __forceinline__ int perm32(int rho) { const int n = rho >> 4, i = rho & 15; return 8 * (i >> 2) + 4 * n + (i & 3); }

struct Unit { int pm, pn; };
struct Gemm { const bf16_t* A; const bf16_t* Bt; int M, N, K; };

struct StaticOrder {
    int nM, nN, nwg, G, c, wgm, rev;
    __host__ __device__ void init(int M, int N, int G_, int c_, int wgm_ = WGM, int rev_ = 0) { nM = M / BM; nN = N / BM; nwg = nM * nN; G = G_; c = c_; wgm = wgm_; rev = rev_; }
    __host__ __device__ bool next(int i, Unit& u) const {
        const int nr = (nwg + G - 1) / G; if (i >= nr) return false; const long L = (long)(rev ? nr - 1 - i : i) * G + c; if (L >= nwg) return false;
        int wgid = (int)L; { const int q = nwg / NXCD, r = nwg % NXCD, xcd = wgid % NXCD, off = wgid / NXCD; wgid = (xcd < r ? xcd * (q + 1) : r * (q + 1) + (xcd - r) * q) + off; }
        const int nig = wgm * nN, gid = wgid / nig, fm = gid * wgm, gsz = (nM - fm) < wgm ? (nM - fm) : wgm;
        u.pm = fm + ((wgid % nig) % gsz); u.pn = (wgid % nig) / gsz; return true;
    }
    __device__ __forceinline__ void a_ready(const Unit&) const {}
    __device__ __forceinline__ void done(const Unit&) const {}
};

__device__ __forceinline__ unsigned cvt_pk_bf16(float lo, float hi) { unsigned r; asm volatile("v_cvt_pk_bf16_f32 %0, %1, %2" : "=v"(r) : "v"(lo), "v"(hi)); return r; }
typedef float f32x2 __attribute__((ext_vector_type(2)));
__device__ __forceinline__ float row_rstd(const float* SS, int row, int fq) {
    const f32x4* p = (const f32x4*)(SS + (size_t)row * 32 + fq * 8); const f32x4 a = p[0], b = p[1];
    float s = ((a[0] + a[1]) + (a[2] + a[3])) + ((b[0] + b[1]) + (b[2] + b[3]));
    s += xl_swz<16>(s); s = xl_add32(s);
    return __builtin_amdgcn_rsqf(s * (1.0f / 2048.0f) + 1e-6f);
}
constexpr int ROWS_P = 32768, ROWS_R = 32896;
constexpr size_t WS_XB_ = (size_t)361 << 20, WS_SS0_ = (size_t)490 << 20, WS_SS1_ = (size_t)495 << 20, WS_Q_ = (size_t)500 << 20, WS_K_ = (size_t)629 << 20, WS_V_ = (size_t)758 << 20;
template <bool ISB> struct EpiQKV {
    static constexpr bool PERM = true, AFTER_DRAIN = false;
    unsigned char* ws; float* out; int pr;
    __device__ __forceinline__ void operator()(const f32x4 (&acc)[2][2][4][2], const Unit& u, int wr, int wc, int fr, int fq) const {
        constexpr int nkv = ISB ? 512 : 2048;
        constexpr float qscale = (ISB ? 0.125f : 0.08838834764831845f) * 1.4426950408889634f;
        const float* SS = (const float*)(ws + WS_SS0_);
        const int colt = u.pn * BM; const int region = colt < 2048 ? 0 : (colt < 2048 + nkv ? 1 : 2);
        const int cbase = (region == 0 ? colt : (region == 1 ? colt - 2048 : colt - 2048 - nkv)) + wc * 32 + 8 * fq;
        bf16_t* const ob = (bf16_t*)(ws + (region == 0 ? WS_Q_ : (region == 1 ? WS_K_ : WS_V_))); const int ld = region == 0 ? 2048 : nkv;
        const float sc = region == 0 ? qscale : 1.0f;
#pragma unroll
        for (int ai = 0; ai < 2; ++ai)
#pragma unroll
            for (int m = 0; m < 4; ++m) {
                const int row = u.pm * BM + ai * HALF + wr * 64 + m * 16 + fr;
                const float rs = row_rstd(SS, row, fq) * sc;
#pragma unroll
                for (int bj = 0; bj < 2; ++bj) {
                    const f32x4 v0 = acc[ai][bj][m][0] * rs, v1 = acc[ai][bj][m][1] * rs; const int col = cbase + bj * HALF;
                    u32x4 w; w.x = cvt_pk_bf16(v0[0], v0[1]); w.y = cvt_pk_bf16(v0[2], v0[3]); w.z = cvt_pk_bf16(v1[0], v1[1]); w.w = cvt_pk_bf16(v1[2], v1[3]);
                    *(u32x4*)(ob + (size_t)row * ld + col) = w;
                }
            }
    }
};
__device__ __forceinline__ float bf_lo(unsigned w) { return __builtin_bit_cast(float, w << 16); }
__device__ __forceinline__ float bf_hi(unsigned w) { return __builtin_bit_cast(float, w & 0xffff0000u); }
struct EpiRes {
    static constexpr bool PERM = true, AFTER_DRAIN = false;
    unsigned char* ws; int sssel;
    __device__ __forceinline__ void operator()(const f32x4 (&acc)[2][2][4][2], const Unit& u, int wr, int wc, int fr, int fq) const {
        const int col0 = u.pn * BM + wc * 32 + 8 * fq; bf16_t* const XB = (bf16_t*)(ws + WS_XB_); float* const SSout = (float*)(ws + (sssel ? WS_SS1_ : WS_SS0_));
#pragma unroll
        for (int ai = 0; ai < 2; ++ai)
#pragma unroll
            for (int m = 0; m < 4; ++m) {
                const int row = u.pm * BM + ai * HALF + wr * 64 + m * 16 + fr;
                float ssq = 0.f;
#pragma unroll
                for (int bj = 0; bj < 2; ++bj) { u32x4* const px = (u32x4*)(XB + (size_t)row * 2048 + col0 + bj * HALF);
                    const u32x4 xo = *px; const f32x4 a0 = acc[ai][bj][m][0], a1 = acc[ai][bj][m][1];
                    u32x4 w; w.x = cvt_pk_bf16(bf_lo(xo.x) + a0[0], bf_hi(xo.x) + a0[1]); w.y = cvt_pk_bf16(bf_lo(xo.y) + a0[2], bf_hi(xo.y) + a0[3]);
                    w.z = cvt_pk_bf16(bf_lo(xo.z) + a1[0], bf_hi(xo.z) + a1[1]); w.w = cvt_pk_bf16(bf_lo(xo.w) + a1[2], bf_hi(xo.w) + a1[3]);
                    *px = w;
                    const float r0 = bf_lo(w.x), r1 = bf_hi(w.x), r2 = bf_lo(w.y), r3 = bf_hi(w.y), r4 = bf_lo(w.z), r5 = bf_hi(w.z), r6 = bf_lo(w.w), r7 = bf_hi(w.w);
                    ssq += ((r0 * r0 + r1 * r1) + (r2 * r2 + r3 * r3)) + ((r4 * r4 + r5 * r5) + (r6 * r6 + r7 * r7)); }
                ssq += xl_swz<16>(ssq); ssq = xl_add32(ssq);
                if (fq == 0) SSout[(size_t)row * 32 + u.pn * 4 + wc] = ssq;
            }
    }
};
struct EpiUp {
    static constexpr bool PERM = true, AFTER_DRAIN = false;
    unsigned char* ws;
    __device__ __forceinline__ void operator()(const f32x4 (&acc)[2][2][4][2], const Unit& u, int wr, int wc, int fr, int fq) const {
        const int col0 = u.pn * BM + wc * 32 + 8 * fq; bf16_t* const H = (bf16_t*)(ws + WS_Q_); const float* const SS = (const float*)(ws + WS_SS1_);
#pragma unroll
        for (int ai = 0; ai < 2; ++ai)
#pragma unroll
            for (int m = 0; m < 4; ++m) {
                const int row = u.pm * BM + ai * HALF + wr * 64 + m * 16 + fr;
                const float rs = row_rstd(SS, row, fq);
#pragma unroll
                for (int bj = 0; bj < 2; ++bj) {
                    f32x4 v0 = acc[ai][bj][m][0] * rs, v1 = acc[ai][bj][m][1] * rs;
#pragma unroll
                    for (int e = 0; e < 4; ++e) { const float a = fmaxf(v0[e], 0.f), b = fmaxf(v1[e], 0.f); v0[e] = a * a; v1[e] = b * b; }
                    u32x4 w; w.x = cvt_pk_bf16(v0[0], v0[1]); w.y = cvt_pk_bf16(v0[2], v0[3]); w.z = cvt_pk_bf16(v1[0], v1[1]); w.w = cvt_pk_bf16(v1[2], v1[3]);
                    { const int col = col0 + bj * HALF; __builtin_nontemporal_store(w, (u32x4*)(H + (size_t)(col >> 6) * ((size_t)ROWS_P * 64) + (size_t)row * 64 + (col & 63))); }
                }
            }
    }
};
struct Tail { unsigned* tk; unsigned* fc; volatile PG8_LAS unsigned* slot; unsigned* st; };
template <class Epi, class Sched, bool ALIGN_EPI = false, bool SP2 = false, bool ATILED = false>
__device__ __forceinline__ void gemm_phase(PG8_LAS unsigned char* lds, const Gemm g, const Sched& S, const Epi& E, const int tid_in, const Tail T);
template <class Epi, class Sched, bool ALIGN_EPI, bool SP2, bool ATILED>
__device__ __forceinline__ void gemm_phase(PG8_LAS unsigned char* lds, const Gemm g, const Sched& S, const Epi& E, const int tid_in, const Tail T) {
    int tid_ = tid_in; asm volatile("" : "+v"(tid_));
    const int tid = tid_, wid = __builtin_amdgcn_readfirstlane(tid >> 6), lane = tid & 63, wr = wid >> 2, wc = wid & 3, fr = lane & 15, fq = lane >> 4;
    const int K = g.K, nt = K / BK;
    unsigned voffA[2], voffB[2];
#pragma unroll
    for (int i = 0; i < 2; ++i) { int R, C; stage_rc(tid * 16 + i * 8192, R, C); const int Rb = Epi::PERM ? ((R & ~31) + perm32(R & 31)) : R;
        voffA[i] = ATILED ? (unsigned)(R * BK + C) * 2u : (unsigned)(R * K + C) * 2u; voffB[i] = (unsigned)(Rb * K + C) * 2u; }
    const size_t kstep = (size_t)(BK * 2);
    const size_t hstep = (size_t)HALF * K * 2;
    const size_t tstep = 2 * hstep;
    const size_t kstepA = ATILED ? (size_t)g.M * BK * 2 : kstep, hstepA = ATILED ? (size_t)HALF * BK * 2 : hstep, tstepA = 2 * hstepA;
    const unsigned ldsw = (unsigned)wid * 1024u;
    const int aoff = lds_byte(wr * 64 + fr, fq * 8), boff = lds_byte(wc * 32 + fr, fq * 8);
#define PG8_SA(b, h) (((b) * 2 + (h)) * HTB)
#define PG8_SB(b, h) ((4 + (b) * 2 + (h)) * HTB)
#define PG8_STAGE(bufoff, gbase, voff) do { _Pragma("unroll") for (int _i = 0; _i < 2; ++_i) \
        __builtin_amdgcn_global_load_lds((const unsigned*)((const char*)(gbase) + (voff)[_i]), (PG8_LAS unsigned*)(lds + (bufoff) + ldsw + _i * 8192), 16, 0, 0); } while (0)
#define PG8_LDA(dst, b, h) do { _Pragma("unroll") for (int m = 0; m < 4; ++m) _Pragma("unroll") for (int k = 0; k < 2; ++k) dst[m][k] = *(const PG8_LAS bf16x8*)(lds + PG8_SA(b, h) + aoff + m * 2048 + k * 1024); } while (0)
#define PG8_LDB(dst, b, h) do { _Pragma("unroll") for (int n = 0; n < 2; ++n) _Pragma("unroll") for (int k = 0; k < 2; ++k) dst[n][k] = *(const PG8_LAS bf16x8*)(lds + PG8_SB(b, h) + boff + n * 2048 + k * 1024); } while (0)
#define PG8_MMA(ai, bj, At, Bt) do { __builtin_amdgcn_s_setprio(1); _Pragma("unroll") for (int m = 0; m < 4; ++m) _Pragma("unroll") for (int n = 0; n < 2; ++n) _Pragma("unroll") for (int k = 0; k < 2; ++k) \
        acc[ai][bj][m][n] = __builtin_amdgcn_mfma_f32_16x16x32_bf16(Bt[n][k], At[m][k], acc[ai][bj][m][n], 0, 0, 0); __builtin_amdgcn_s_setprio(0); } while (0)
#define PG8_WAIT_V(n) asm volatile("s_waitcnt vmcnt(" #n ")" ::: "memory")
#define PG8_WAIT_L(n) asm volatile("s_waitcnt lgkmcnt(" #n ")" ::: "memory")
#define PG8_BAR __builtin_amdgcn_s_barrier()
#define PG8_SCHED __builtin_amdgcn_sched_barrier(0)
    Unit cur, nxt; int ui = 0;
    if (!S.next(0, cur)) return;
    f32x4 acc[2][2][4][2];
#pragma unroll
    for (int a = 0; a < 2; ++a)
#pragma unroll
        for (int b = 0; b < 2; ++b)
#pragma unroll
            for (int m = 0; m < 4; ++m)
#pragma unroll
                for (int n = 0; n < 2; ++n) acc[a][b][m][n] = (f32x4){0.f, 0.f, 0.f, 0.f};
    bf16x8 At[4][2], B0[2][2], B1[2][2];
    const char* cA = (const char*)g.A + (size_t)cur.pm * tstepA; const char* cB = (const char*)g.Bt + (size_t)cur.pn * tstep;
    S.a_ready(cur);
    if constexpr (SP2) {
        PG8_STAGE(PG8_SB(0, 0), cB, voffB); PG8_STAGE(PG8_SB(0, 1), cB + hstep, voffB); PG8_STAGE(PG8_SA(0, 0), cA, voffA); PG8_STAGE(PG8_SA(0, 1), cA + hstepA, voffA);
        if (wr == 1) PG8_BAR;
        PG8_WAIT_V(2); PG8_BAR;
        PG8_STAGE(PG8_SB(1, 0), cB + kstep, voffB); PG8_STAGE(PG8_SA(1, 0), cA + kstepA, voffA); PG8_STAGE(PG8_SB(1, 1), cB + hstep + kstep, voffB);
        PG8_WAIT_V(6); PG8_BAR;
    } else {
        PG8_STAGE(PG8_SB(0, 0), cB, voffB); PG8_STAGE(PG8_SA(0, 0), cA, voffA); PG8_STAGE(PG8_SB(0, 1), cB + hstep, voffB); PG8_STAGE(PG8_SA(0, 1), cA + hstepA, voffA);
        if (wr == 1) PG8_BAR;
        PG8_WAIT_V(4); PG8_BAR;
        PG8_STAGE(PG8_SB(1, 0), cB + kstep, voffB); PG8_STAGE(PG8_SA(1, 0), cA + kstepA, voffA); PG8_STAGE(PG8_SB(1, 1), cB + hstep + kstep, voffB);
        PG8_WAIT_V(6); PG8_BAR;
    }
    for (;;) {
        const bool has_next = S.next(ui + 1, nxt);
        const char* nA = has_next ? (const char*)g.A + (size_t)nxt.pm * tstepA : cA; const char* nB = has_next ? (const char*)g.Bt + (size_t)nxt.pn * tstep : cB;
        for (int t = 0; t < nt; t += 2) {
            const bool last = (t == nt - 2);
            const char* a1 = cA + (size_t)(t + 1) * kstepA;
            const char* a2 = last ? nA : cA + (size_t)(t + 2) * kstepA; const char* b2 = last ? nB : cB + (size_t)(t + 2) * kstep;
            const char* a3 = a2 + kstepA; const char* b3 = b2 + kstep;
            if (last && has_next) S.a_ready(nxt);
            if constexpr (SP2) {
            PG8_LDB(B0, 0, 0); PG8_LDB(B1, 0, 1); PG8_SCHED; PG8_LDA(At, 0, 0); PG8_STAGE(PG8_SA(1, 1), a1 + hstepA, voffA);
            PG8_WAIT_V(8); PG8_WAIT_L(0); PG8_BAR; PG8_MMA(0, 0, At, B0); PG8_MMA(0, 1, At, B1); PG8_BAR; PG8_SCHED;
            PG8_LDA(At, 0, 1); PG8_STAGE(PG8_SB(0, 0), b2, voffB); PG8_STAGE(PG8_SB(0, 1), b2 + hstep, voffB); PG8_STAGE(PG8_SA(0, 0), a2, voffA);
            PG8_WAIT_V(8); PG8_WAIT_L(0); PG8_BAR; PG8_MMA(1, 0, At, B0); PG8_MMA(1, 1, At, B1); PG8_BAR; PG8_SCHED;
            PG8_LDB(B0, 1, 0); PG8_LDB(B1, 1, 1); PG8_SCHED; PG8_LDA(At, 1, 0); PG8_STAGE(PG8_SA(0, 1), a2 + hstepA, voffA);
            PG8_WAIT_V(8); PG8_WAIT_L(0); PG8_BAR; PG8_MMA(0, 0, At, B0); PG8_MMA(0, 1, At, B1); PG8_BAR; PG8_SCHED;
            PG8_LDA(At, 1, 1); PG8_STAGE(PG8_SB(1, 0), b3, voffB); PG8_STAGE(PG8_SB(1, 1), b3 + hstep, voffB); PG8_STAGE(PG8_SA(1, 0), a3, voffA);
            PG8_WAIT_V(8); PG8_WAIT_L(0); PG8_BAR; PG8_MMA(1, 0, At, B0); PG8_MMA(1, 1, At, B1); PG8_BAR; PG8_SCHED;
            } else {
            PG8_LDB(B0, 0, 0); PG8_SCHED; PG8_LDA(At, 0, 0); PG8_STAGE(PG8_SA(1, 1), a1 + hstepA, voffA);
            PG8_WAIT_L(8); PG8_BAR; PG8_WAIT_L(0); PG8_MMA(0, 0, At, B0); PG8_BAR; PG8_SCHED;
            PG8_LDB(B1, 0, 1); PG8_STAGE(PG8_SB(0, 0), b2, voffB);
            PG8_BAR; PG8_WAIT_L(0); PG8_MMA(0, 1, At, B1); PG8_BAR;
            PG8_LDA(At, 0, 1); PG8_STAGE(PG8_SA(0, 0), a2, voffA);
            PG8_BAR; PG8_WAIT_L(0); PG8_MMA(1, 0, At, B0); PG8_BAR; PG8_SCHED;
            PG8_STAGE(PG8_SB(0, 1), b2 + hstep, voffB);
            PG8_WAIT_V(6); PG8_BAR; PG8_MMA(1, 1, At, B1); PG8_BAR;
            PG8_LDB(B0, 1, 0); PG8_SCHED; PG8_LDA(At, 1, 0); PG8_STAGE(PG8_SA(0, 1), a2 + hstepA, voffA);
            PG8_WAIT_L(8); PG8_BAR; PG8_WAIT_L(0); PG8_MMA(0, 0, At, B0); PG8_BAR; PG8_SCHED;
            PG8_LDB(B1, 1, 1); PG8_STAGE(PG8_SB(1, 0), b3, voffB);
            PG8_BAR; PG8_WAIT_L(0); PG8_MMA(0, 1, At, B1); PG8_BAR;
            PG8_LDA(At, 1, 1); PG8_STAGE(PG8_SA(1, 0), a3, voffA);
            PG8_BAR; PG8_WAIT_L(0); PG8_MMA(1, 0, At, B0); PG8_BAR; PG8_SCHED;
            PG8_STAGE(PG8_SB(1, 1), b3 + hstep, voffB);
            PG8_WAIT_V(6); PG8_BAR; PG8_MMA(1, 1, At, B1); PG8_BAR;
            }
        }
        if constexpr (ALIGN_EPI) { if (wr == 0) PG8_BAR; }
        unsigned tk1_ = 0u, fc1_ = 0u, st1_ = 0u;
        if (!has_next && tid == 0) { tk1_ = __hip_atomic_fetch_add((__attribute__((address_space(1))) unsigned*)T.tk, 1u, __ATOMIC_RELAXED, __HIP_MEMORY_SCOPE_AGENT); fc1_ = __hip_atomic_load((__attribute__((address_space(1))) unsigned*)T.fc, __ATOMIC_RELAXED, __HIP_MEMORY_SCOPE_AGENT);
            if (T.st) st1_ = __hip_atomic_load((__attribute__((address_space(1))) unsigned*)T.st, __ATOMIC_RELAXED, __HIP_MEMORY_SCOPE_AGENT); }
        if constexpr (!Epi::AFTER_DRAIN) { E(acc, cur, wr, wc, fr, fq); S.done(cur); }
        if (!has_next && tid == 0) { T.slot[0] = tk1_; T.slot[2] = fc1_; T.slot[3] = st1_; }
        if (!has_next) break;
#pragma unroll
        for (int a = 0; a < 2; ++a)
#pragma unroll
            for (int b = 0; b < 2; ++b)
#pragma unroll
                for (int m = 0; m < 4; ++m)
#pragma unroll
                    for (int n = 0; n < 2; ++n) acc[a][b][m][n] = (f32x4){0.f, 0.f, 0.f, 0.f};
        cur = nxt; cA = nA; cB = nB; ++ui;
        if constexpr (ALIGN_EPI) { if (wr == 1) PG8_BAR; }
    }
    PG8_WAIT_V(0);
    if constexpr (!ALIGN_EPI) { if (wr == 0) PG8_BAR; }
    PG8_BAR;
    if constexpr (Epi::AFTER_DRAIN) { E.fused(acc, cur, wr, wc, fr, fq, lds, wid, lane); S.done(cur); }
#undef PG8_SA
#undef PG8_SB
#undef PG8_STAGE
#undef PG8_LDA
#undef PG8_LDB
#undef PG8_MMA
#undef PG8_WAIT_V
#undef PG8_WAIT_L
#undef PG8_BAR
#undef PG8_SCHED
}
}
namespace att {
using bf16 = unsigned short;
using bf16x8 = __attribute__((ext_vector_type(8))) short;
using s16x4  = __attribute__((ext_vector_type(4))) short;
using f32x16 = __attribute__((ext_vector_type(16))) float;
using f32x4v = __attribute__((ext_vector_type(4))) float;
using u32x4  = __attribute__((ext_vector_type(4))) unsigned;
using u32x2  = __attribute__((ext_vector_type(2))) unsigned;
#define ALAS __attribute__((address_space(3)))
#define SBAR() __builtin_amdgcn_sched_barrier(0)
constexpr float LOG2E = 1.4426950408889634f;
constexpr float THR2 = 10.0f;
__device__ __forceinline__ int crow(int r, int hi) { return (r & 3) + 8 * (r >> 2) + 4 * hi; }
__device__ __forceinline__ unsigned cvtpk(float lo, float hi) { unsigned r; asm volatile("v_cvt_pk_bf16_f32 %0, %1, %2" : "=v"(r) : "v"(lo), "v"(hi)); return r; }
__device__ __forceinline__ float bf2f(unsigned short h) { return __uint_as_float((unsigned)h << 16); }
template <int HD> __device__ __forceinline__ int kswz(int row, int colB) {
    if constexpr (HD == 128) return row * 256 + (colB ^ ((row & 15) << 4));
    else return row * 128 + (colB ^ (((row >> 1) & 7) << 4));
}
template <int HD> __device__ __forceinline__ void qkt(f32x16& p0, f32x16& p1, const ALAS char* Ks, const bf16x8* qr, int r32, int hi) {
    p0 = f32x16{}; p1 = f32x16{};
#pragma unroll
    for (int d0 = 0; d0 < HD / 16; ++d0) { const int cb = (d0 * 16 + hi * 8) * 2;
        const bf16x8 b0 = *(const ALAS bf16x8*)(Ks + kswz<HD>(r32, cb));
        const bf16x8 b1 = *(const ALAS bf16x8*)(Ks + kswz<HD>(32 + r32, cb));
        p0 = __builtin_amdgcn_mfma_f32_32x32x16_bf16(b0, qr[d0], p0, 0, 0, 0);
        p1 = __builtin_amdgcn_mfma_f32_32x32x16_bf16(b1, qr[d0], p1, 0, 0, 0); }
}
template <int NCB> __device__ __forceinline__ int v_st(int k, int c) { const int kk = (k & ~0xC) | ((k & 4) << 1) | ((k & 8) >> 1); return ((kk >> 3) * NCB + (c >> 5)) * 512 + ((kk & 7) * 32 + (c & 31)) * 2; }
__device__ __forceinline__ int v_rd_base(int lane) { return ((lane & 3) << 3) | (((lane >> 2) & 3) << 6) | (((lane >> 4) & 1) << 5) | (((lane >> 5) & 1) << 8); }
template <int NCB> constexpr int v_rd_off(int d0, int ks, int half) { return d0 * 512 + ks * (NCB * 1024) + half * (NCB * 512); }
template <int OFF> __device__ __forceinline__ s16x4 tr_read(int vb) { s16x4 r; asm volatile("ds_read_b64_tr_b16 %0, %1 offset:%2" : "=&v"(r) : "v"(vb), "i"(OFF) : "memory"); return r; }
template <int NCB, int D0> __device__ __forceinline__ void pv_one(f32x16& od, int vb, bf16x8 pa0, bf16x8 pa1, bf16x8 pa2, bf16x8 pa3) {
    const s16x4 l0 = tr_read<v_rd_off<NCB>(D0, 0, 0)>(vb), h0 = tr_read<v_rd_off<NCB>(D0, 0, 1)>(vb), l1 = tr_read<v_rd_off<NCB>(D0, 1, 0)>(vb), h1 = tr_read<v_rd_off<NCB>(D0, 1, 1)>(vb);
    const s16x4 l2 = tr_read<v_rd_off<NCB>(D0, 2, 0)>(vb), h2 = tr_read<v_rd_off<NCB>(D0, 2, 1)>(vb), l3 = tr_read<v_rd_off<NCB>(D0, 3, 0)>(vb), h3 = tr_read<v_rd_off<NCB>(D0, 3, 1)>(vb);
    asm volatile("s_waitcnt lgkmcnt(0)" ::: "memory"); SBAR();
#define PK(L, H) (bf16x8){L[0], L[1], L[2], L[3], H[0], H[1], H[2], H[3]}
    od = __builtin_amdgcn_mfma_f32_32x32x16_bf16(pa0, PK(l0, h0), od, 0, 0, 0);
    od = __builtin_amdgcn_mfma_f32_32x32x16_bf16(pa1, PK(l1, h1), od, 0, 0, 0);
    od = __builtin_amdgcn_mfma_f32_32x32x16_bf16(pa2, PK(l2, h2), od, 0, 0, 0);
    od = __builtin_amdgcn_mfma_f32_32x32x16_bf16(pa3, PK(l3, h3), od, 0, 0, 0);
#undef PK
}
__device__ __forceinline__ void softmax_tile(f32x16& p0, f32x16& p1, float& m_reg, float& l_reg, float& alpha, bf16x8& pa0, bf16x8& pa1, bf16x8& pa2, bf16x8& pa3) {
    float pmax = p0[0];
#pragma unroll
    for (int r = 1; r < 16; ++r) pmax = fmaxf(pmax, p0[r]);
#pragma unroll
    for (int r = 0; r < 16; ++r) pmax = fmaxf(pmax, p1[r]);
    { auto rr = __builtin_amdgcn_permlane32_swap(__float_as_uint(pmax), __float_as_uint(pmax), false, false); pmax = fmaxf(__uint_as_float(rr[0]), __uint_as_float(rr[1])); }
    if (__all(pmax - m_reg <= THR2)) { alpha = 1.f; }
    else { const float mn = fmaxf(m_reg, pmax); alpha = __builtin_amdgcn_exp2f(m_reg - mn); m_reg = mn; }
    float ps = 0.f;
#pragma unroll
    for (int r = 0; r < 16; ++r) { p0[r] = __builtin_amdgcn_exp2f(p0[r] - m_reg); p1[r] = __builtin_amdgcn_exp2f(p1[r] - m_reg); }
#pragma unroll
    for (int r = 0; r < 16; ++r) ps += p0[r];
#pragma unroll
    for (int r = 0; r < 16; ++r) ps += p1[r];
    { auto rr = __builtin_amdgcn_permlane32_swap(__float_as_uint(ps), __float_as_uint(ps), false, false); ps = __uint_as_float(rr[0]) + __uint_as_float(rr[1]); }
    l_reg = l_reg * alpha + ps;
#define PK4(P, BASE, OUT) do { unsigned a0 = cvtpk(P[BASE + 0], P[BASE + 1]), a1 = cvtpk(P[BASE + 2], P[BASE + 3]);   \
    unsigned b0 = cvtpk(P[BASE + 4], P[BASE + 5]), b1 = cvtpk(P[BASE + 6], P[BASE + 7]);                              \
    auto r0 = __builtin_amdgcn_permlane32_swap(a0, b0, false, false); auto r1 = __builtin_amdgcn_permlane32_swap(a1, b1, false, false); \
    u32x4 w = {r0[0], r1[0], r0[1], r1[1]}; OUT = __builtin_bit_cast(bf16x8, w); } while (0)
    PK4(p0, 0, pa0); PK4(p0, 8, pa1); PK4(p1, 0, pa2); PK4(p1, 8, pa3);
#undef PK4
}
template <int NB> __device__ __forceinline__ void rescale_o(f32x16* o, float alpha, ALAS float* al_l, int r32, int hi) {
    if (__any(alpha < 1.f && alpha > 0.f)) {
        if (hi == 0) al_l[r32] = alpha;
        asm volatile("s_waitcnt lgkmcnt(0)" ::: "memory");
#pragma unroll
        for (int r = 0; r < 16; ++r) { const float a = al_l[crow(r, hi)];
#pragma unroll
            for (int d = 0; d < NB; ++d) o[d][r] *= a; }
        asm volatile("s_waitcnt lgkmcnt(0)" ::: "memory");
    }
}
template <int NB> __device__ __forceinline__ void store_o(const f32x16* o, float l_tot, ALAS float* li_l, ALAS char* stg, bf16* Ow, int lane, int r32, int hi) {
    if (hi == 0) li_l[r32] = l_tot;
    asm volatile("s_waitcnt lgkmcnt(0)" ::: "memory");
#pragma unroll
    for (int r = 0; r < 16; ++r) { const int orow = crow(r, hi); const float rl = __builtin_amdgcn_rcpf(li_l[orow]);
#pragma unroll
        for (int d0 = 0; d0 < NB; ++d0) { const unsigned w = cvtpk(o[d0][r] * rl, 0.f); *(ALAS unsigned short*)(stg + orow * (64 * NB) + (d0 * 32 + r32) * 2) = (unsigned short)(w & 0xffffu); } }
    asm volatile("s_waitcnt lgkmcnt(0)" ::: "memory");
    constexpr int CPR = 4 * NB, RPI = 64 / CPR;
#pragma unroll
    for (int i = 0; i < 32 / RPI; ++i) { const int row = i * RPI + lane / CPR, ch = lane % CPR;
        const u32x4 v = *(const ALAS u32x4*)(stg + row * (64 * NB) + ch * 16); *(u32x4*)(Ow + (size_t)row * 2048 + ch * 8) = v; }
    asm volatile("s_waitcnt lgkmcnt(0)" ::: "memory");
}

constexpr int ATTA_LDS = 98304 + 2048 + 1040;
__device__ __forceinline__ void attnA_unit(const int tid, int b, int h, int qb, const bf16* Qb, const bf16* Kb, const bf16* Vb, bf16* Ob, const float* tabsrc, ALAS char* lds) {
    constexpr int HD = 128, LD = 2048, TB = 16384;
    const int lane = tid & 63, r32 = lane & 31, hi = lane >> 5; const int wid = __builtin_amdgcn_readfirstlane(tid >> 6);
    ALAS char* V_lds = lds; ALAS char* K_lds = lds + 3 * TB;
    ALAS float* wsf = (ALAS float*)(lds + 6 * TB) + wid * 64; ALAS float* tab = (ALAS float*)(lds + 6 * TB + 2048);
    if (tid < 257) tab[tid] = tabsrc[tid] * LOG2E;
    const int c0 = qb * 4, co = wid >> 1, c = c0 + co, rh = wid & 1;
    const size_t rowbase = (size_t)b * 8192;
    const bf16* Qw = Qb + (rowbase + c * 64 + rh * 32 + r32) * LD + h * HD + hi * 8;
    bf16x8 qr[8];
#pragma unroll
    for (int d0 = 0; d0 < 8; ++d0) qr[d0] = *(const bf16x8*)(Qw + d0 * 16);
    const int kc_lo = c0 - 8 > 0 ? c0 - 8 : 0, NT = c0 + 3 - kc_lo + 1;
    const int my_lo = c - 8 > 0 ? c - 8 : 0, my_hi = c;
    const int krow = 4 * wid + (lane >> 4), kchunk = (lane & 15) ^ (krow & 15);
    const int vkk = (wid >> 1) * 8 + ((lane & 31) >> 2), vkey = (vkk & ~0xC) | ((vkk & 4) << 1) | ((vkk & 8) >> 1), vcol = (2 * (wid & 1) + (lane >> 5)) * 32 + (lane & 3) * 8;
    const bf16* Kh = Kb + rowbase * LD + h * HD + (size_t)krow * LD + kchunk * 8; const bf16* Vh = Vb + rowbase * LD + h * HD + (size_t)vkey * LD + vcol;
    const int vb0 = (int)(unsigned)(uintptr_t)V_lds + v_rd_base(lane);
#define SDMA(kc, bf) do { const size_t o_ = (size_t)(kc) * 64 * LD; \
        __builtin_amdgcn_global_load_lds((const unsigned*)(Kh + o_), (ALAS unsigned*)(K_lds + (bf) * TB + wid * 1024), 16, 0, 0); \
        __builtin_amdgcn_global_load_lds((const unsigned*)(Kh + o_ + 32 * LD), (ALAS unsigned*)(K_lds + (bf) * TB + (wid + 8) * 1024), 16, 0, 0); \
        __builtin_amdgcn_global_load_lds((const unsigned*)(Vh + o_), (ALAS unsigned*)(V_lds + (bf) * TB + wid * 1024), 16, 0, 0); \
        __builtin_amdgcn_global_load_lds((const unsigned*)(Vh + o_ + 32 * LD), (ALAS unsigned*)(V_lds + (bf) * TB + (wid + 8) * 1024), 16, 0, 0); } while (0)
    float m_reg = -1e30f, l_reg = 0.f; f32x16 o[4] = {f32x16{}, f32x16{}, f32x16{}, f32x16{}};
    const int qloc = rh * 32 + r32;
    SDMA(kc_lo, 0); if (NT > 1) { SDMA(kc_lo + 1, 1); asm volatile("s_waitcnt vmcnt(4)" ::: "memory"); } else { asm volatile("s_waitcnt vmcnt(0)" ::: "memory"); }
    __syncthreads();
    int cur = 0;
    for (int t = 0; t < NT; ++t) {
        const int kc = kc_lo + t; const int nx2 = cur == 0 ? 2 : cur - 1;
        if (t + 2 < NT) SDMA(kc + 2, nx2);
        if (kc >= my_lo && kc <= my_hi) {
            f32x16 p0, p1; qkt<HD>(p0, p1, K_lds + cur * TB, qr, r32, hi);
            const int dc = kc - c;
            if (dc <= -3) { const float bb = tab[0];
#pragma unroll
                for (int r = 0; r < 16; ++r) { p0[r] += bb; p1[r] += bb; } }
            else { const int base = (dc + 2) * 64 - qloc + 4 * hi;
#pragma unroll
                for (int r = 0; r < 16; ++r) { const int i0 = base + (r & 3) + 8 * (r >> 2), i1 = i0 + 32; p0[r] += tab[i0 > 0 ? i0 : 0]; p1[r] += tab[i1 > 0 ? i1 : 0]; } }
            float alpha; bf16x8 pa0, pa1, pa2, pa3;
            softmax_tile(p0, p1, m_reg, l_reg, alpha, pa0, pa1, pa2, pa3);
            rescale_o<4>(o, alpha, wsf, r32, hi);
            const int vb = vb0 + cur * TB;
            pv_one<4, 0>(o[0], vb, pa0, pa1, pa2, pa3); pv_one<4, 1>(o[1], vb, pa0, pa1, pa2, pa3); pv_one<4, 2>(o[2], vb, pa0, pa1, pa2, pa3); pv_one<4, 3>(o[3], vb, pa0, pa1, pa2, pa3);
        }
        if (t + 2 < NT) { asm volatile("s_waitcnt vmcnt(4)" ::: "memory"); } else { asm volatile("s_waitcnt vmcnt(0)" ::: "memory"); }
        __syncthreads();
        cur = cur == 2 ? 0 : cur + 1;
    }
#undef SDMA
    store_o<4>(o, l_reg, wsf, lds + wid * 8192, Ob + (rowbase + c * 64 + rh * 32) * LD + h * HD, lane, r32, hi);
    asm volatile("s_waitcnt lgkmcnt(0)" ::: "memory");
    __builtin_amdgcn_s_barrier();
    asm volatile("" ::: "memory");
}

constexpr int ATTB_RC = 16, ATTB_LDS = 65536 + 2048 + 32768;
__device__ __forceinline__ void attnB_unit(const int tid, int b, int kvh, int run, const bf16* Qb, const bf16* Kb, const bf16* Vb, bf16* Ob, const float* sinks, ALAS char* lds) {
    constexpr int HD = 64, LDQ = 2048, LDK = 512, TB = 8192;
    const int lane = tid & 63, r32 = lane & 31, hi = lane >> 5; const int wid = __builtin_amdgcn_readfirstlane(tid >> 6);
    ALAS char* K_lds = lds; ALAS char* V_lds = lds + 4 * TB; ALAS float* wsf = (ALAS float*)(lds + 8 * TB) + wid * 64;
    const int qh = kvh * 4 + (wid >> 1), rh = wid & 1;
    const float slope2 = __builtin_amdgcn_exp2f(-0.25f * (float)(qh + 1)) * LOG2E, sink2 = sinks[qh] * LOG2E;
    const size_t rowbase = (size_t)b * 8192;
    const int krow = 8 * wid + (lane >> 3), kchunk = (lane & 7) ^ ((krow >> 1) & 7);
    const int vkk = wid * 8 + ((lane & 31) >> 2), vkey = (vkk & ~0xC) | ((vkk & 4) << 1) | ((vkk & 8) >> 1), vcol = (lane >> 5) * 32 + (lane & 3) * 8;
    const bf16* Kh = Kb + (rowbase + krow) * LDK + kvh * HD + kchunk * 8; const bf16* Vh = Vb + (rowbase + vkey) * LDK + kvh * HD + vcol;
    const int vb0 = (int)(unsigned)(uintptr_t)V_lds + v_rd_base(lane);
    const int c_first = run * ATTB_RC, c_last = c_first + ATTB_RC - 1;
#define SDMA(kc) do { __builtin_amdgcn_global_load_lds((const unsigned*)(Kh + (size_t)(kc) * 64 * LDK), (ALAS unsigned*)(K_lds + ((kc) & 3) * TB + wid * 1024), 16, 0, 0); \
        __builtin_amdgcn_global_load_lds((const unsigned*)(Vh + (size_t)(kc) * 64 * LDK), (ALAS unsigned*)(V_lds + ((kc) & 3) * TB + wid * 1024), 16, 0, 0); } while (0)
    for (int kc = (c_first - 2 > 0 ? c_first - 2 : 0); kc <= c_first; ++kc) SDMA(kc);
    const bf16* Qw = Qb + (rowbase + rh * 32 + r32) * LDQ + qh * HD + hi * 8;
    bf16x8 qr[4], qn[4];
#pragma unroll
    for (int d0 = 0; d0 < 4; ++d0) qr[d0] = *(const bf16x8*)(Qw + (size_t)c_first * 64 * LDQ + d0 * 16);
    asm volatile("s_waitcnt vmcnt(0)" ::: "memory"); __syncthreads();
    const int qloc = rh * 32 + r32;
    for (int c = c_first; c <= c_last; ++c) {
        const bool more = c < c_last;
        if (more) { SDMA(c + 1);
#pragma unroll
            for (int d0 = 0; d0 < 4; ++d0) qn[d0] = *(const bf16x8*)(Qw + (size_t)(c + 1) * 64 * LDQ + d0 * 16); }
        float m_reg = -1e30f, l_reg = 0.f; f32x16 o[2] = {f32x16{}, f32x16{}};
        for (int kc = (c - 2 > 0 ? c - 2 : 0); kc <= c; ++kc) {
            const int slot = kc & 3;
            f32x16 p0, p1; qkt<HD>(p0, p1, K_lds + slot * TB, qr, r32, hi);
            const int base = (kc - c) * 64 - qloc + 4 * hi;
#pragma unroll
            for (int r = 0; r < 16; ++r) { const int i0 = base + (r & 3) + 8 * (r >> 2); p0[r] -= slope2 * fabsf((float)i0); p1[r] -= slope2 * fabsf((float)(i0 + 32)); }
            float alpha; bf16x8 pa0, pa1, pa2, pa3;
            softmax_tile(p0, p1, m_reg, l_reg, alpha, pa0, pa1, pa2, pa3);
            rescale_o<2>(o, alpha, wsf, r32, hi);
            const int vb = vb0 + slot * TB;
            pv_one<2, 0>(o[0], vb, pa0, pa1, pa2, pa3); pv_one<2, 1>(o[1], vb, pa0, pa1, pa2, pa3);
        }
        if (more) {
#pragma unroll
            for (int d0 = 0; d0 < 4; ++d0) qr[d0] = qn[d0]; }
        const float l_tot = l_reg + __builtin_amdgcn_exp2f(sink2 - m_reg);
        store_o<2>(o, l_tot, wsf, lds + 8 * TB + 2048 + wid * 4096, Ob + (rowbase + (size_t)c * 64 + rh * 32) * LDQ + qh * HD, lane, r32, hi);
        asm volatile("s_waitcnt vmcnt(4) lgkmcnt(0)" ::: "memory");
        __builtin_amdgcn_s_barrier();
        asm volatile("" ::: "memory");
    }
#undef SDMA
}

template <int HD, int CL, bool ISA>
__device__ __forceinline__ void sample_attn_unit(const int tid, int sb, int qh, const bf16* Qb, const bf16* Kb, const bf16* Vb, bf16* Ob, const float* cache_k, const float* cache_v, const float* aux, ALAS char* lds) {
    constexpr int NK = CL + 16, NKP = NK + 1, KVW = ISA ? 2048 : 512, PAST = 1024;
    const int lane = tid & 63; const int wid = __builtin_amdgcn_readfirstlane(tid >> 6);
    const int kvh = ISA ? qh : (qh >> 2);
    ALAS float* qs = (ALAS float*)lds; ALAS float* S = qs + 16 * HD; ALAS float* inv = S + 16 * NKP;
    const size_t row0 = 32768 + (size_t)sb * 16;
    for (int i = tid; i < 16 * HD; i += 512) { const int j = i / HD, d = i % HD; qs[i] = bf2f(Qb[(row0 + j) * 2048 + qh * HD + d]); }
    __syncthreads();
    const float slope2 = __builtin_amdgcn_exp2f(-0.25f * (float)(qh + 1)) * LOG2E;
    for (int k = tid; k < NK; k += 512) {
        float acc[16];
#pragma unroll
        for (int j = 0; j < 16; ++j) acc[j] = 0.f;
        if (k < CL) { const float* kp = cache_k + ((size_t)sb * CL + k) * KVW + kvh * HD;
#pragma unroll 8
            for (int d4 = 0; d4 < HD / 4; ++d4) { const f32x4v kv = *(const f32x4v*)(kp + d4 * 4);
#pragma unroll
                for (int j = 0; j < 16; ++j) { const f32x4v q4 = *(const ALAS f32x4v*)(qs + j * HD + d4 * 4); acc[j] += (kv[0] * q4[0] + kv[1] * q4[1]) + (kv[2] * q4[2] + kv[3] * q4[3]); } } }
        else { const bf16* kp = Kb + (row0 + (k - CL)) * KVW + kvh * HD;
#pragma unroll 2
            for (int d4 = 0; d4 < HD / 4; ++d4) { const u32x2 kw = *(const u32x2*)(kp + d4 * 4);
                const float k0 = __uint_as_float(kw[0] << 16), k1 = __uint_as_float(kw[0] & 0xffff0000u), k2 = __uint_as_float(kw[1] << 16), k3 = __uint_as_float(kw[1] & 0xffff0000u);
#pragma unroll
                for (int j = 0; j < 16; ++j) { const f32x4v q4 = *(const ALAS f32x4v*)(qs + j * HD + d4 * 4); acc[j] += (k0 * q4[0] + k1 * q4[1]) + (k2 * q4[2] + k3 * q4[3]); } } }
        const int kpos = k < CL ? PAST - CL + k : PAST + (k - CL);
#pragma unroll
        for (int j = 0; j < 16; ++j) { const int rel = kpos - (PAST + j); float bias;
            if constexpr (ISA) { int idx = rel < -128 ? -128 : (rel > 128 ? 128 : rel); bias = aux[idx + 128] * LOG2E; } else { bias = -slope2 * fabsf((float)rel); }
            S[j * NKP + k] = acc[j] + bias; }
    }
    __syncthreads();
#pragma unroll
    for (int jj = 0; jj < 2; ++jj) { const int j = 2 * wid + jj;
        float m = -1e30f; for (int k = lane; k < NK; k += 64) m = fmaxf(m, S[j * NKP + k]);
        m = xl_wave_max(m);
        float s = 0.f; for (int k = lane; k < NK; k += 64) { const float e = __builtin_amdgcn_exp2f(S[j * NKP + k] - m); S[j * NKP + k] = e; s += e; }
        s = xl_wave_sum(s);
        if constexpr (!ISA) s += __builtin_amdgcn_exp2f(aux[qh] * LOG2E - m);
        if (lane == 0) inv[j] = 1.0f / s; }
    __syncthreads();
    constexpr int TPR = HD / 4, RG = 64 / TPR, RPL = 16 / RG, KPW = (NK + 7) / 8;
    ALAS float* red = (ALAS float*)(lds + 49152);
    { const int d4 = (lane & (TPR - 1)) * 4, rg = lane / TPR; f32x4v acc[RPL];
#pragma unroll
        for (int r = 0; r < RPL; ++r) acc[r] = (f32x4v){0.f, 0.f, 0.f, 0.f};
        const int k0 = wid * KPW, k1 = (k0 + KPW < NK) ? k0 + KPW : NK;
        const float* vp = cache_v + (size_t)sb * CL * KVW + kvh * HD + d4; const bf16* vn = Vb + row0 * KVW + kvh * HD + d4;
        const ALAS float* Sp = S + (rg * RPL) * NKP;
#pragma unroll 6
        for (int k = k0; k < k1; ++k) { f32x4v v4;
            if (k < CL) v4 = *(const f32x4v*)(vp + (size_t)k * KVW);
            else { const u32x2 vw = *(const u32x2*)(vn + (size_t)(k - CL) * KVW); v4 = (f32x4v){__uint_as_float(vw[0] << 16), __uint_as_float(vw[0] & 0xffff0000u), __uint_as_float(vw[1] << 16), __uint_as_float(vw[1] & 0xffff0000u)}; }
#pragma unroll
            for (int r = 0; r < RPL; ++r) acc[r] = acc[r] + v4 * Sp[r * NKP + k]; }
#pragma unroll
        for (int r = 0; r < RPL; ++r) *(ALAS f32x4v*)(red + (wid * 16 + rg * RPL + r) * HD + d4) = acc[r]; }
    __syncthreads();
    if (tid < 16 * TPR) { const int j = tid / TPR, d4 = (tid % TPR) * 4; f32x4v o = {0.f, 0.f, 0.f, 0.f};
#pragma unroll
        for (int w = 0; w < 8; ++w) o = o + *(const ALAS f32x4v*)(red + (w * 16 + j) * HD + d4);
        const float il = inv[j]; u32x2 w; w[0] = cvtpk(o[0] * il, o[1] * il); w[1] = cvtpk(o[2] * il, o[3] * il);
        *(u32x2*)(Ob + samp_toff(sb * 16 + j, qh * HD + d4)) = w; }
    __syncthreads();
}
#undef SBAR
#undef ALAS
}
namespace mini {
typedef unsigned short bf16_t;
typedef short bf16x8 __attribute__((ext_vector_type(8)));
typedef float f32x4 __attribute__((ext_vector_type(4)));
typedef unsigned u32x4 __attribute__((ext_vector_type(4)));
#define MLAS __attribute__((address_space(3)))
constexpr int SROW0 = 32768;
constexpr size_t WS_SSS_ = ((size_t)499 << 20) + (512 << 10), WS_Q_ = (size_t)500 << 20, WS_K_ = (size_t)629 << 20, WS_V_ = (size_t)758 << 20;
constexpr size_t WS_XBS_ = (size_t)1016 << 20, WS_OS_ = WS_XBS_ + (512 << 10), WS_HS_ = (size_t)1017 << 20;
__host__ __device__ __forceinline__ size_t toff(int r, int c) { return samp_toff(r, c); }
__device__ __forceinline__ unsigned cvt_pk_bf16(float lo, float hi) { unsigned r; asm volatile("v_cvt_pk_bf16_f32 %0, %1, %2" : "=v"(r) : "v"(lo), "v"(hi)); return r; }
__device__ __forceinline__ float bf_lo(unsigned w) { return __builtin_bit_cast(float, w << 16); }
__device__ __forceinline__ float bf_hi(unsigned w) { return __builtin_bit_cast(float, w & 0xffff0000u); }
__device__ __forceinline__ float srow_rstd(const unsigned char* ws, int sel, int r) {
    const f32x4* p = (const f32x4*)(ws + WS_SSS_) + (size_t)(sel * 128 + r) * 32; float s = 0.f;
#pragma unroll
    for (int q = 0; q < 32; ++q) { const f32x4 t = p[q]; s += (t[0] + t[1]) + (t[2] + t[3]); }
    return __builtin_amdgcn_rsqf(s * (1.0f / 2048.0f) + 1e-6f);
}
template <bool ISB> struct EpiQKV {
    unsigned char* ws; float* out; int pr;
    __device__ __forceinline__ void operator()(int r, int col, const float (&v)[8]) const {
        constexpr int nkv = ISB ? 512 : 2048, CL = ISB ? 128 : 512;
        constexpr float qscale = (ISB ? 0.125f : 0.08838834764831845f) * 1.4426950408889634f;
        constexpr size_t OKS = ISB ? 118751232 : 85196800, OVS = ISB ? 119799808 : 101974016;
        const int region = col < 2048 ? 0 : (col < 2048 + nkv ? 1 : 2);
        const float rs = srow_rstd(ws, 0, r) * (region == 0 ? qscale : 1.0f);
        const int c = region == 0 ? col : (region == 1 ? col - 2048 : col - 2048 - nkv), ld = region == 0 ? 2048 : nkv;
        bf16_t* const ob = (bf16_t*)(ws + (region == 0 ? WS_Q_ : (region == 1 ? WS_K_ : WS_V_)));
        float x[8];
#pragma unroll
        for (int e = 0; e < 8; ++e) x[e] = v[e] * rs;
        u32x4 w; w.x = cvt_pk_bf16(x[0], x[1]); w.y = cvt_pk_bf16(x[2], x[3]); w.z = cvt_pk_bf16(x[4], x[5]); w.w = cvt_pk_bf16(x[6], x[7]);
        *(u32x4*)(ob + (size_t)(SROW0 + r) * ld + c) = w;
        if (region != 0) { float* d = out + (region == 1 ? OKS : OVS) + (size_t)pr * 8 * CL * nkv + (size_t)((r >> 4) * CL + (CL - 16 + (r & 15))) * nkv + c;
            *(f32x4*)d = (f32x4){x[0], x[1], x[2], x[3]}; *(f32x4*)(d + 4) = (f32x4){x[4], x[5], x[6], x[7]}; }
    }
};
struct EpiRes {
    unsigned char* ws; int sssel;
    __device__ __forceinline__ void operator()(int r, int col, const float (&v)[8]) const {
        u32x4* const px = (u32x4*)((bf16_t*)(ws + WS_XBS_) + toff(r, col)); const u32x4 xo = *px;
        u32x4 w; w.x = cvt_pk_bf16(bf_lo(xo.x) + v[0], bf_hi(xo.x) + v[1]); w.y = cvt_pk_bf16(bf_lo(xo.y) + v[2], bf_hi(xo.y) + v[3]);
        w.z = cvt_pk_bf16(bf_lo(xo.z) + v[4], bf_hi(xo.z) + v[5]); w.w = cvt_pk_bf16(bf_lo(xo.w) + v[6], bf_hi(xo.w) + v[7]);
        *px = w;
        const float r0 = bf_lo(w.x), r1 = bf_hi(w.x), r2 = bf_lo(w.y), r3 = bf_hi(w.y), r4 = bf_lo(w.z), r5 = bf_hi(w.z), r6 = bf_lo(w.w), r7 = bf_hi(w.w);
        float ssq = ((r0 * r0 + r1 * r1) + (r2 * r2 + r3 * r3)) + ((r4 * r4 + r5 * r5) + (r6 * r6 + r7 * r7));
        ssq += xl_swz<1>(ssq);
        if ((col & 15) == 0) ((float*)(ws + WS_SSS_))[(size_t)(sssel * 128 + r) * 128 + (col >> 4)] = ssq;
    }
};
struct EpiUp {
    unsigned char* ws;
    __device__ __forceinline__ void operator()(int r, int col, const float (&v)[8]) const {
        const float rs = srow_rstd(ws, 1, r); float x[8];
#pragma unroll
        for (int e = 0; e < 8; ++e) { const float a = fmaxf(v[e] * rs, 0.f); x[e] = a * a; }
        u32x4 w; w.x = cvt_pk_bf16(x[0], x[1]); w.y = cvt_pk_bf16(x[2], x[3]); w.z = cvt_pk_bf16(x[4], x[5]); w.w = cvt_pk_bf16(x[6], x[7]);
        *(u32x4*)((bf16_t*)(ws + WS_HS_) + toff(r, col)) = w;
    }
};
template <class Epi, int NT, int DEPTH>
__device__ __forceinline__ void task(const int tid, const bf16_t* A, const bf16_t* Bt, const int K, const int c0, MLAS float* red, const Epi& E) {
    const int lane = tid & 63, i = lane & 15, kq = lane >> 4; const int wid = __builtin_amdgcn_readfirstlane(tid >> 6);
    const int ks = K >> 3, nsteps = ks >> 5;
    const bf16_t* ap = A + (size_t)(wid * nsteps) * 8 * 512 + lane * 8;
    const bf16_t* bp = Bt + (size_t)(c0 + i) * K + wid * ks + 8 * kq;
    f32x4 acc[8][NT];
#pragma unroll
    for (int m = 0; m < 8; ++m)
#pragma unroll
        for (int n = 0; n < NT; ++n) acc[m][n] = (f32x4){0.f, 0.f, 0.f, 0.f};
    bf16x8 af[DEPTH][8], bfr[DEPTH][NT];
#define MLOAD(d, s) do { _Pragma("unroll") for (int m = 0; m < 8; ++m) af[d][m] = *(const bf16x8*)(ap + (size_t)((s) * 8 + m) * 512); \
        _Pragma("unroll") for (int n = 0; n < NT; ++n) bfr[d][n] = *(const bf16x8*)(bp + (size_t)(16 * n) * K + 32 * (s)); } while (0)
#define MMMA(d) do { _Pragma("unroll") for (int m = 0; m < 8; ++m) _Pragma("unroll") for (int n = 0; n < NT; ++n) acc[m][n] = __builtin_amdgcn_mfma_f32_16x16x32_bf16(af[d][m], bfr[d][n], acc[m][n], 0, 0, 0); } while (0)
#pragma unroll
    for (int d = 0; d < DEPTH - 1; ++d) MLOAD(d, d);
    __builtin_amdgcn_sched_barrier(0);
    for (int s = 0; s < nsteps; s += DEPTH) {
#pragma unroll
        for (int d = 0; d < DEPTH; ++d) {
            if (s + d + DEPTH - 1 < nsteps) MLOAD((d + DEPTH - 1) % DEPTH, s + d + DEPTH - 1);
            __builtin_amdgcn_sched_barrier(0);
            MMMA(d);
            __builtin_amdgcn_sched_barrier(0);
        }
    }
#undef MLOAD
#undef MMMA
    constexpr int NC = 16 * NT, CG = 2 * NT;
    MLAS float* mine = red + wid * (128 * NC);
#pragma unroll
    for (int m = 0; m < 8; ++m)
#pragma unroll
        for (int n = 0; n < NT; ++n)
#pragma unroll
            for (int r = 0; r < 4; ++r) mine[(16 * m + 4 * kq + r) * NC + 16 * n + i] = acc[m][n][r];
    __syncthreads();
    if (tid < 128 * CG) { const int row = tid / CG, cg = tid % CG; float v[8];
#pragma unroll
        for (int e = 0; e < 8; ++e) v[e] = 0.f;
#pragma unroll
        for (int w = 0; w < 8; ++w) { const f32x4 p = *(const MLAS f32x4*)(red + w * (128 * NC) + row * NC + 8 * cg), q = *(const MLAS f32x4*)(red + w * (128 * NC) + row * NC + 8 * cg + 4);
            v[0] += p[0]; v[1] += p[1]; v[2] += p[2]; v[3] += p[3]; v[4] += q[0]; v[5] += q[1]; v[6] += q[2]; v[7] += q[3]; }
        E(row, c0 + 8 * cg, v); }
    __syncthreads();
}
#undef MLAS
}
constexpr int NWAVES = 8;
#ifndef MK_ONE_LAUNCH
#define MK_ONE_LAUNCH 1
#endif
constexpr int DM = 2048, FF = 8192, SEQ = 8192, NBATCH = 4, MP = NBATCH * SEQ, MS = 128, MR = MP + MS, MPAD = 33024;
constexpr int NPH = 22;
constexpr size_t MiB = 1u << 20;
constexpr size_t WS_CTL = 0, CTL_ZERO_BYTES = 1 * MiB;
constexpr size_t WS_WQA = 1 * MiB, WS_WOA = 49 * MiB, WS_WQB = 65 * MiB, WS_WOB = 89 * MiB, WS_WUP = 105 * MiB, WS_WDN = 233 * MiB;
constexpr size_t WS_XB = 361 * MiB;
constexpr size_t WS_SS0 = 490 * MiB, WS_SS1 = 495 * MiB;
constexpr size_t WS_SSS = 499 * MiB + 512 * 1024;
constexpr size_t WS_ACT = 500 * MiB;
constexpr size_t WS_Q = WS_ACT, WS_K = WS_ACT + 129 * MiB, WS_V = WS_ACT + 258 * MiB, WS_O = WS_ACT + 387 * MiB;
constexpr size_t WS_XBS = 1016 * MiB, WS_OS = WS_XBS + 512 * 1024, WS_HS = 1017 * MiB, WS_END = 1019 * MiB;
static_assert((size_t)MPAD * DM * 2 == 129 * MiB && (size_t)MPAD * FF * 2 == 516 * MiB, "buffer sizes");
constexpr int CW_TMO = 0, CW_BAR = 4096, CW_TKT = 16384, CW_CPY = 20480;
constexpr size_t O_Y = 0, O_AKP = 67371008, O_AVP = 75759616, O_BKP = 84148224, O_BVP = 84672512, O_AKS = 85196800, O_AVS = 101974016, O_BKS = 118751232, O_BVS = 119799808, O_END = 120848384;
constexpr int RING_BYTES = 131072, MISC_OFF = RING_BYTES + 320, LDS_BYTES = 147456;

#define GAS __attribute__((address_space(1)))
#define LAS __attribute__((address_space(3)))
typedef unsigned short bf16;
typedef unsigned v4u __attribute__((ext_vector_type(4)));
typedef unsigned v2u __attribute__((ext_vector_type(2)));
typedef float f32x4 __attribute__((ext_vector_type(4)));
typedef GAS unsigned gu32;
#define RLX_AGENT __ATOMIC_RELAXED, __HIP_MEMORY_SCOPE_AGENT
#define LDS_WAIT() asm volatile("s_waitcnt lgkmcnt(0)" ::: "memory")
#define VM_WAIT() asm volatile("s_waitcnt vmcnt(0)" ::: "memory")
__device__ __forceinline__ unsigned f2bf(float f) { unsigned u = __builtin_bit_cast(unsigned, f); return (u + 0x7fffu + ((u >> 16) & 1u)) >> 16; }
__device__ __forceinline__ unsigned pk2(float lo, float hi) { return f2bf(lo) | (f2bf(hi) << 16); }
#define XB_TMO      128
#define XB_XCNT(j)  (256  + 64 * (j))
#define XB_XSUB(j)  (1280 + 64 * (j))
#define XB_XGEN(j)  (2304 + 64 * (j))
#define XB_TOP      3328
#define XB_TOPGEN   3392
#define XCD_BAR_WORDS 3456
#define XB_SPIN_CAP (1u << 18)

__device__ __forceinline__ unsigned xb_ld(unsigned* p)              { return __hip_atomic_load(p, __ATOMIC_RELAXED, __HIP_MEMORY_SCOPE_AGENT); }
__device__ __forceinline__ unsigned xb_add(unsigned* p, unsigned v) { return __hip_atomic_fetch_add(p, v, __ATOMIC_RELAXED, __HIP_MEMORY_SCOPE_AGENT); }
__device__ __forceinline__ unsigned xb_xcc_id() { return (unsigned)__builtin_amdgcn_s_getreg((3 << 11) | 20) & 0xFu; }
#define XB_SPIN(cond, bar) do { unsigned _sp = 0; while (cond) { __builtin_amdgcn_s_sleep(1); \
    if ((++_sp & 255u) == 0u) { if (xb_ld(&(bar)[XB_TMO])) break; if (_sp > XB_SPIN_CAP) { atomicAdd(&(bar)[XB_TMO], 1u); break; } } } } while (0)

struct XcdBarrier {
    unsigned* bar; unsigned x;
    volatile LAS unsigned* st;
};

__device__ __forceinline__ XcdBarrier xcd_barrier_post(unsigned* bar, volatile LAS unsigned* st) {
    XcdBarrier b; b.bar = bar; b.x = xb_xcc_id(); b.st = st;
    if (threadIdx.x == 0) (void)xb_add(&bar[XB_XCNT(b.x)], 1u);
    return b;
}
__device__ __forceinline__ void xcd_barrier_complete(unsigned* bar, unsigned x, unsigned& nloc, unsigned& nx) {
    const unsigned G = gridDim.x * gridDim.y * gridDim.z;
    unsigned sum, cnt, mine, sp = 0u;
    for (;;) {
        sum = 0u; cnt = 0u; mine = 0u;
#pragma unroll
        for (unsigned j = 0; j < 16; ++j) { const unsigned c = xb_ld(&bar[XB_XCNT(j)]); sum += c; cnt += (c > 0u) ? 1u : 0u; mine = (j == x) ? c : mine; }
        if (sum == G) break;
        __builtin_amdgcn_s_sleep(1);
        if ((++sp & 255u) == 0u) { if (xb_ld(&bar[XB_TMO])) break; if (sp > XB_SPIN_CAP) { atomicAdd(&bar[XB_TMO], 1u); break; } }
    }
    nloc = mine > 0u ? mine : 1u; nx = cnt > 0u ? cnt : 1u;
}

__device__ __forceinline__ void xcd_barrier(const XcdBarrier& b) {
    asm volatile("s_waitcnt vmcnt(0)" ::: "memory");
    __syncthreads();
    if (threadIdx.x == 0) {
        unsigned* bar = b.bar;
        __builtin_amdgcn_s_waitcnt(0);
        unsigned nloc = b.st[0], nx = b.st[1];
        if (nloc == 0u) { xcd_barrier_complete(bar, b.x, nloc, nx); b.st[0] = nloc; b.st[1] = nx; }
        const unsigned old = xb_add(&bar[XB_XSUB(b.x)], 1u);
        const unsigned gen = old / nloc;
        if (old + 1u == (gen + 1u) * nloc) {
            __builtin_amdgcn_fence(__ATOMIC_RELEASE, "agent");
            asm volatile("s_waitcnt vmcnt(0)" ::: "memory");
            const unsigned og = xb_add(&bar[XB_TOP], 1u);
            const unsigned tg = og / nx;
            if (og + 1u == (tg + 1u) * nx) xb_add(&bar[XB_TOPGEN], 1u);
            else XB_SPIN(xb_ld(&bar[XB_TOPGEN]) == tg, bar);
            __builtin_amdgcn_fence(__ATOMIC_ACQUIRE, "agent");
            xb_add(&bar[XB_XGEN(b.x)], 1u);
            asm volatile("s_waitcnt vmcnt(0)" ::: "memory");
        } else {
            XB_SPIN(xb_ld(&bar[XB_XGEN(b.x)]) == gen, bar);
            __builtin_amdgcn_fence(__ATOMIC_ACQUIRE, "agent");
            asm volatile("s_waitcnt vmcnt(0)" ::: "memory");
        }
    }
    __syncthreads();
}
struct Frame {
    LAS unsigned char* lds;
    volatile LAS unsigned* MISC;
};
enum { P_XP = 0, P_XS, P_CAK, P_CAV, P_CBK, P_CBV, P_NMIX, P_NFFN, P_NFIN, P_AWQKV, P_AWO, P_AREL, P_BWQKV, P_BWO, P_BSINK, P_WUP, P_WDN, P_OUT, P_WS, P_COUNT };
typedef const __attribute__((address_space(4))) unsigned long long* karg_t;
#define KARGS() karg_t KA = (karg_t)__builtin_amdgcn_kernarg_segment_ptr(); asm volatile("" : "+s"(KA))
#define FPTR(i) ((const float*)(const GAS float*)KA[(i)])
#define OUTP() ((float*)(GAS float*)KA[P_OUT])
#define WSP() ((unsigned char*)(GAS unsigned char*)KA[P_WS])
__device__ __forceinline__ int opaque_lane() { int l; asm volatile("v_mbcnt_lo_u32_b32 %0, -1, 0\n\tv_mbcnt_hi_u32_b32 %0, -1, %0" : "=v"(l)); return l; }
__device__ __forceinline__ float wave_sum(float v) {
    return xl_wave_sum(v);
}
struct WItem { const float* W; const float* gain; bf16* WT; int K, N, r; };
#define P0_LOAD(R, GV, T) do { const int nblk_ = (T).N / 32, k0_ = 64 * ((T).r / nblk_), n0_ = 32 * ((T).r % nblk_); const float* wp_ = (T).W + (size_t)(k0_ + (lane >> 5)) * (T).N + n0_ + (lane & 31); \
        GV = (T).gain ? (T).gain[k0_ + lane] : 1.0f; \
        _Pragma("unroll") for (int i = 0; i < 32; ++i) R[i] = __builtin_nontemporal_load(wp_ + (size_t)(2 * i) * (T).N); } while (0)
#define P0_PROC(R, GV, T) do { const int nblk_ = (T).N / 32, k0_ = 64 * ((T).r / nblk_), n0_ = 32 * ((T).r % nblk_); \
        _Pragma("unroll") for (int i = 0; i < 32; ++i) { const float g0_ = __builtin_bit_cast(float, __builtin_amdgcn_readlane(__builtin_bit_cast(int, GV), 2 * i)), g1_ = __builtin_bit_cast(float, __builtin_amdgcn_readlane(__builtin_bit_cast(int, GV), 2 * i + 1)); \
            scr[(2 * i + (lane >> 5)) * 33 + (lane & 31)] = R[i] * ((lane >> 5) ? g1_ : g0_); } \
        LDS_WAIT(); asm volatile("" ::: "memory"); \
        { const int c_ = lane & 7; _Pragma("unroll") for (int j = 0; j < 4; ++j) { const int n_ = (lane >> 3) + 8 * j; const LAS float* s_ = scr + (8 * c_) * 33 + n_; \
            v4u o_; o_.x = pk2(s_[0 * 33], s_[1 * 33]); o_.y = pk2(s_[2 * 33], s_[3 * 33]); o_.z = pk2(s_[4 * 33], s_[5 * 33]); o_.w = pk2(s_[6 * 33], s_[7 * 33]); \
            *(GAS v4u*)((T).WT + (size_t)(n0_ + n_) * (T).K + k0_ + 8 * c_) = o_; } } \
        LDS_WAIT(); asm volatile("" ::: "memory"); } while (0)
__device__ __forceinline__ WItem witem(karg_t KA, unsigned char* ws, const int kind, const int s, const int r) { WItem t; t.r = r;
    if (kind == 0)      { t.W = FPTR(P_AWQKV) + (size_t)s * 2048 * 6144; t.gain = FPTR(P_NMIX) + (2 * s) * 2048;     t.K = 2048; t.N = 6144; t.WT = (bf16*)(ws + WS_WQA + (size_t)s * 24 * MiB); }
    else if (kind == 1) { t.W = FPTR(P_AWO) + (size_t)s * 2048 * 2048;   t.gain = nullptr;                            t.K = 2048; t.N = 2048; t.WT = (bf16*)(ws + WS_WOA + (size_t)s * 8 * MiB); }
    else if (kind == 2) { t.W = FPTR(P_BWQKV) + (size_t)s * 2048 * 3072; t.gain = FPTR(P_NMIX) + (2 * s + 1) * 2048; t.K = 2048; t.N = 3072; t.WT = (bf16*)(ws + WS_WQB + (size_t)s * 12 * MiB); }
    else if (kind == 3) { t.W = FPTR(P_BWO) + (size_t)s * 2048 * 2048;   t.gain = nullptr;                            t.K = 2048; t.N = 2048; t.WT = (bf16*)(ws + WS_WOB + (size_t)s * 8 * MiB); }
    else if (kind == 4) { t.W = FPTR(P_WUP) + (size_t)s * 2048 * 8192;   t.gain = FPTR(P_NFFN) + s * 2048;            t.K = 2048; t.N = 8192; t.WT = (bf16*)(ws + WS_WUP + (size_t)s * 32 * MiB); }
    else                { t.W = FPTR(P_WDN) + (size_t)s * 8192 * 2048;   t.gain = nullptr;                            t.K = 8192; t.N = 2048; t.WT = (bf16*)(ws + WS_WDN + (size_t)s * 32 * MiB); }
    return t; }
constexpr int I_AQ = 32 * 192, I_O = 32 * 64, I_BQ = 32 * 96, I_UP = 32 * 256, I_DN = 128 * 64;
constexpr int P0_ITEMS = I_AQ + I_O;
__device__ __forceinline__ WItem p0_decode(karg_t KA, unsigned char* ws, const int it) {
    if (it < I_AQ) return witem(KA, ws, 0, 0, it);
    return witem(KA, ws, 1, 0, it - I_AQ); }
constexpr int FW_A0 = I_UP, FW_A1 = FW_A0 + I_DN,
              FW_B0 = FW_A1 + I_BQ, FW_B1 = FW_B0 + I_O, FW_B2 = FW_B1 + I_UP, FW_B3 = FW_B2 + I_DN, FW_B4 = FW_B3 + I_AQ, FW_B5 = FW_B4 + I_O, FW_B6 = FW_B5 + I_UP, FW_B7 = FW_B6 + I_DN,
              FW_B8 = FW_B7 + I_BQ, FW_B9 = FW_B8 + I_O, FW_B10 = FW_B9 + I_UP, FW_B11 = FW_B10 + I_DN;
constexpr int FW_TASK_ITEMS = 16, FW_TASKS = FW_B11 / FW_TASK_ITEMS;
static_assert(FW_B11 % FW_TASK_ITEMS == 0 && FW_B11 + P0_ITEMS == 2 * I_AQ + 4 * I_O + 2 * I_BQ + 4 * I_UP + 4 * I_DN, "deferred weight items");
__device__ __forceinline__ WItem fw_decode(karg_t KA, unsigned char* ws, const int it) {
    if (it < FW_A0) return witem(KA, ws, 4, 0, it);
    if (it < FW_A1) return witem(KA, ws, 5, 0, it - FW_A0);
    if (it < FW_B0) return witem(KA, ws, 2, 0, it - FW_A1);
    if (it < FW_B1) return witem(KA, ws, 3, 0, it - FW_B0);
    if (it < FW_B2) return witem(KA, ws, 4, 1, it - FW_B1);
    if (it < FW_B3) return witem(KA, ws, 5, 1, it - FW_B2);
    if (it < FW_B4) return witem(KA, ws, 0, 1, it - FW_B3);
    if (it < FW_B5) return witem(KA, ws, 1, 1, it - FW_B4);
    if (it < FW_B6) return witem(KA, ws, 4, 2, it - FW_B5);
    if (it < FW_B7) return witem(KA, ws, 5, 2, it - FW_B6);
    if (it < FW_B8) return witem(KA, ws, 2, 1, it - FW_B7);
    if (it < FW_B9) return witem(KA, ws, 3, 1, it - FW_B8);
    if (it < FW_B10) return witem(KA, ws, 4, 3, it - FW_B9);
    return witem(KA, ws, 5, 3, it - FW_B10); }
__device__ __forceinline__ unsigned fill_must(const int pr, const int site) {
    constexpr int T = FW_TASK_ITEMS;
    const int m0 = site <= 2 ? 0 : site == 3 ? FW_A0 / T : site == 4 ? FW_A1 / T : site <= 6 ? FW_B0 / T : site == 7 ? FW_B1 / T : site == 8 ? FW_B2 / T : site == 9 ? FW_B3 / T : FW_B4 / T;
    const int m1 = site <= 1 ? FW_B4 / T : site == 2 ? FW_B5 / T : site == 3 ? FW_B6 / T : site == 4 ? FW_B7 / T : site <= 6 ? FW_B8 / T : site == 7 ? FW_B9 / T : site == 8 ? FW_B10 / T : FW_B11 / T;
    return (unsigned)(pr == 0 ? m0 : m1); }
__device__ __forceinline__ void fill_weight_task(Frame& F, karg_t KA, const int tid, const int t) {
#if defined(PROBE_DUMMY_FILL) && PROBE_DUMMY_FILL == 1
    __builtin_amdgcn_s_sleep(127); return;
#endif
    const int lane = tid & 63, wave = __builtin_amdgcn_readfirstlane(tid >> 6);
    unsigned char* const ws = WSP();
    LAS float* scr = (LAS float*)(F.lds + wave * 16384);
    float ra[32], rb[32]; float ga = 1.f, gb = 1.f;
    const WItem ta = fw_decode(KA, ws, FW_TASK_ITEMS * t + wave), tb = fw_decode(KA, ws, FW_TASK_ITEMS * t + 8 + wave);
    P0_LOAD(ra, ga, ta); P0_LOAD(rb, gb, tb);
    P0_PROC(ra, ga, ta); P0_PROC(rb, gb, tb);
}
__device__ __forceinline__ void p0_prologue(Frame& F, const int wave0) {
    KARGS();
    int tid_ = (wave0 << 6) | opaque_lane(), bid_ = blockIdx.x, G_ = gridDim.x; asm volatile("" : "+v"(tid_), "+s"(bid_), "+s"(G_));
    const int lane = tid_ & 63, wave = __builtin_amdgcn_readfirstlane(tid_ >> 6), vcu = (G_ % 8 == 0) ? (bid_ % 8) * (G_ / 8) + bid_ / 8 : bid_;
    unsigned char* const ws = WSP(); float* const out = OUTP();
    LAS float* scr = (LAS float*)(F.lds + wave * 16384);
    const int gw = vcu * NWAVES + wave, NGW = G_ * NWAVES;
#ifdef PROBE_DUMMY_FILL
    constexpr int E5 = P0_ITEMS + FW_B11;
    auto decode = [&](int it) -> WItem { return it < P0_ITEMS ? p0_decode(KA, ws, it) : fw_decode(KA, ws, it - P0_ITEMS); };
#else
    constexpr int E5 = P0_ITEMS;
    auto decode = [&](int it) -> WItem { return p0_decode(KA, ws, it); };
#endif
    {
        float ra[32], rb[32]; float ga = 1.f, gb = 1.f; WItem ta, tb;
        int it = gw;
        if (it < E5) { ta = decode(it); P0_LOAD(ra, ga, ta); }
        while (it < E5) {
            const int it2 = it + NGW, it3 = it2 + NGW;
            if (it2 < E5) { tb = decode(it2); P0_LOAD(rb, gb, tb); }
            P0_PROC(ra, ga, ta);
            if (it3 < E5) { ta = decode(it3); P0_LOAD(ra, ga, ta); }
            if (it2 < E5) { P0_PROC(rb, gb, tb); }
            it = it3;
        }
    }
    bf16* XB = (bf16*)(ws + WS_XB); float* SS0 = (float*)(ws + WS_SS0); const float* const xp_ = FPTR(P_XP); const float* const xs_ = FPTR(P_XS);
    for (int m0 = gw; m0 < MPAD; m0 += 2 * NGW) {
        f32x4 v[2][8];
#pragma unroll
        for (int h = 0; h < 2; ++h) { const int m = m0 + h * NGW;
            if (m < MR) { const float* xrow = m < MP ? xp_ + (size_t)m * DM : xs_ + (size_t)(m - MP) * DM; const GAS f32x4* xr = (const GAS f32x4*)xrow + lane;
#pragma unroll
                for (int j = 0; j < 8; ++j) v[h][j] = __builtin_nontemporal_load(xr + 64 * j); }
            else {
#pragma unroll
                for (int j = 0; j < 8; ++j) v[h][j] = (f32x4){0.f, 0.f, 0.f, 0.f}; } }
#pragma unroll
        for (int h = 0; h < 2; ++h) { const int m = m0 + h * NGW;
            if (m < MPAD) { float s = 0.f;
#pragma unroll
                for (int j = 0; j < 8; ++j) s += (v[h][j][0] * v[h][j][0] + v[h][j][1] * v[h][j][1]) + (v[h][j][2] * v[h][j][2] + v[h][j][3] * v[h][j][3]);
                s = wave_sum(s);
                if (m >= MP && m < MR) {
                    bf16* const xbs = (bf16*)(ws + WS_XBS);
#pragma unroll
                    for (int j = 0; j < 8; ++j) { v2u w; w.x = pk2(v[h][j][0], v[h][j][1]); w.y = pk2(v[h][j][2], v[h][j][3]); *(GAS v2u*)(xbs + samp_toff(m - MP, 4 * lane + 256 * j)) = w; }
                } else {
                GAS v2u* o8 = (GAS v2u*)(XB + (size_t)m * DM) + lane;
#pragma unroll
                for (int j = 0; j < 8; ++j) { v2u w; w.x = pk2(v[h][j][0], v[h][j][1]); w.y = pk2(v[h][j][2], v[h][j][3]); o8[64 * j] = w; } }
                if (lane < 32) SS0[(size_t)m * 32 + lane] = lane == 0 ? s : 0.f;
                if (m >= MP && m < MR) { ((float*)(ws + WS_SSS))[(size_t)(m - MP) * 128 + lane] = lane == 0 ? s : 0.f; ((float*)(ws + WS_SSS))[(size_t)(m - MP) * 128 + 64 + lane] = 0.f; } } }
    }
}
constexpr int CPY_A_TASKS = 992, CPY_TASKS = 1048, CPY_CHUNK4 = 8192;
__device__ __forceinline__ void copy_task(const float* cak_, const float* cav_, const float* cbk_, const float* cbv_, float* out, const int t, const int tid) {
    constexpr size_t A_BLK4 = 512 * 512, A_CP4 = 496 * 512, A_TOT = 16 * A_CP4, B_BLK4 = 128 * 128, B_CP4 = 112 * 128, B_TOT = 16 * B_CP4;
    static_assert(2 * A_TOT == (size_t)CPY_A_TASKS * CPY_CHUNK4 && 2 * B_TOT == (size_t)(CPY_TASKS - CPY_A_TASKS) * CPY_CHUNK4, "copy tasks");
    const bool isa = t < CPY_A_TASKS; const size_t base = (size_t)(isa ? t : t - CPY_A_TASKS) * CPY_CHUNK4 + tid;
    const size_t TOT = isa ? A_TOT : B_TOT, CP4 = isa ? A_CP4 : B_CP4, BLK4 = isa ? A_BLK4 : B_BLK4, SKIP = isa ? 16 * 512 : 16 * 128;
    const f32x4* const sk = (const f32x4*)(isa ? cak_ : cbk_); const f32x4* const sv = (const f32x4*)(isa ? cav_ : cbv_);
    f32x4* const dk = (f32x4*)(out + (isa ? O_AKS : O_BKS)); f32x4* const dv = (f32x4*)(out + (isa ? O_AVS : O_BVS));
#pragma unroll 1
    for (int bq = 0; bq < CPY_CHUNK4 / 4096; ++bq) { f32x4 v[8];
#pragma unroll
        for (int e = 0; e < 8; ++e) { const size_t i = base + (size_t)(bq * 8 + e) * 512; const bool isv = i >= TOT; const size_t q = isv ? i - TOT : i, blk = q / CP4, off = q % CP4;
            v[e] = __builtin_nontemporal_load((isv ? sv : sk) + blk * BLK4 + SKIP + off); }
#pragma unroll
        for (int e = 0; e < 8; ++e) { const size_t i = base + (size_t)(bq * 8 + e) * 512; const bool isv = i >= TOT; const size_t q = isv ? i - TOT : i, blk = q / CP4, off = q % CP4;
            __builtin_nontemporal_store(v[e], (isv ? dv : dk) + blk * BLK4 + off); } }
}
#ifndef FILL_WQ
#define FILL_WQ 280u
#endif
#ifndef FILL_MOD
#define FILL_MOD 1u
#endif
#ifndef FILL_CQ
#define FILL_CQ 53u
#endif
constexpr unsigned FILL_TOTAL = FW_TASKS + CPY_TASKS, FILL_NONE = 0xfffffffeu, FILL_DONE = 0xffffffffu;
constexpr int ST_A_TASKS = 256, ST_B_TASKS = 16, CW_ST = CW_CPY + 256;
__device__ __forceinline__ void state_task(unsigned char* ws, float* out, const int pr, const bool isb, const int t, const int tid) {
    const int kv = isb ? t >> 3 : t >> 7, rem = isb ? (t & 7) : (t & 127), b = isb ? rem >> 1 : rem >> 5, r0 = isb ? (rem & 1) * 64 : (rem & 31) * 16;
    const size_t W = isb ? 512 : 2048, CLr = isb ? 128 : 512, srow = (size_t)b * 8192 + (8192 - CLr) + r0;
    const bf16* const src = (const bf16*)(ws + (kv ? WS_V : WS_K)) + srow * W;
    float* const dst = out + (isb ? (kv ? O_BVP : O_BKP) : (kv ? O_AVP : O_AKP)) + (size_t)pr * 4 * CLr * W + ((size_t)b * CLr + r0) * W;
    v4u w[8];
#pragma unroll
    for (int j = 0; j < 8; ++j) w[j] = *(const GAS v4u*)(src + 8 * (tid + 512 * j));
#pragma unroll
    for (int j = 0; j < 8; ++j) { GAS f32x4* const d = (GAS f32x4*)(dst + 8 * (tid + 512 * j));
        d[0] = (f32x4){__uint_as_float(w[j].x << 16), __uint_as_float(w[j].x & 0xffff0000u), __uint_as_float(w[j].y << 16), __uint_as_float(w[j].y & 0xffff0000u)};
        d[1] = (f32x4){__uint_as_float(w[j].z << 16), __uint_as_float(w[j].z & 0xffff0000u), __uint_as_float(w[j].w << 16), __uint_as_float(w[j].w & 0xffff0000u)}; }
}
__device__ __forceinline__ void fill_run(Frame& F, karg_t KA, const int tid, const unsigned t, const int st_pr, const bool st_b) {
    if (t >= FW_TASKS + CPY_TASKS) state_task(WSP(), OUTP(), st_pr, st_b, (int)(t - (FW_TASKS + CPY_TASKS)), tid);
    else if (t < (unsigned)FW_TASKS) fill_weight_task(F, KA, tid, (int)t);
    else copy_task(FPTR(P_CAK), FPTR(P_CAV), FPTR(P_CBK), FPTR(P_CBV), OUTP(), (int)(t - FW_TASKS), tid);
}
__device__ __forceinline__ void fill_until(Frame& F, karg_t KA, const int tid, const unsigned must, const unsigned mustc) {
    gu32* const ck = (gu32*)(WSP() + WS_CTL) + CW_CPY; gu32* const cc = ck + 64;
    for (;;) {
        if (tid == 0) { unsigned r = FILL_NONE;
            if (__hip_atomic_load(ck, RLX_AGENT) < must) { r = __hip_atomic_fetch_add(ck, 1u, RLX_AGENT); if (r >= (unsigned)FW_TASKS) r = FILL_NONE; }
            if (r == FILL_NONE && __hip_atomic_load(cc, RLX_AGENT) < mustc) { r = __hip_atomic_fetch_add(cc, 1u, RLX_AGENT); r = r < (unsigned)CPY_TASKS ? r + FW_TASKS : FILL_NONE; }
            F.MISC[17] = r; }
        __syncthreads();
        const unsigned t = F.MISC[17]; if (t >= FILL_TOTAL) break;
        fill_run(F, KA, tid, t, 0, false); __syncthreads();
    }
}
__device__ __forceinline__ void xcd_barrier_fill(const XcdBarrier& b, Frame& F, karg_t KA, const int tid, const unsigned must, const unsigned wq, const unsigned cq, const int st_mode, const int st_pr, const bool st_b) {
    gu32* const sc = (gu32*)(WSP() + WS_CTL) + CW_ST + 64 * (2 * st_pr + (st_b ? 1 : 0)); const unsigned st_n = st_b ? (unsigned)ST_B_TASKS : (unsigned)ST_A_TASKS;
    if (st_mode == 2 && F.MISC[19] < st_n) {
        for (;;) {
            if (tid == 0) { unsigned r = FILL_NONE; if (__hip_atomic_load(sc, RLX_AGENT) < st_n) { r = __hip_atomic_fetch_add(sc, 1u, RLX_AGENT); r = r < st_n ? r + FILL_TOTAL : FILL_NONE; } F.MISC[17] = r; }
            __syncthreads();
            const unsigned t = F.MISC[17]; if (t == FILL_NONE) break;
            fill_run(F, KA, tid, t, st_pr, st_b); __syncthreads();
        }
    }
    if (must != 0u && F.MISC[18] < must) fill_until(F, KA, tid, must, 0u);
    asm volatile("s_waitcnt vmcnt(0)" ::: "memory");
    __syncthreads();
    unsigned gen = 0u; bool open = false;
    if (tid == 0) {
        unsigned* bar = b.bar;
        __builtin_amdgcn_s_waitcnt(0);
        unsigned nloc = b.st[0], nx = b.st[1];
        if (nloc == 0u) { xcd_barrier_complete(bar, b.x, nloc, nx); b.st[0] = nloc; b.st[1] = nx; }
        const unsigned old = xb_add(&bar[XB_XSUB(b.x)], 1u);
        gen = old / nloc;
        if (old + 1u == (gen + 1u) * nloc) {
            __builtin_amdgcn_fence(__ATOMIC_RELEASE, "agent");
            asm volatile("s_waitcnt vmcnt(0)" ::: "memory");
            const unsigned og = xb_add(&bar[XB_TOP], 1u);
            const unsigned tg = og / nx;
            if (og + 1u == (tg + 1u) * nx) xb_add(&bar[XB_TOPGEN], 1u);
            else XB_SPIN(xb_ld(&bar[XB_TOPGEN]) == tg, bar);
            __builtin_amdgcn_fence(__ATOMIC_ACQUIRE, "agent");
            xb_add(&bar[XB_XGEN(b.x)], 1u);
            asm volatile("s_waitcnt vmcnt(0)" ::: "memory");
            open = true;
        }
    }
    gu32* const ck = (gu32*)(WSP() + WS_CTL) + CW_CPY; gu32* const cc = ck + 64;
    for (;;) {
        if (tid == 0) {
            unsigned r = FILL_DONE;
            if (!open) {
                unsigned* bar = b.bar;
                if (xb_ld(&bar[XB_XGEN(b.x)]) == gen) {
                    r = FILL_NONE;
                    if (st_mode == 1 && __hip_atomic_load(sc, RLX_AGENT) < st_n) { r = __hip_atomic_fetch_add(sc, 1u, RLX_AGENT); r = r < st_n ? r + FILL_TOTAL : FILL_NONE; }
                    if (r == FILL_NONE && __hip_atomic_load(ck, RLX_AGENT) < wq) { r = __hip_atomic_fetch_add(ck, 1u, RLX_AGENT); if (r >= (unsigned)FW_TASKS) r = FILL_NONE; }
                    if (r == FILL_NONE && __hip_atomic_load(cc, RLX_AGENT) < cq) { r = __hip_atomic_fetch_add(cc, 1u, RLX_AGENT); r = r < (unsigned)CPY_TASKS ? r + FW_TASKS : FILL_NONE; }
                    if (r == FILL_NONE) { XB_SPIN(xb_ld(&bar[XB_XGEN(b.x)]) == gen, bar); r = FILL_DONE; }
                }
                if (r == FILL_DONE) { __builtin_amdgcn_fence(__ATOMIC_ACQUIRE, "agent"); asm volatile("s_waitcnt vmcnt(0)" ::: "memory"); }
            }
            F.MISC[17] = r;
        }
        __syncthreads();
        const unsigned t = F.MISC[17]; if (t == FILL_DONE) break;
        fill_run(F, KA, tid, t, st_pr, st_b); __syncthreads();
    }
}
__device__ __forceinline__ void final_norm(Frame& F, const int wave0) {
    KARGS();
    int tid_ = (wave0 << 6) | opaque_lane(), bid_ = blockIdx.x, G_ = gridDim.x; asm volatile("" : "+v"(tid_), "+s"(bid_), "+s"(G_));
    const int lane = tid_ & 63, wave = __builtin_amdgcn_readfirstlane(tid_ >> 6), vcu = (G_ % 8 == 0) ? (bid_ % 8) * (G_ / 8) + bid_ / 8 : bid_;
    float* const out = OUTP(); const float* const nfin_ = FPTR(P_NFIN); const bf16* const XB = (const bf16*)(WSP() + WS_XB);
    const int gw = vcu * NWAVES + wave, NGW = G_ * NWAVES;
    f32x4 g[4][2];
#pragma unroll
    for (int j = 0; j < 4; ++j) { g[j][0] = *(const GAS f32x4*)(nfin_ + 512 * j + 8 * lane); g[j][1] = *(const GAS f32x4*)(nfin_ + 512 * j + 8 * lane + 4); }
    for (int m = gw; m < MR; m += NGW) {
        v4u w[4]; float s = 0.f; f32x4 v[4][2];
        if (m < MP) { const GAS v4u* xr = (const GAS v4u*)(XB + (size_t)m * DM) + lane;
#pragma unroll
            for (int j = 0; j < 4; ++j) w[j] = xr[64 * j]; }
        else { const bf16* const xbs = (const bf16*)(WSP() + WS_XBS);
#pragma unroll
            for (int j = 0; j < 4; ++j) w[j] = *(const GAS v4u*)(xbs + samp_toff(m - MP, 8 * lane + 512 * j)); }
#pragma unroll
        for (int j = 0; j < 4; ++j) { v[j][0] = (f32x4){__uint_as_float(w[j].x << 16), __uint_as_float(w[j].x & 0xffff0000u), __uint_as_float(w[j].y << 16), __uint_as_float(w[j].y & 0xffff0000u)};
            v[j][1] = (f32x4){__uint_as_float(w[j].z << 16), __uint_as_float(w[j].z & 0xffff0000u), __uint_as_float(w[j].w << 16), __uint_as_float(w[j].w & 0xffff0000u)};
#pragma unroll
            for (int h = 0; h < 2; ++h) s += (v[j][h][0] * v[j][h][0] + v[j][h][1] * v[j][h][1]) + (v[j][h][2] * v[j][h][2] + v[j][h][3] * v[j][h][3]); }
        const float rs = 1.0f / sqrtf(wave_sum(s) * (1.0f / DM) + 1e-6f);
        GAS f32x4* yr = (GAS f32x4*)(out + (size_t)m * DM + 8 * lane);
#pragma unroll
        for (int j = 0; j < 4; ++j) { yr[128 * j] = v[j][0] * rs * g[j][0]; yr[128 * j + 1] = v[j][1] * rs * g[j][1]; }
    }
}

#ifndef WGM_BIG
#define WGM_BIG 4
#endif
#ifndef GP_ALIGN
#define GP_ALIGN true
#endif
#ifndef GP_SP2
#define GP_SP2 true
#endif
struct Args { const float* in[17]; float* out; unsigned char* ws; int pr_lo, pr_hi; };
template <int SITE> __global__ void __launch_bounds__(NWAVES * 64, 2) mk_fwd(Args args) {
    extern __shared__ __attribute__((aligned(16))) unsigned char lds[];
    Frame F;
    F.lds = (LAS unsigned char*)lds;
    F.MISC = (volatile LAS unsigned*)(F.lds + MISC_OFF);
    for (int u = threadIdx.x; u < (LDS_BYTES - RING_BYTES) / 4; u += NWAVES * 64) ((LAS unsigned*)(F.lds + RING_BYTES))[u] = 0u;
    __syncthreads();
    constexpr bool ALL = SITE < 0;
    const int wave0 = __builtin_amdgcn_readfirstlane(threadIdx.x >> 6);
    XcdBarrier bar; bar.bar = nullptr; bar.x = 0; bar.st = nullptr;
    if constexpr (ALL) { KARGS(); bar = xcd_barrier_post((unsigned*)(WSP() + WS_CTL) + CW_BAR, F.MISC + 8); }
#ifndef PHM
#define PHM 0xFFFF
#endif
#define ON(b) (((PHM >> (b)) & 1) && (ALL || SITE == (b)))
#ifdef TS_DIAG
    volatile LAS unsigned long long* const TSW = (volatile LAS unsigned long long*)(F.lds + MISC_OFF + 128);
    if (wave0 == 0 && opaque_lane() == 0) TSW[0] = __builtin_amdgcn_s_memrealtime();
#ifndef TS_BLOCK
#define TS_BLOCK 0
#endif
#ifndef TS_B
#define TS_B (-1)
#endif
#define TS_MARK(cat) do { if (((cat) == TS_A || (cat) == TS_B || true) && wave0 == 0 && opaque_lane() == 0) { const unsigned long long now_ = __builtin_amdgcn_s_memrealtime(), d_ = now_ - TSW[0]; if ((cat) == TS_A) TSW[1] += d_; if ((cat) == TS_B) TSW[2] += d_; TSW[0] = now_; } } while (0)
#else
#define TS_MARK(cat) do {} while (0)
#endif
#define JIT_WQ(site) ((site) <= 1 ? fill_must(pr_, 2) : (site) <= 6 ? fill_must(pr_, 7) : (pr_ == 0 ? fill_must(1, 2) : (unsigned)FW_TASKS))
#define SEAM(site) do { if constexpr (ALL) { KARGS(); OTID(ftid); XcdBarrier b_ = bar; asm volatile("" : "+s"(b_.bar)); { const unsigned e1_ = (unsigned)(((site) ? pr_ * 10 : 0) + (site) + 1); const bool el_ = (((blockIdx.x >> 3) + e1_) & (FILL_MOD - 1u)) == 0u;     \
        constexpr bool att_ = (site) == 2 || (site) == 7;     \
        xcd_barrier_fill(b_, F, KA, ftid, fill_must((site) ? pr_ : 0, (site)), att_ ? (unsigned)FW_TASKS : (el_ ? JIT_WQ(site) : 0u), att_ ? (unsigned)CPY_TASKS : (el_ ? e1_ * FILL_CQ : 0u), att_ ? 1 : (((site) == 3 || (site) == 8) ? 2 : 0), pr_, (site) == 7 || (site) == 8); } TS_MARK(8); } } while (0)
#define OTID(name) int name = (wave0 << 6) | opaque_lane(); asm volatile("" : "+v"(name))
#define DYN_TASKS(tidv, TKT, NTASKS, ...) do { gu32* const tk_ = (gu32*)(ws + WS_CTL) + CW_TKT + 64 * (TKT); \
        for (;;) { if ((tidv) == 0) { const unsigned tk1_ = __hip_atomic_fetch_add(tk_, 1u, __ATOMIC_RELAXED, __HIP_MEMORY_SCOPE_AGENT), fc1_ = __hip_atomic_load((gu32*)(ws + WS_CTL) + CW_CPY, RLX_AGENT); F.MISC[16] = tk1_; F.MISC[18] = fc1_; }     \
            __syncthreads(); const int t = (int)F.MISC[16]; if (t >= (NTASKS)) break; __VA_ARGS__; __syncthreads(); } } while (0)
#define DYN_TASKS_PRE(tidv, TKT, NTASKS, ...) do { gu32* const tk_ = (gu32*)(ws + WS_CTL) + CW_TKT + 64 * (TKT); \
        for (bool first_ = true;; first_ = false) { if ((tidv) == 0 && !first_) { const unsigned tk1_ = __hip_atomic_fetch_add(tk_, 1u, __ATOMIC_RELAXED, __HIP_MEMORY_SCOPE_AGENT), fc1_ = __hip_atomic_load((gu32*)(ws + WS_CTL) + CW_CPY, RLX_AGENT); F.MISC[16] = tk1_; F.MISC[18] = fc1_; }     \
            __syncthreads(); const int t = (int)F.MISC[16]; if (t >= (NTASKS)) break; __VA_ARGS__; __syncthreads(); } } while (0)
#define SITE_IDS() KARGS(); OTID(otid); (void)otid; int bid = blockIdx.x, G = gridDim.x; asm volatile("" : "+s"(bid), "+s"(G)); const int vcu = (G % 8 == 0) ? (bid % 8) * (G / 8) + bid / 8 : bid; (void)vcu
    LAS char* const alds = (LAS char*)F.lds;

    { const int pr_ = 0; if (ON(0)) { p0_prologue(F, wave0); TS_MARK(0); } SEAM(0); }

    for (int pr = args.pr_lo; pr < args.pr_hi; ++pr) { const int pr_ = pr;
        if (ON(1)) {
            SITE_IDS(); const int TKT_ID = pr * 12 + 1; (void)TKT_ID;
            unsigned char* const ws = WSP();
            pg8::Gemm g{(const bf16*)(ws + WS_XB), (const bf16*)(ws + WS_WQA + (size_t)pr * 24 * MiB), MP, 6144, 2048}; pg8::StaticOrder S; S.init(MP, 6144, G, bid, WGM_BIG);
            pg8::EpiQKV<false> E{ws, OUTP(), pr};
            pg8::gemm_phase<pg8::EpiQKV<false>, pg8::StaticOrder, GP_ALIGN, GP_SP2>(F.lds, g, S, E, otid, pg8::Tail{(unsigned*)(ws + WS_CTL) + CW_TKT + 64 * TKT_ID, (unsigned*)(ws + WS_CTL) + CW_CPY, (volatile PG8_LAS unsigned*)(F.MISC + 16), nullptr});
            { mini::EpiQKV<false> ME{ws, OUTP(), pr}; OTID(mtid);
              DYN_TASKS_PRE(mtid, TKT_ID, 6144 / 32, mini::task<mini::EpiQKV<false>, 2, 2>(mtid, (const bf16*)(ws + WS_XBS), g.Bt, 2048, 32 * t, (LAS float*)F.lds, ME)); }
        TS_MARK(1); } SEAM(1);
        if (ON(2)) {
            SITE_IDS(); const int TKT_ID = pr * 12 + 2; (void)TKT_ID;
            unsigned char* const ws = WSP(); const bf16* const QB = (const bf16*)(ws + WS_Q); bf16* const OB = (bf16*)(ws + WS_O); const bf16* const KB = (const bf16*)(ws + WS_K); const bf16* const VB = (const bf16*)(ws + WS_V);
            const float* rel = FPTR(P_AREL) + (size_t)pr * 16 * 257;
            for (int u = vcu; u < 2048; u += G) { const int bh = u >> 5, qb = u & 31;
                att::attnA_unit(otid, bh >> 4, bh & 15, qb, QB, KB, VB, OB, rel + (bh & 15) * 257, alds); }
            __syncthreads();
            OTID(otid2);
            DYN_TASKS(otid2, TKT_ID, 128, att::sample_attn_unit<128, 512, true>(otid2, t >> 4, t & 15, QB, KB, VB, (bf16*)(ws + WS_OS), FPTR(P_CAK) + (size_t)pr * 8 * 512 * 2048, FPTR(P_CAV) + (size_t)pr * 8 * 512 * 2048, rel + (t & 15) * 257, alds));
            __syncthreads();
        TS_MARK(2); } SEAM(2);
        if (ON(3)) {
            SITE_IDS(); const int TKT_ID = pr * 12 + 3; (void)TKT_ID;
            unsigned char* const ws = WSP();
            pg8::Gemm g{(const bf16*)(ws + WS_O), (const bf16*)(ws + WS_WOA + (size_t)pr * 8 * MiB), MP, 2048, 2048}; pg8::StaticOrder S; S.init(MP, 2048, G, bid, 4);
            pg8::EpiRes E{ws, 1};
            pg8::gemm_phase<pg8::EpiRes, pg8::StaticOrder, GP_ALIGN, GP_SP2>(F.lds, g, S, E, otid, pg8::Tail{(unsigned*)(ws + WS_CTL) + CW_TKT + 64 * TKT_ID, (unsigned*)(ws + WS_CTL) + CW_CPY, (volatile PG8_LAS unsigned*)(F.MISC + 16), (unsigned*)(ws + WS_CTL) + CW_ST + 64 * (2 * pr + 0)});
            { mini::EpiRes ME{ws, 1}; OTID(mtid);
              DYN_TASKS_PRE(mtid, TKT_ID, 2048 / 16, mini::task<mini::EpiRes, 1, 4>(mtid, (const bf16*)(ws + WS_OS), g.Bt, 2048, 16 * t, (LAS float*)F.lds, ME)); }
        TS_MARK(4); } SEAM(3);
        if (ON(4)) {
            SITE_IDS(); const int TKT_ID = pr * 12 + 4; (void)TKT_ID;
            unsigned char* const ws = WSP();
            pg8::Gemm g{(const bf16*)(ws + WS_XB), (const bf16*)(ws + WS_WUP + (size_t)(2 * pr) * 32 * MiB), MP, 8192, 2048}; pg8::StaticOrder S; S.init(MP, 8192, G, bid, WGM_BIG);
            pg8::EpiUp E{ws};
            pg8::gemm_phase<pg8::EpiUp, pg8::StaticOrder, GP_ALIGN, GP_SP2>(F.lds, g, S, E, otid, pg8::Tail{(unsigned*)(ws + WS_CTL) + CW_TKT + 64 * TKT_ID, (unsigned*)(ws + WS_CTL) + CW_CPY, (volatile PG8_LAS unsigned*)(F.MISC + 16), nullptr});
            { mini::EpiUp ME{ws}; OTID(mtid);
              DYN_TASKS_PRE(mtid, TKT_ID, 8192 / 32, mini::task<mini::EpiUp, 2, 2>(mtid, (const bf16*)(ws + WS_XBS), g.Bt, 2048, 32 * t, (LAS float*)F.lds, ME)); }
        TS_MARK(5); } SEAM(4);
        if (ON(5)) {
            SITE_IDS(); const int TKT_ID = pr * 12 + 5; (void)TKT_ID;
            unsigned char* const ws = WSP();
            pg8::Gemm g{(const bf16*)(ws + WS_ACT), (const bf16*)(ws + WS_WDN + (size_t)(2 * pr) * 32 * MiB), MP, 2048, 8192}; pg8::StaticOrder S; S.init(MP, 2048, G, bid, 4, 0);
            pg8::EpiRes E{ws, 0};
            pg8::gemm_phase<pg8::EpiRes, pg8::StaticOrder, GP_ALIGN, GP_SP2, true>(F.lds, g, S, E, otid, pg8::Tail{(unsigned*)(ws + WS_CTL) + CW_TKT + 64 * TKT_ID, (unsigned*)(ws + WS_CTL) + CW_CPY, (volatile PG8_LAS unsigned*)(F.MISC + 16), nullptr});
            { mini::EpiRes ME{ws, 0}; OTID(mtid);
              DYN_TASKS_PRE(mtid, TKT_ID, 2048 / 16, mini::task<mini::EpiRes, 1, 4>(mtid, (const bf16*)(ws + WS_HS), g.Bt, 8192, 16 * t, (LAS float*)F.lds, ME)); }
        TS_MARK(6); } SEAM(5);
        if (ON(6)) {
            SITE_IDS(); const int TKT_ID = pr * 12 + 6; (void)TKT_ID;
            unsigned char* const ws = WSP();
            pg8::Gemm g{(const bf16*)(ws + WS_XB), (const bf16*)(ws + WS_WQB + (size_t)pr * 12 * MiB), MP, 3072, 2048}; pg8::StaticOrder S; S.init(MP, 3072, G, bid, WGM_BIG);
            pg8::EpiQKV<true> E{ws, OUTP(), pr};
            pg8::gemm_phase<pg8::EpiQKV<true>, pg8::StaticOrder, GP_ALIGN, GP_SP2>(F.lds, g, S, E, otid, pg8::Tail{(unsigned*)(ws + WS_CTL) + CW_TKT + 64 * TKT_ID, (unsigned*)(ws + WS_CTL) + CW_CPY, (volatile PG8_LAS unsigned*)(F.MISC + 16), nullptr});
            { mini::EpiQKV<true> ME{ws, OUTP(), pr}; OTID(mtid);
              DYN_TASKS_PRE(mtid, TKT_ID, 3072 / 16, mini::task<mini::EpiQKV<true>, 1, 4>(mtid, (const bf16*)(ws + WS_XBS), g.Bt, 2048, 16 * t, (LAS float*)F.lds, ME)); }
        TS_MARK(1); } SEAM(6);
        if (ON(7)) {
            SITE_IDS(); const int TKT_ID = pr * 12 + 7; (void)TKT_ID;
            unsigned char* const ws = WSP(); const bf16* const QB = (const bf16*)(ws + WS_Q); bf16* const OB = (bf16*)(ws + WS_O); const bf16* const KB = (const bf16*)(ws + WS_K); const bf16* const VB = (const bf16*)(ws + WS_V);
            const float* sinks = FPTR(P_BSINK) + pr * 32;
            for (int u = vcu; u < 256; u += G) { const int bk = u >> 3, run = u & 7;
                att::attnB_unit(otid, bk >> 3, bk & 7, run, QB, KB, VB, OB, sinks, alds); }
            __syncthreads();
            OTID(otid2);
            DYN_TASKS(otid2, TKT_ID, 256, att::sample_attn_unit<64, 128, false>(otid2, t >> 5, t & 31, QB, KB, VB, (bf16*)(ws + WS_OS), FPTR(P_CBK) + (size_t)pr * 8 * 128 * 512, FPTR(P_CBV) + (size_t)pr * 8 * 128 * 512, sinks, alds));
            __syncthreads();
        TS_MARK(3); } SEAM(7);
        if (ON(8)) {
            SITE_IDS(); const int TKT_ID = pr * 12 + 8; (void)TKT_ID;
            unsigned char* const ws = WSP();
            pg8::Gemm g{(const bf16*)(ws + WS_O), (const bf16*)(ws + WS_WOB + (size_t)pr * 8 * MiB), MP, 2048, 2048}; pg8::StaticOrder S; S.init(MP, 2048, G, bid, 4);
            pg8::EpiRes E{ws, 1};
            pg8::gemm_phase<pg8::EpiRes, pg8::StaticOrder, GP_ALIGN, GP_SP2>(F.lds, g, S, E, otid, pg8::Tail{(unsigned*)(ws + WS_CTL) + CW_TKT + 64 * TKT_ID, (unsigned*)(ws + WS_CTL) + CW_CPY, (volatile PG8_LAS unsigned*)(F.MISC + 16), (unsigned*)(ws + WS_CTL) + CW_ST + 64 * (2 * pr + 1)});
            { mini::EpiRes ME{ws, 1}; OTID(mtid);
              DYN_TASKS_PRE(mtid, TKT_ID, 2048 / 16, mini::task<mini::EpiRes, 1, 4>(mtid, (const bf16*)(ws + WS_OS), g.Bt, 2048, 16 * t, (LAS float*)F.lds, ME)); }
        TS_MARK(4); } SEAM(8);
        if (ON(9)) {
            SITE_IDS(); const int TKT_ID = pr * 12 + 9; (void)TKT_ID;
            unsigned char* const ws = WSP();
            pg8::Gemm g{(const bf16*)(ws + WS_XB), (const bf16*)(ws + WS_WUP + (size_t)(2 * pr + 1) * 32 * MiB), MP, 8192, 2048}; pg8::StaticOrder S; S.init(MP, 8192, G, bid, WGM_BIG);
            pg8::EpiUp E{ws};
            pg8::gemm_phase<pg8::EpiUp, pg8::StaticOrder, GP_ALIGN, GP_SP2>(F.lds, g, S, E, otid, pg8::Tail{(unsigned*)(ws + WS_CTL) + CW_TKT + 64 * TKT_ID, (unsigned*)(ws + WS_CTL) + CW_CPY, (volatile PG8_LAS unsigned*)(F.MISC + 16), nullptr});
            { mini::EpiUp ME{ws}; OTID(mtid);
              DYN_TASKS_PRE(mtid, TKT_ID, 8192 / 32, mini::task<mini::EpiUp, 2, 2>(mtid, (const bf16*)(ws + WS_XBS), g.Bt, 2048, 32 * t, (LAS float*)F.lds, ME)); }
        TS_MARK(5); } SEAM(9);
        if (ON(10)) {
            SITE_IDS(); const int TKT_ID = pr * 12 + 10; (void)TKT_ID;
            unsigned char* const ws = WSP();
            pg8::Gemm g{(const bf16*)(ws + WS_ACT), (const bf16*)(ws + WS_WDN + (size_t)(2 * pr + 1) * 32 * MiB), MP, 2048, 8192}; pg8::StaticOrder S; S.init(MP, 2048, G, bid, 4, 0);
            pg8::EpiRes E{ws, 0};
            pg8::gemm_phase<pg8::EpiRes, pg8::StaticOrder, GP_ALIGN, GP_SP2, true>(F.lds, g, S, E, otid, pg8::Tail{(unsigned*)(ws + WS_CTL) + CW_TKT + 64 * TKT_ID, (unsigned*)(ws + WS_CTL) + CW_CPY, (volatile PG8_LAS unsigned*)(F.MISC + 16), nullptr});
            { mini::EpiRes ME{ws, 0}; OTID(mtid);
              DYN_TASKS_PRE(mtid, TKT_ID, 2048 / 16, mini::task<mini::EpiRes, 1, 4>(mtid, (const bf16*)(ws + WS_HS), g.Bt, 8192, 16 * t, (LAS float*)F.lds, ME)); }
        TS_MARK(6); } SEAM(10);
    }
    if (ON(11)) { final_norm(F, wave0); if constexpr (ALL) { KARGS(); OTID(ftid); __syncthreads(); fill_until(F, KA, ftid, FW_TASKS, CPY_TASKS); } }
#ifdef TS_DIAG
    TS_MARK(7);
    if constexpr (ALL) { { XcdBarrier b_ = bar; xcd_barrier(b_); } KARGS(); float* const out = OUTP(); __syncthreads(); const float va = (float)TSW[1] * 0.001f;
        OTID(dtid); if (blockIdx.x == TS_BLOCK && dtid == 0) out[(size_t)MP * DM] = va; }
#endif
#undef ON
#undef SEAM
}

extern "C" void kernel_launch(void* const* d_in, const int* in_sizes, int n_in, void* d_out, int out_size, void* d_ws, size_t ws_size, hipStream_t stream) {
    static int grid = 0;
    if (grid == 0) {
        if (n_in != 17 || in_sizes[0] != MP * DM || (size_t)out_size != O_END || ws_size < WS_END) { fprintf(stderr, "kernel_launch: unexpected shapes (n_in %d, in0 %d, out %d, ws %zu)\n", n_in, n_in > 0 ? in_sizes[0] : -1, out_size, ws_size); grid = -1; return; }
        int dev = 0, cus = 0, per_cu = 0;
        if (hipGetDevice(&dev) != hipSuccess || hipDeviceGetAttribute(&cus, hipDeviceAttributeMultiprocessorCount, dev) != hipSuccess) { grid = -1; return; }
#if MK_ONE_LAUNCH
        if (hipFuncSetAttribute((const void*)mk_fwd<-1>, hipFuncAttributeMaxDynamicSharedMemorySize, LDS_BYTES) != hipSuccess) { fprintf(stderr, "kernel_launch: hipFuncSetAttribute failed\n"); grid = -1; return; }
        if (hipOccupancyMaxActiveBlocksPerMultiprocessor(&per_cu, (const void*)mk_fwd<-1>, NWAVES * 64, LDS_BYTES) != hipSuccess || per_cu < 1) { fprintf(stderr, "kernel_launch: occupancy query reports %d workgroups per CU\n", per_cu); grid = -1; return; }
#else
#define SETATTR(s) (hipFuncSetAttribute((const void*)mk_fwd<s>, hipFuncAttributeMaxDynamicSharedMemorySize, LDS_BYTES) == hipSuccess)
        if (!(SETATTR(0) && SETATTR(1) && SETATTR(2) && SETATTR(3) && SETATTR(4) && SETATTR(5) && SETATTR(6) && SETATTR(7) && SETATTR(8) && SETATTR(9) && SETATTR(10) && SETATTR(11))) { fprintf(stderr, "kernel_launch: hipFuncSetAttribute failed\n"); grid = -1; return; }
        per_cu = 1;
#endif
        (void)hipGetLastError();
        grid = cus;
    }
    if (grid < 0) return;
    if (hipMemsetAsync((char*)d_ws + WS_CTL, 0, CTL_ZERO_BYTES, stream) != hipSuccess) return;
    Args a{};
    for (int i = 0; i < 17; ++i) a.in[i] = (const float*)d_in[i];
    a.out = (float*)d_out; a.ws = (unsigned char*)d_ws;
#if MK_ONE_LAUNCH
    a.pr_lo = 0; a.pr_hi = 2;
    hipLaunchKernelGGL(mk_fwd<-1>, dim3(grid), dim3(NWAVES * 64), LDS_BYTES, stream, a);
#else
#define LAUNCH_SITE(s, p0, p1) do { a.pr_lo = (p0); a.pr_hi = (p1); hipLaunchKernelGGL(mk_fwd<s>, dim3(grid), dim3(NWAVES * 64), LDS_BYTES, stream, a); } while (0)
    LAUNCH_SITE(0, 0, 0);
    for (int p = 0; p < 2; ++p) { LAUNCH_SITE(1, p, p + 1); LAUNCH_SITE(2, p, p + 1); LAUNCH_SITE(3, p, p + 1); LAUNCH_SITE(4, p, p + 1); LAUNCH_SITE(5, p, p + 1);
                                  LAUNCH_SITE(6, p, p + 1); LAUNCH_SITE(7, p, p + 1); LAUNCH_SITE(8, p, p + 1); LAUNCH_SITE(9, p, p + 1); LAUNCH_SITE(10, p, p + 1); }
    LAUNCH_SITE(11, 0, 0);
#endif
    const hipError_t le = hipPeekAtLastError();
    if (le != hipSuccess) fprintf(stderr, "kernel_launch: launch failed: %s\n", hipGetErrorName(le));
}
```

```cpp
#include <hip/hip_runtime.h>
#include <cstdio>
#include <cstdint>
template <int K> __device__ __forceinline__ float xl_swz(float v) { return __builtin_bit_cast(float, __builtin_amdgcn_ds_swizzle(__builtin_bit_cast(int, v), (K << 10) | 0x1f)); }
__device__ __forceinline__ void xl_swap32(float& a, float& b) { asm volatile("s_nop 1\n\tv_permlane32_swap_b32 %0, %1" : "+v"(a), "+v"(b)); }
__device__ __forceinline__ float xl_add32(float v) { float a = v, b = v; xl_swap32(a, b); return a + b; }
__device__ __forceinline__ float xl_max32(float v) { float a = v, b = v; xl_swap32(a, b); return fmaxf(a, b); }
__device__ __forceinline__ float xl_wave_sum(float v) { v += xl_swz<1>(v); v += xl_swz<2>(v); v += xl_swz<4>(v); v += xl_swz<8>(v); v += xl_swz<16>(v); return xl_add32(v); }
__device__ __forceinline__ float xl_wave_max(float v) { v = fmaxf(v, xl_swz<1>(v)); v = fmaxf(v, xl_swz<2>(v)); v = fmaxf(v, xl_swz<4>(v)); v = fmaxf(v, xl_swz<8>(v)); v = fmaxf(v, xl_swz<16>(v)); return xl_max32(v); }
__host__ __device__ __forceinline__ size_t samp_toff(int r, int c) { return ((size_t)(((c >> 5) * 8 + (r >> 4)) * 64 + ((c >> 3) & 3) * 16 + (r & 15))) * 8 + (c & 7); }
namespace pg8 {
#define PG8_LAS __attribute__((address_space(3)))
typedef unsigned short bf16_t;
typedef short bf16x8 __attribute__((ext_vector_type(8)));
typedef float f32x4 __attribute__((ext_vector_type(4)));
typedef unsigned u32x4 __attribute__((ext_vector_type(4)));
constexpr int BM = 256, BK = 64, HALF = 128, HTB = HALF * BK * 2  , STAGE_BYTES = 8 * HTB, NXCD = 8, WGM = 8;

__host__ __device__ __forceinline__ int lds_byte(int r, int c) { const int st = (r >> 4) * 2 + (c >> 5), rr = r & 15, cc = c & 31, ob = rr * 64 + cc * 2; return st * 1024 + (ob ^ (((ob >> 9) & 1) << 5)); }
__host__ __device__ __forceinline__ void stage_rc(int b, int& R, int& C) { const int st = b / 1024, sb = b % 1024, swz = sb ^ (((sb >> 9) & 1) << 5); R = (st >> 1) * 16 + swz / 64; C = (st & 1) * 32 + (swz % 64) / 2; }
__host__ __device__ __forceinline__ int perm32(int rho) { const int n = rho >> 4, i = rho & 15; return 8 * (i >> 2) + 4 * n + (i & 3); }

struct Unit { int pm, pn; };
struct Gemm { const bf16_t* A; const bf16_t* Bt; int M, N, K; };

struct StaticOrder {
    int nM, nN, nwg, G, c, wgm, rev;
    __host__ __device__ void init(int M, int N, int G_, int c_, int wgm_ = WGM, int rev_ = 0) { nM = M / BM; nN = N / BM; nwg = nM * nN; G = G_; c = c_; wgm = wgm_; rev = rev_; }
    __host__ __device__ bool next(int i, Unit& u) const {
        const int nr = (nwg + G - 1) / G; if (i >= nr) return false; const long L = (long)(rev ? nr - 1 - i : i) * G + c; if (L >= nwg) return false;
        int wgid = (int)L; { const int q = nwg / NXCD, r = nwg % NXCD, xcd = wgid % NXCD, off = wgid / NXCD; wgid = (xcd < r ? xcd * (q + 1) : r * (q + 1) + (xcd - r) * q) + off; }
        const int nig = wgm * nN, gid = wgid / nig, fm = gid * wgm, gsz = (nM - fm) < wgm ? (nM - fm) : wgm;
        u.pm = fm + ((wgid % nig) % gsz); u.pn = (wgid % nig) / gsz; return true;
    }
    __device__ __forceinline__ void a_ready(const Unit&) const {}
    __device__ __forceinline__ void done(const Unit&) const {}
};

__device__ __forceinline__ unsigned cvt_pk_bf16(float lo, float hi) { unsigned r; asm volatile("v_cvt_pk_bf16_f32 %0, %1, %2" : "=v"(r) : "v"(lo), "v"(hi)); return r; }
typedef float f32x2 __attribute__((ext_vector_type(2)));
__device__ __forceinline__ float row_rstd(const float* SS, int row, int fq) {
    const f32x4* p = (const f32x4*)(SS + (size_t)row * 32 + fq * 8); const f32x4 a = p[0], b = p[1];
    float s = ((a[0] + a[1]) + (a[2] + a[3])) + ((b[0] + b[1]) + (b[2] + b[3]));
    s += xl_swz<16>(s); s = xl_add32(s);
    return __builtin_amdgcn_rsqf(s * (1.0f / 2048.0f) + 1e-6f);
}
constexpr int ROWS_P = 32768, ROWS_R = 32896;
constexpr size_t WS_XB_ = (size_t)361 << 20, WS_SS0_ = (size_t)490 << 20, WS_SS1_ = (size_t)495 << 20, WS_Q_ = (size_t)500 << 20, WS_K_ = (size_t)629 << 20, WS_V_ = (size_t)758 << 20;
template <bool ISB> struct EpiQKV {
    static constexpr bool PERM = true, AFTER_DRAIN = false;
    unsigned char* ws; float* out; int pr;
    __device__ __forceinline__ void operator()(const f32x4 (&acc)[2][2][4][2], const Unit& u, int wr, int wc, int fr, int fq) const {
        constexpr int nkv = ISB ? 512 : 2048;
        constexpr float qscale = (ISB ? 0.125f : 0.08838834764831845f) * 1.4426950408889634f;
        const float* SS = (const float*)(ws + WS_SS0_);
        const int colt = u.pn * BM; const int region = colt < 2048 ? 0 : (colt < 2048 + nkv ? 1 : 2);
        const int cbase = (region == 0 ? colt : (region == 1 ? colt - 2048 : colt - 2048 - nkv)) + wc * 32 + 8 * fq;
        bf16_t* const ob = (bf16_t*)(ws + (region == 0 ? WS_Q_ : (region == 1 ? WS_K_ : WS_V_))); const int ld = region == 0 ? 2048 : nkv;
        const float sc = region == 0 ? qscale : 1.0f;
#pragma unroll
        for (int ai = 0; ai < 2; ++ai)
#pragma unroll
            for (int m = 0; m < 4; ++m) {
                const int row = u.pm * BM + ai * HALF + wr * 64 + m * 16 + fr;
                const float rs = row_rstd(SS, row, fq) * sc;
#pragma unroll
                for (int bj = 0; bj < 2; ++bj) {
                    const f32x4 v0 = acc[ai][bj][m][0] * rs, v1 = acc[ai][bj][m][1] * rs; const int col = cbase + bj * HALF;
                    u32x4 w; w.x = cvt_pk_bf16(v0[0], v0[1]); w.y = cvt_pk_bf16(v0[2], v0[3]); w.z = cvt_pk_bf16(v1[0], v1[1]); w.w = cvt_pk_bf16(v1[2], v1[3]);
                    *(u32x4*)(ob + (size_t)row * ld + col) = w;
                }
            }
    }
};
__device__ __forceinline__ float bf_lo(unsigned w) { return __builtin_bit_cast(float, w << 16); }
__device__ __forceinline__ float bf_hi(unsigned w) { return __builtin_bit_cast(float, w & 0xffff0000u); }
struct EpiRes {
    static constexpr bool PERM = true, AFTER_DRAIN = false;
    unsigned char* ws; int sssel;
    __device__ __forceinline__ void operator()(const f32x4 (&acc)[2][2][4][2], const Unit& u, int wr, int wc, int fr, int fq) const {
        const int col0 = u.pn * BM + wc * 32 + 8 * fq; bf16_t* const XB = (bf16_t*)(ws + WS_XB_); float* const SSout = (float*)(ws + (sssel ? WS_SS1_ : WS_SS0_));
#pragma unroll
        for (int ai = 0; ai < 2; ++ai)
#pragma unroll
            for (int m = 0; m < 4; ++m) {
                const int row = u.pm * BM + ai * HALF + wr * 64 + m * 16 + fr;
                float ssq = 0.f;
#pragma unroll
                for (int bj = 0; bj < 2; ++bj) { u32x4* const px = (u32x4*)(XB + (size_t)row * 2048 + col0 + bj * HALF);
                    const u32x4 xo = *px; const f32x4 a0 = acc[ai][bj][m][0], a1 = acc[ai][bj][m][1];
                    u32x4 w; w.x = cvt_pk_bf16(bf_lo(xo.x) + a0[0], bf_hi(xo.x) + a0[1]); w.y = cvt_pk_bf16(bf_lo(xo.y) + a0[2], bf_hi(xo.y) + a0[3]);
                    w.z = cvt_pk_bf16(bf_lo(xo.z) + a1[0], bf_hi(xo.z) + a1[1]); w.w = cvt_pk_bf16(bf_lo(xo.w) + a1[2], bf_hi(xo.w) + a1[3]);
                    *px = w;
                    const float r0 = bf_lo(w.x), r1 = bf_hi(w.x), r2 = bf_lo(w.y), r3 = bf_hi(w.y), r4 = bf_lo(w.z), r5 = bf_hi(w.z), r6 = bf_lo(w.w), r7 = bf_hi(w.w);
                    ssq += ((r0 * r0 + r1 * r1) + (r2 * r2 + r3 * r3)) + ((r4 * r4 + r5 * r5) + (r6 * r6 + r7 * r7)); }
                ssq += xl_swz<16>(ssq); ssq = xl_add32(ssq);
                if (fq == 0) SSout[(size_t)row * 32 + u.pn * 4 + wc] = ssq;
            }
    }
};
struct EpiUp {
    static constexpr bool PERM = true, AFTER_DRAIN = false;
    unsigned char* ws;
    __device__ __forceinline__ void operator()(const f32x4 (&acc)[2][2][4][2], const Unit& u, int wr, int wc, int fr, int fq) const {
        const int col0 = u.pn * BM + wc * 32 + 8 * fq; bf16_t* const H = (bf16_t*)(ws + WS_Q_); const float* const SS = (const float*)(ws + WS_SS1_);
#pragma unroll
        for (int ai = 0; ai < 2; ++ai)
#pragma unroll
            for (int m = 0; m < 4; ++m) {
                const int row = u.pm * BM + ai * HALF + wr * 64 + m * 16 + fr;
                const float rs = row_rstd(SS, row, fq);
#pragma unroll
                for (int bj = 0; bj < 2; ++bj) {
                    f32x4 v0 = acc[ai][bj][m][0] * rs, v1 = acc[ai][bj][m][1] * rs;
#pragma unroll
                    for (int e = 0; e < 4; ++e) { const float a = fmaxf(v0[e], 0.f), b = fmaxf(v1[e], 0.f); v0[e] = a * a; v1[e] = b * b; }
                    u32x4 w; w.x = cvt_pk_bf16(v0[0], v0[1]); w.y = cvt_pk_bf16(v0[2], v0[3]); w.z = cvt_pk_bf16(v1[0], v1[1]); w.w = cvt_pk_bf16(v1[2], v1[3]);
                    { const int col = col0 + bj * HALF; __builtin_nontemporal_store(w, (u32x4*)(H + (size_t)(col >> 6) * ((size_t)ROWS_P * 64) + (size_t)row * 64 + (col & 63))); }
                }
            }
    }
};
struct Tail { unsigned* tk; unsigned* fc; volatile PG8_LAS unsigned* slot; unsigned* st; };
template <class Epi, class Sched, bool ALIGN_EPI = false, bool SP2 = false, bool ATILED = false>
__device__ __forceinline__ void gemm_phase(PG8_LAS unsigned char* lds, const Gemm g, const Sched& S, const Epi& E, const int tid_in, const Tail T);
template <class Epi, class Sched, bool ALIGN_EPI, bool SP2, bool ATILED>
__device__ __forceinline__ void gemm_phase(PG8_LAS unsigned char* lds, const Gemm g, const Sched& S, const Epi& E, const int tid_in, const Tail T) {
    int tid_ = tid_in; asm volatile("" : "+v"(tid_));
    const int tid = tid_, wid = __builtin_amdgcn_readfirstlane(tid >> 6), lane = tid & 63, wr = wid >> 2, wc = wid & 3, fr = lane & 15, fq = lane >> 4;
    const int K = g.K, nt = K / BK;
    unsigned voffA[2], voffB[2];
#pragma unroll
    for (int i = 0; i < 2; ++i) { int R, C; stage_rc(tid * 16 + i * 8192, R, C); const int Rb = Epi::PERM ? ((R & ~31) + perm32(R & 31)) : R;
        voffA[i] = ATILED ? (unsigned)(R * BK + C) * 2u : (unsigned)(R * K + C) * 2u; voffB[i] = (unsigned)(Rb * K + C) * 2u; }
    const size_t kstep = (size_t)(BK * 2);
    const size_t hstep = (size_t)HALF * K * 2;
    const size_t tstep = 2 * hstep;
    const size_t kstepA = ATILED ? (size_t)g.M * BK * 2 : kstep, hstepA = ATILED ? (size_t)HALF * BK * 2 : hstep, tstepA = 2 * hstepA;
    const unsigned ldsw = (unsigned)wid * 1024u;
    const int aoff = lds_byte(wr * 64 + fr, fq * 8), boff = lds_byte(wc * 32 + fr, fq * 8);
#define PG8_SA(b, h) (((b) * 2 + (h)) * HTB)
#define PG8_SB(b, h) ((4 + (b) * 2 + (h)) * HTB)
#define PG8_STAGE(bufoff, gbase, voff) do { _Pragma("unroll") for (int _i = 0; _i < 2; ++_i) \
        __builtin_amdgcn_global_load_lds((const unsigned*)((const char*)(gbase) + (voff)[_i]), (PG8_LAS unsigned*)(lds + (bufoff) + ldsw + _i * 8192), 16, 0, 0); } while (0)
#define PG8_LDA(dst, b, h) do { _Pragma("unroll") for (int m = 0; m < 4; ++m) _Pragma("unroll") for (int k = 0; k < 2; ++k) dst[m][k] = *(const PG8_LAS bf16x8*)(lds + PG8_SA(b, h) + aoff + m * 2048 + k * 1024); } while (0)
#define PG8_LDB(dst, b, h) do { _Pragma("unroll") for (int n = 0; n < 2; ++n) _Pragma("unroll") for (int k = 0; k < 2; ++k) dst[n][k] = *(const PG8_LAS bf16x8*)(lds + PG8_SB(b, h) + boff + n * 2048 + k * 1024); } while (0)
#define PG8_MMA(ai, bj, At, Bt) do { __builtin_amdgcn_s_setprio(1); _Pragma("unroll") for (int m = 0; m < 4; ++m) _Pragma("unroll") for (int n = 0; n < 2; ++n) _Pragma("unroll") for (int k = 0; k < 2; ++k) \
        acc[ai][bj][m][n] = __builtin_amdgcn_mfma_f32_16x16x32_bf16(Bt[n][k], At[m][k], acc[ai][bj][m][n], 0, 0, 0); __builtin_amdgcn_s_setprio(0); } while (0)
#define PG8_WAIT_V(n) asm volatile("s_waitcnt vmcnt(" #n ")" ::: "memory")
#define PG8_WAIT_L(n) asm volatile("s_waitcnt lgkmcnt(" #n ")" ::: "memory")
#define PG8_BAR __builtin_amdgcn_s_barrier()
#define PG8_SCHED __builtin_amdgcn_sched_barrier(0)
    Unit cur, nxt; int ui = 0;
    if (!S.next(0, cur)) return;
    f32x4 acc[2][2][4][2];
#pragma unroll
    for (int a = 0; a < 2; ++a)
#pragma unroll
        for (int b = 0; b < 2; ++b)
#pragma unroll
            for (int m = 0; m < 4; ++m)
#pragma unroll
                for (int n = 0; n < 2; ++n) acc[a][b][m][n] = (f32x4){0.f, 0.f, 0.f, 0.f};
    bf16x8 At[4][2], B0[2][2], B1[2][2];
    const char* cA = (const char*)g.A + (size_t)cur.pm * tstepA; const char* cB = (const char*)g.Bt + (size_t)cur.pn * tstep;
    S.a_ready(cur);
    if constexpr (SP2) {
        PG8_STAGE(PG8_SB(0, 0), cB, voffB); PG8_STAGE(PG8_SB(0, 1), cB + hstep, voffB); PG8_STAGE(PG8_SA(0, 0), cA, voffA); PG8_STAGE(PG8_SA(0, 1), cA + hstepA, voffA);
        if (wr == 1) PG8_BAR;
        PG8_WAIT_V(2); PG8_BAR;
        PG8_STAGE(PG8_SB(1, 0), cB + kstep, voffB); PG8_STAGE(PG8_SA(1, 0), cA + kstepA, voffA); PG8_STAGE(PG8_SB(1, 1), cB + hstep + kstep, voffB);
        PG8_WAIT_V(6); PG8_BAR;
    } else {
        PG8_STAGE(PG8_SB(0, 0), cB, voffB); PG8_STAGE(PG8_SA(0, 0), cA, voffA); PG8_STAGE(PG8_SB(0, 1), cB + hstep, voffB); PG8_STAGE(PG8_SA(0, 1), cA + hstepA, voffA);
        if (wr == 1) PG8_BAR;
        PG8_WAIT_V(4); PG8_BAR;
        PG8_STAGE(PG8_SB(1, 0), cB + kstep, voffB); PG8_STAGE(PG8_SA(1, 0), cA + kstepA, voffA); PG8_STAGE(PG8_SB(1, 1), cB + hstep + kstep, voffB);
        PG8_WAIT_V(6); PG8_BAR;
    }
    for (;;) {
        const bool has_next = S.next(ui + 1, nxt);
        const char* nA = has_next ? (const char*)g.A + (size_t)nxt.pm * tstepA : cA; const char* nB = has_next ? (const char*)g.Bt + (size_t)nxt.pn * tstep : cB;
        for (int t = 0; t < nt; t += 2) {
            const bool last = (t == nt - 2);
            const char* a1 = cA + (size_t)(t + 1) * kstepA;
            const char* a2 = last ? nA : cA + (size_t)(t + 2) * kstepA; const char* b2 = last ? nB : cB + (size_t)(t + 2) * kstep;
            const char* a3 = a2 + kstepA; const char* b3 = b2 + kstep;
            if (last && has_next) S.a_ready(nxt);
            if constexpr (SP2) {
            PG8_LDB(B0, 0, 0); PG8_LDB(B1, 0, 1); PG8_SCHED; PG8_LDA(At, 0, 0); PG8_STAGE(PG8_SA(1, 1), a1 + hstepA, voffA);
            PG8_WAIT_V(8); PG8_WAIT_L(0); PG8_BAR; PG8_MMA(0, 0, At, B0); PG8_MMA(0, 1, At, B1); PG8_BAR; PG8_SCHED;
            PG8_LDA(At, 0, 1); PG8_STAGE(PG8_SB(0, 0), b2, voffB); PG8_STAGE(PG8_SB(0, 1), b2 + hstep, voffB); PG8_STAGE(PG8_SA(0, 0), a2, voffA);
            PG8_WAIT_V(8); PG8_WAIT_L(0); PG8_BAR; PG8_MMA(1, 0, At, B0); PG8_MMA(1, 1, At, B1); PG8_BAR; PG8_SCHED;
            PG8_LDB(B0, 1, 0); PG8_LDB(B1, 1, 1); PG8_SCHED; PG8_LDA(At, 1, 0); PG8_STAGE(PG8_SA(0, 1), a2 + hstepA, voffA);
            PG8_WAIT_V(8); PG8_WAIT_L(0); PG8_BAR; PG8_MMA(0, 0, At, B0); PG8_MMA(0, 1, At, B1); PG8_BAR; PG8_SCHED;
            PG8_LDA(At, 1, 1); PG8_STAGE(PG8_SB(1, 0), b3, voffB); PG8_STAGE(PG8_SB(1, 1), b3 + hstep, voffB); PG8_STAGE(PG8_SA(1, 0), a3, voffA);
            PG8_WAIT_V(8); PG8_WAIT_L(0); PG8_BAR; PG8_MMA(1, 0, At, B0); PG8_MMA(1, 1, At, B1); PG8_BAR; PG8_SCHED;
            } else {
            PG8_LDB(B0, 0, 0); PG8_SCHED; PG8_LDA(At, 0, 0); PG8_STAGE(PG8_SA(1, 1), a1 + hstepA, voffA);
            PG8_WAIT_L(8); PG8_BAR; PG8_WAIT_L(0); PG8_MMA(0, 0, At, B0); PG8_BAR; PG8_SCHED;
            PG8_LDB(B1, 0, 1); PG8_STAGE(PG8_SB(0, 0), b2, voffB);
            PG8_BAR; PG8_WAIT_L(0); PG8_MMA(0, 1, At, B1); PG8_BAR;
            PG8_LDA(At, 0, 1); PG8_STAGE(PG8_SA(0, 0), a2, voffA);
            PG8_BAR; PG8_WAIT_L(0); PG8_MMA(1, 0, At, B0); PG8_BAR; PG8_SCHED;
            PG8_STAGE(PG8_SB(0, 1), b2 + hstep, voffB);
            PG8_WAIT_V(6); PG8_BAR; PG8_MMA(1, 1, At, B1); PG8_BAR;
            PG8_LDB(B0, 1, 0); PG8_SCHED; PG8_LDA(At, 1, 0); PG8_STAGE(PG8_SA(0, 1), a2 + hstepA, voffA);
            PG8_WAIT_L(8); PG8_BAR; PG8_WAIT_L(0); PG8_MMA(0, 0, At, B0); PG8_BAR; PG8_SCHED;
            PG8_LDB(B1, 1, 1); PG8_STAGE(PG8_SB(1, 0), b3, voffB);
            PG8_BAR; PG8_WAIT_L(0); PG8_MMA(0, 1, At, B1); PG8_BAR;
            PG8_LDA(At, 1, 1); PG8_STAGE(PG8_SA(1, 0), a3, voffA);
            PG8_BAR; PG8_WAIT_L(0); PG8_MMA(1, 0, At, B0); PG8_BAR; PG8_SCHED;
            PG8_STAGE(PG8_SB(1, 1), b3 + hstep, voffB);
            PG8_WAIT_V(6); PG8_BAR; PG8_MMA(1, 1, At, B1); PG8_BAR;
            }
        }
        if constexpr (ALIGN_EPI) { if (wr == 0) PG8_BAR; }
        unsigned tk1_ = 0u, fc1_ = 0u, st1_ = 0u;
        if (!has_next && tid == 0) { tk1_ = __hip_atomic_fetch_add((__attribute__((address_space(1))) unsigned*)T.tk, 1u, __ATOMIC_RELAXED, __HIP_MEMORY_SCOPE_AGENT); fc1_ = __hip_atomic_load((__attribute__((address_space(1))) unsigned*)T.fc, __ATOMIC_RELAXED, __HIP_MEMORY_SCOPE_AGENT);
            if (T.st) st1_ = __hip_atomic_load((__attribute__((address_space(1))) unsigned*)T.st, __ATOMIC_RELAXED, __HIP_MEMORY_SCOPE_AGENT); }
        if constexpr (!Epi::AFTER_DRAIN) { E(acc, cur, wr, wc, fr, fq); S.done(cur); }
        if (!has_next && tid == 0) { T.slot[0] = tk1_; T.slot[2] = fc1_; T.slot[3] = st1_; }
        if (!has_next) break;
#pragma unroll
        for (int a = 0; a < 2; ++a)
#pragma unroll
            for (int b = 0; b < 2; ++b)
#pragma unroll
                for (int m = 0; m < 4; ++m)
#pragma unroll
                    for (int n = 0; n < 2; ++n) acc[a][b][m][n] = (f32x4){0.f, 0.f, 0.f, 0.f};
        cur = nxt; cA = nA; cB = nB; ++ui;
        if constexpr (ALIGN_EPI) { if (wr == 1) PG8_BAR; }
    }
    PG8_WAIT_V(0);
    if constexpr (!ALIGN_EPI) { if (wr == 0) PG8_BAR; }
    PG8_BAR;
    if constexpr (Epi::AFTER_DRAIN) { E.fused(acc, cur, wr, wc, fr, fq, lds, wid, lane); S.done(cur); }
#undef PG8_SA
#undef PG8_SB
#undef PG8_STAGE
#undef PG8_LDA
#undef PG8_LDB
#undef PG8_MMA
#undef PG8_WAIT_V
#undef PG8_WAIT_L
#undef PG8_BAR
#undef PG8_SCHED
}
}
namespace att {
using bf16 = unsigned short;
using bf16x8 = __attribute__((ext_vector_type(8))) short;
using s16x4  = __attribute__((ext_vector_type(4))) short;
using f32x16 = __attribute__((ext_vector_type(16))) float;
using f32x4v = __attribute__((ext_vector_type(4))) float;
using u32x4  = __attribute__((ext_vector_type(4))) unsigned;
using u32x2  = __attribute__((ext_vector_type(2))) unsigned;
#define ALAS __attribute__((address_space(3)))
#define SBAR() __builtin_amdgcn_sched_barrier(0)
constexpr float LOG2E = 1.4426950408889634f;
constexpr float THR2 = 10.0f;
__device__ __forceinline__ int crow(int r, int hi) { return (r & 3) + 8 * (r >> 2) + 4 * hi; }
__device__ __forceinline__ unsigned cvtpk(float lo, float hi) { unsigned r; asm volatile("v_cvt_pk_bf16_f32 %0, %1, %2" : "=v"(r) : "v"(lo), "v"(hi)); return r; }
__device__ __forceinline__ float bf2f(unsigned short h) { return __uint_as_float((unsigned)h << 16); }
template <int HD> __device__ __forceinline__ int kswz(int row, int colB) {
    if constexpr (HD == 128) return row * 256 + (colB ^ ((row & 15) << 4));
    else return row * 128 + (colB ^ (((row >> 1) & 7) << 4));
}
template <int HD> __device__ __forceinline__ void qkt(f32x16& p0, f32x16& p1, const ALAS char* Ks, const bf16x8* qr, int r32, int hi) {
    p0 = f32x16{}; p1 = f32x16{};
#pragma unroll
    for (int d0 = 0; d0 < HD / 16; ++d0) { const int cb = (d0 * 16 + hi * 8) * 2;
        const bf16x8 b0 = *(const ALAS bf16x8*)(Ks + kswz<HD>(r32, cb));
        const bf16x8 b1 = *(const ALAS bf16x8*)(Ks + kswz<HD>(32 + r32, cb));
        p0 = __builtin_amdgcn_mfma_f32_32x32x16_bf16(b0, qr[d0], p0, 0, 0, 0);
        p1 = __builtin_amdgcn_mfma_f32_32x32x16_bf16(b1, qr[d0], p1, 0, 0, 0); }
}
template <int NCB> __device__ __forceinline__ int v_st(int k, int c) { const int kk = (k & ~0xC) | ((k & 4) << 1) | ((k & 8) >> 1); return ((kk >> 3) * NCB + (c >> 5)) * 512 + ((kk & 7) * 32 + (c & 31)) * 2; }
__device__ __forceinline__ int v_rd_base(int lane) { return ((lane & 3) << 3) | (((lane >> 2) & 3) << 6) | (((lane >> 4) & 1) << 5) | (((lane >> 5) & 1) << 8); }
template <int NCB> constexpr int v_rd_off(int d0, int ks, int half) { return d0 * 512 + ks * (NCB * 1024) + half * (NCB * 512); }
template <int OFF> __device__ __forceinline__ s16x4 tr_read(int vb) { s16x4 r; asm volatile("ds_read_b64_tr_b16 %0, %1 offset:%2" : "=&v"(r) : "v"(vb), "i"(OFF) : "memory"); return r; }
template <int NCB, int D0> __device__ __forceinline__ void pv_one(f32x16& od, int vb, bf16x8 pa0, bf16x8 pa1, bf16x8 pa2, bf16x8 pa3) {
    const s16x4 l0 = tr_read<v_rd_off<NCB>(D0, 0, 0)>(vb), h0 = tr_read<v_rd_off<NCB>(D0, 0, 1)>(vb), l1 = tr_read<v_rd_off<NCB>(D0, 1, 0)>(vb), h1 = tr_read<v_rd_off<NCB>(D0, 1, 1)>(vb);
    const s16x4 l2 = tr_read<v_rd_off<NCB>(D0, 2, 0)>(vb), h2 = tr_read<v_rd_off<NCB>(D0, 2, 1)>(vb), l3 = tr_read<v_rd_off<NCB>(D0, 3, 0)>(vb), h3 = tr_read<v_rd_off<NCB>(D0, 3, 1)>(vb);
    asm volatile("s_waitcnt lgkmcnt(0)" ::: "memory"); SBAR();
#define PK(L, H) (bf16x8){L[0], L[1], L[2], L[3], H[0], H[1], H[2], H[3]}
    od = __builtin_amdgcn_mfma_f32_32x32x16_bf16(pa0, PK(l0, h0), od, 0, 0, 0);
    od = __builtin_amdgcn_mfma_f32_32x32x16_bf16(pa1, PK(l1, h1), od, 0, 0, 0);
    od = __builtin_amdgcn_mfma_f32_32x32x16_bf16(pa2, PK(l2, h2), od, 0, 0, 0);
    od = __builtin_amdgcn_mfma_f32_32x32x16_bf16(pa3, PK(l3, h3), od, 0, 0, 0);
#undef PK
}
__device__ __forceinline__ void softmax_tile(f32x16& p0, f32x16& p1, float& m_reg, float& l_reg, float& alpha, bf16x8& pa0, bf16x8& pa1, bf16x8& pa2, bf16x8& pa3) {
    float pmax = p0[0];
#pragma unroll
    for (int r = 1; r < 16; ++r) pmax = fmaxf(pmax, p0[r]);
#pragma unroll
    for (int r = 0; r < 16; ++r) pmax = fmaxf(pmax, p1[r]);
    { auto rr = __builtin_amdgcn_permlane32_swap(__float_as_uint(pmax), __float_as_uint(pmax), false, false); pmax = fmaxf(__uint_as_float(rr[0]), __uint_as_float(rr[1])); }
    if (__all(pmax - m_reg <= THR2)) { alpha = 1.f; }
    else { const float mn = fmaxf(m_reg, pmax); alpha = __builtin_amdgcn_exp2f(m_reg - mn); m_reg = mn; }
    float ps = 0.f;
#pragma unroll
    for (int r = 0; r < 16; ++r) { p0[r] = __builtin_amdgcn_exp2f(p0[r] - m_reg); p1[r] = __builtin_amdgcn_exp2f(p1[r] - m_reg); }
#pragma unroll
    for (int r = 0; r < 16; ++r) ps += p0[r];
#pragma unroll
    for (int r = 0; r < 16; ++r) ps += p1[r];
    { auto rr = __builtin_amdgcn_permlane32_swap(__float_as_uint(ps), __float_as_uint(ps), false, false); ps = __uint_as_float(rr[0]) + __uint_as_float(rr[1]); }
    l_reg = l_reg * alpha + ps;
#define PK4(P, BASE, OUT) do { unsigned a0 = cvtpk(P[BASE + 0], P[BASE + 1]), a1 = cvtpk(P[BASE + 2], P[BASE + 3]);   \
    unsigned b0 = cvtpk(P[BASE + 4], P[BASE + 5]), b1 = cvtpk(P[BASE + 6], P[BASE + 7]);                              \
    auto r0 = __builtin_amdgcn_permlane32_swap(a0, b0, false, false); auto r1 = __builtin_amdgcn_permlane32_swap(a1, b1, false, false); \
    u32x4 w = {r0[0], r1[0], r0[1], r1[1]}; OUT = __builtin_bit_cast(bf16x8, w); } while (0)
    PK4(p0, 0, pa0); PK4(p0, 8, pa1); PK4(p1, 0, pa2); PK4(p1, 8, pa3);
#undef PK4
}
template <int NB> __device__ __forceinline__ void rescale_o(f32x16* o, float alpha, ALAS float* al_l, int r32, int hi) {
    if (__any(alpha < 1.f && alpha > 0.f)) {
        if (hi == 0) al_l[r32] = alpha;
        asm volatile("s_waitcnt lgkmcnt(0)" ::: "memory");
#pragma unroll
        for (int r = 0; r < 16; ++r) { const float a = al_l[crow(r, hi)];
#pragma unroll
            for (int d = 0; d < NB; ++d) o[d][r] *= a; }
        asm volatile("s_waitcnt lgkmcnt(0)" ::: "memory");
    }
}
template <int NB> __device__ __forceinline__ void store_o(const f32x16* o, float l_tot, ALAS float* li_l, ALAS char* stg, bf16* Ow, int lane, int r32, int hi) {
    if (hi == 0) li_l[r32] = l_tot;
    asm volatile("s_waitcnt lgkmcnt(0)" ::: "memory");
#pragma unroll
    for (int r = 0; r < 16; ++r) { const int orow = crow(r, hi); const float rl = __builtin_amdgcn_rcpf(li_l[orow]);
#pragma unroll
        for (int d0 = 0; d0 < NB; ++d0) { const unsigned w = cvtpk(o[d0][r] * rl, 0.f); *(ALAS unsigned short*)(stg + orow * (64 * NB) + (d0 * 32 + r32) * 2) = (unsigned short)(w & 0xffffu); } }
    asm volatile("s_waitcnt lgkmcnt(0)" ::: "memory");
    constexpr int CPR = 4 * NB, RPI = 64 / CPR;
#pragma unroll
    for (int i = 0; i < 32 / RPI; ++i) { const int row = i * RPI + lane / CPR, ch = lane % CPR;
        const u32x4 v = *(const ALAS u32x4*)(stg + row * (64 * NB) + ch * 16); *(u32x4*)(Ow + (size_t)row * 2048 + ch * 8) = v; }
    asm volatile("s_waitcnt lgkmcnt(0)" ::: "memory");
}

constexpr int ATTA_LDS = 98304 + 2048 + 1040;
__device__ __forceinline__ void attnA_unit(const int tid, int b, int h, int qb, const bf16* Qb, const bf16* Kb, const bf16* Vb, bf16* Ob, const float* tabsrc, ALAS char* lds) {
    constexpr int HD = 128, LD = 2048, TB = 16384;
    const int lane = tid & 63, r32 = lane & 31, hi = lane >> 5; const int wid = __builtin_amdgcn_readfirstlane(tid >> 6);
    ALAS char* V_lds = lds; ALAS char* K_lds = lds + 3 * TB;
    ALAS float* wsf = (ALAS float*)(lds + 6 * TB) + wid * 64; ALAS float* tab = (ALAS float*)(lds + 6 * TB + 2048);
    if (tid < 257) tab[tid] = tabsrc[tid] * LOG2E;
    const int c0 = qb * 4, co = wid >> 1, c = c0 + co, rh = wid & 1;
    const size_t rowbase = (size_t)b * 8192;
    const bf16* Qw = Qb + (rowbase + c * 64 + rh * 32 + r32) * LD + h * HD + hi * 8;
    bf16x8 qr[8];
#pragma unroll
    for (int d0 = 0; d0 < 8; ++d0) qr[d0] = *(const bf16x8*)(Qw + d0 * 16);
    const int kc_lo = c0 - 8 > 0 ? c0 - 8 : 0, NT = c0 + 3 - kc_lo + 1;
    const int my_lo = c - 8 > 0 ? c - 8 : 0, my_hi = c;
    const int krow = 4 * wid + (lane >> 4), kchunk = (lane & 15) ^ (krow & 15);
    const int vkk = (wid >> 1) * 8 + ((lane & 31) >> 2), vkey = (vkk & ~0xC) | ((vkk & 4) << 1) | ((vkk & 8) >> 1), vcol = (2 * (wid & 1) + (lane >> 5)) * 32 + (lane & 3) * 8;
    const bf16* Kh = Kb + rowbase * LD + h * HD + (size_t)krow * LD + kchunk * 8; const bf16* Vh = Vb + rowbase * LD + h * HD + (size_t)vkey * LD + vcol;
    const int vb0 = (int)(unsigned)(uintptr_t)V_lds + v_rd_base(lane);
#define SDMA(kc, bf) do { const size_t o_ = (size_t)(kc) * 64 * LD; \
        __builtin_amdgcn_global_load_lds((const unsigned*)(Kh + o_), (ALAS unsigned*)(K_lds + (bf) * TB + wid * 1024), 16, 0, 0); \
        __builtin_amdgcn_global_load_lds((const unsigned*)(Kh + o_ + 32 * LD), (ALAS unsigned*)(K_lds + (bf) * TB + (wid + 8) * 1024), 16, 0, 0); \
        __builtin_amdgcn_global_load_lds((const unsigned*)(Vh + o_), (ALAS unsigned*)(V_lds + (bf) * TB + wid * 1024), 16, 0, 0); \
        __builtin_amdgcn_global_load_lds((const unsigned*)(Vh + o_ + 32 * LD), (ALAS unsigned*)(V_lds + (bf) * TB + (wid + 8) * 1024), 16, 0, 0); } while (0)
    float m_reg = -1e30f, l_reg = 0.f; f32x16 o[4] = {f32x16{}, f32x16{}, f32x16{}, f32x16{}};
    const int qloc = rh * 32 + r32;
    SDMA(kc_lo, 0); if (NT > 1) { SDMA(kc_lo + 1, 1); asm volatile("s_waitcnt vmcnt(4)" ::: "memory"); } else { asm volatile("s_waitcnt vmcnt(0)" ::: "memory"); }
    __syncthreads();
    int cur = 0;
    for (int t = 0; t < NT; ++t) {
        const int kc = kc_lo + t; const int nx2 = cur == 0 ? 2 : cur - 1;
        if (t + 2 < NT) SDMA(kc + 2, nx2);
        if (kc >= my_lo && kc <= my_hi) {
            f32x16 p0, p1; qkt<HD>(p0, p1, K_lds + cur * TB, qr, r32, hi);
            const int dc = kc - c;
            if (dc <= -3) { const float bb = tab[0];
#pragma unroll
                for (int r = 0; r < 16; ++r) { p0[r] += bb; p1[r] += bb; } }
            else { const int base = (dc + 2) * 64 - qloc + 4 * hi;
#pragma unroll
                for (int r = 0; r < 16; ++r) { const int i0 = base + (r & 3) + 8 * (r >> 2), i1 = i0 + 32; p0[r] += tab[i0 > 0 ? i0 : 0]; p1[r] += tab[i1 > 0 ? i1 : 0]; } }
            float alpha; bf16x8 pa0, pa1, pa2, pa3;
            softmax_tile(p0, p1, m_reg, l_reg, alpha, pa0, pa1, pa2, pa3);
            rescale_o<4>(o, alpha, wsf, r32, hi);
            const int vb = vb0 + cur * TB;
            pv_one<4, 0>(o[0], vb, pa0, pa1, pa2, pa3); pv_one<4, 1>(o[1], vb, pa0, pa1, pa2, pa3); pv_one<4, 2>(o[2], vb, pa0, pa1, pa2, pa3); pv_one<4, 3>(o[3], vb, pa0, pa1, pa2, pa3);
        }
        if (t + 2 < NT) { asm volatile("s_waitcnt vmcnt(4)" ::: "memory"); } else { asm volatile("s_waitcnt vmcnt(0)" ::: "memory"); }
        __syncthreads();
        cur = cur == 2 ? 0 : cur + 1;
    }
#undef SDMA
    store_o<4>(o, l_reg, wsf, lds + wid * 8192, Ob + (rowbase + c * 64 + rh * 32) * LD + h * HD, lane, r32, hi);
    asm volatile("s_waitcnt lgkmcnt(0)" ::: "memory");
    __builtin_amdgcn_s_barrier();
    asm volatile("" ::: "memory");
}

constexpr int ATTB_RC = 16, ATTB_LDS = 65536 + 2048 + 32768;
__device__ __forceinline__ void attnB_unit(const int tid, int b, int kvh, int run, const bf16* Qb, const bf16* Kb, const bf16* Vb, bf16* Ob, const float* sinks, ALAS char* lds) {
    constexpr int HD = 64, LDQ = 2048, LDK = 512, TB = 8192;
    const int lane = tid & 63, r32 = lane & 31, hi = lane >> 5; const int wid = __builtin_amdgcn_readfirstlane(tid >> 6);
    ALAS char* K_lds = lds; ALAS char* V_lds = lds + 4 * TB; ALAS float* wsf = (ALAS float*)(lds + 8 * TB) + wid * 64;
    const int qh = kvh * 4 + (wid >> 1), rh = wid & 1;
    const float slope2 = __builtin_amdgcn_exp2f(-0.25f * (float)(qh + 1)) * LOG2E, sink2 = sinks[qh] * LOG2E;
    const size_t rowbase = (size_t)b * 8192;
    const int krow = 8 * wid + (lane >> 3), kchunk = (lane & 7) ^ ((krow >> 1) & 7);
    const int vkk = wid * 8 + ((lane & 31) >> 2), vkey = (vkk & ~0xC) | ((vkk & 4) << 1) | ((vkk & 8) >> 1), vcol = (lane >> 5) * 32 + (lane & 3) * 8;
    const bf16* Kh = Kb + (rowbase + krow) * LDK + kvh * HD + kchunk * 8; const bf16* Vh = Vb + (rowbase + vkey) * LDK + kvh * HD + vcol;
    const int vb0 = (int)(unsigned)(uintptr_t)V_lds + v_rd_base(lane);
    const int c_first = run * ATTB_RC, c_last = c_first + ATTB_RC - 1;
#define SDMA(kc) do { __builtin_amdgcn_global_load_lds((const unsigned*)(Kh + (size_t)(kc) * 64 * LDK), (ALAS unsigned*)(K_lds + ((kc) & 3) * TB + wid * 1024), 16, 0, 0); \
        __builtin_amdgcn_global_load_lds((const unsigned*)(Vh + (size_t)(kc) * 64 * LDK), (ALAS unsigned*)(V_lds + ((kc) & 3) * TB + wid * 1024), 16, 0, 0); } while (0)
    for (int kc = (c_first - 2 > 0 ? c_first - 2 : 0); kc <= c_first; ++kc) SDMA(kc);
    const bf16* Qw = Qb + (rowbase + rh * 32 + r32) * LDQ + qh * HD + hi * 8;
    bf16x8 qr[4], qn[4];
#pragma unroll
    for (int d0 = 0; d0 < 4; ++d0) qr[d0] = *(const bf16x8*)(Qw + (size_t)c_first * 64 * LDQ + d0 * 16);
    asm volatile("s_waitcnt vmcnt(0)" ::: "memory"); __syncthreads();
    const int qloc = rh * 32 + r32;
    for (int c = c_first; c <= c_last; ++c) {
        const bool more = c < c_last;
        if (more) { SDMA(c + 1);
#pragma unroll
            for (int d0 = 0; d0 < 4; ++d0) qn[d0] = *(const bf16x8*)(Qw + (size_t)(c + 1) * 64 * LDQ + d0 * 16); }
        float m_reg = -1e30f, l_reg = 0.f; f32x16 o[2] = {f32x16{}, f32x16{}};
        for (int kc = (c - 2 > 0 ? c - 2 : 0); kc <= c; ++kc) {
            const int slot = kc & 3;
            f32x16 p0, p1; qkt<HD>(p0, p1, K_lds + slot * TB, qr, r32, hi);
            const int base = (kc - c) * 64 - qloc + 4 * hi;
#pragma unroll
            for (int r = 0; r < 16; ++r) { const int i0 = base + (r & 3) + 8 * (r >> 2); p0[r] -= slope2 * fabsf((float)i0); p1[r] -= slope2 * fabsf((float)(i0 + 32)); }
            float alpha; bf16x8 pa0, pa1, pa2, pa3;
            softmax_tile(p0, p1, m_reg, l_reg, alpha, pa0, pa1, pa2, pa3);
            rescale_o<2>(o, alpha, wsf, r32, hi);
            const int vb = vb0 + slot * TB;
            pv_one<2, 0>(o[0], vb, pa0, pa1, pa2, pa3); pv_one<2, 1>(o[1], vb, pa0, pa1, pa2, pa3);
        }
        if (more) {
#pragma unroll
            for (int d0 = 0; d0 < 4; ++d0) qr[d0] = qn[d0]; }
        const float l_tot = l_reg + __builtin_amdgcn_exp2f(sink2 - m_reg);
        store_o<2>(o, l_tot, wsf, lds + 8 * TB + 2048 + wid * 4096, Ob + (rowbase + (size_t)c * 64 + rh * 32) * LDQ + qh * HD, lane, r32, hi);
        asm volatile("s_waitcnt vmcnt(4) lgkmcnt(0)" ::: "memory");
        __builtin_amdgcn_s_barrier();
        asm volatile("" ::: "memory");
    }
#undef SDMA
}

template <int HD, int CL, bool ISA>
__device__ __forceinline__ void sample_attn_unit(const int tid, int sb, int qh, const bf16* Qb, const bf16* Kb, const bf16* Vb, bf16* Ob, const float* cache_k, const float* cache_v, const float* aux, ALAS char* lds) {
    constexpr int NK = CL + 16, NKP = NK + 1, KVW = ISA ? 2048 : 512, PAST = 1024;
    const int lane = tid & 63; const int wid = __builtin_amdgcn_readfirstlane(tid >> 6);
    const int kvh = ISA ? qh : (qh >> 2);
    ALAS float* qs = (ALAS float*)lds; ALAS float* S = qs + 16 * HD; ALAS float* inv = S + 16 * NKP;
    const size_t row0 = 32768 + (size_t)sb * 16;
    for (int i = tid; i < 16 * HD; i += 512) { const int j = i / HD, d = i % HD; qs[i] = bf2f(Qb[(row0 + j) * 2048 + qh * HD + d]); }
    __syncthreads();
    const float slope2 = __builtin_amdgcn_exp2f(-0.25f * (float)(qh + 1)) * LOG2E;
    for (int k = tid; k < NK; k += 512) {
        float acc[16];
#pragma unroll
        for (int j = 0; j < 16; ++j) acc[j] = 0.f;
        if (k < CL) { const float* kp = cache_k + ((size_t)sb * CL + k) * KVW + kvh * HD;
#pragma unroll 8
            for (int d4 = 0; d4 < HD / 4; ++d4) { const f32x4v kv = *(const f32x4v*)(kp + d4 * 4);
#pragma unroll
                for (int j = 0; j < 16; ++j) { const f32x4v q4 = *(const ALAS f32x4v*)(qs + j * HD + d4 * 4); acc[j] += (kv[0] * q4[0] + kv[1] * q4[1]) + (kv[2] * q4[2] + kv[3] * q4[3]); } } }
        else { const bf16* kp = Kb + (row0 + (k - CL)) * KVW + kvh * HD;
#pragma unroll 2
            for (int d4 = 0; d4 < HD / 4; ++d4) { const u32x2 kw = *(const u32x2*)(kp + d4 * 4);
                const float k0 = __uint_as_float(kw[0] << 16), k1 = __uint_as_float(kw[0] & 0xffff0000u), k2 = __uint_as_float(kw[1] << 16), k3 = __uint_as_float(kw[1] & 0xffff0000u);
#pragma unroll
                for (int j = 0; j < 16; ++j) { const f32x4v q4 = *(const ALAS f32x4v*)(qs + j * HD + d4 * 4); acc[j] += (k0 * q4[0] + k1 * q4[1]) + (k2 * q4[2] + k3 * q4[3]); } } }
        const int kpos = k < CL ? PAST - CL + k : PAST + (k - CL);
#pragma unroll
        for (int j = 0; j < 16; ++j) { const int rel = kpos - (PAST + j); float bias;
            if constexpr (ISA) { int idx = rel < -128 ? -128 : (rel > 128 ? 128 : rel); bias = aux[idx + 128] * LOG2E; } else { bias = -slope2 * fabsf((float)rel); }
            S[j * NKP + k] = acc[j] + bias; }
    }
    __syncthreads();
#pragma unroll
    for (int jj = 0; jj < 2; ++jj) { const int j = 2 * wid + jj;
        float m = -1e30f; for (int k = lane; k < NK; k += 64) m = fmaxf(m, S[j * NKP + k]);
        m = xl_wave_max(m);
        float s = 0.f; for (int k = lane; k < NK; k += 64) { const float e = __builtin_amdgcn_exp2f(S[j * NKP + k] - m); S[j * NKP + k] = e; s += e; }
        s = xl_wave_sum(s);
        if constexpr (!ISA) s += __builtin_amdgcn_exp2f(aux[qh] * LOG2E - m);
        if (lane == 0) inv[j] = 1.0f / s; }
    __syncthreads();
    constexpr int TPR = HD / 4, RG = 64 / TPR, RPL = 16 / RG, KPW = (NK + 7) / 8;
    ALAS float* red = (ALAS float*)(lds + 49152);
    { const int d4 = (lane & (TPR - 1)) * 4, rg = lane / TPR; f32x4v acc[RPL];
#pragma unroll
        for (int r = 0; r < RPL; ++r) acc[r] = (f32x4v){0.f, 0.f, 0.f, 0.f};
        const int k0 = wid * KPW, k1 = (k0 + KPW < NK) ? k0 + KPW : NK;
        const float* vp = cache_v + (size_t)sb * CL * KVW + kvh * HD + d4; const bf16* vn = Vb + row0 * KVW + kvh * HD + d4;
        const ALAS float* Sp = S + (rg * RPL) * NKP;
#pragma unroll 6
        for (int k = k0; k < k1; ++k) { f32x4v v4;
            if (k < CL) v4 = *(const f32x4v*)(vp + (size_t)k * KVW);
            else { const u32x2 vw = *(const u32x2*)(vn + (size_t)(k - CL) * KVW); v4 = (f32x4v){__uint_as_float(vw[0] << 16), __uint_as_float(vw[0] & 0xffff0000u), __uint_as_float(vw[1] << 16), __uint_as_float(vw[1] & 0xffff0000u)}; }
#pragma unroll
            for (int r = 0; r < RPL; ++r) acc[r] = acc[r] + v4 * Sp[r * NKP + k]; }
#pragma unroll
        for (int r = 0; r < RPL; ++r) *(ALAS f32x4v*)(red + (wid * 16 + rg * RPL + r) * HD + d4) = acc[r]; }
    __syncthreads();
    if (tid < 16 * TPR) { const int j = tid / TPR, d4 = (tid % TPR) * 4; f32x4v o = {0.f, 0.f, 0.f, 0.f};
#pragma unroll
        for (int w = 0; w < 8; ++w) o = o + *(const ALAS f32x4v*)(red + (w * 16 + j) * HD + d4);
        const float il = inv[j]; u32x2 w; w[0] = cvtpk(o[0] * il, o[1] * il); w[1] = cvtpk(o[2] * il, o[3] * il);
        *(u32x2*)(Ob + samp_toff(sb * 16 + j, qh * HD + d4)) = w; }
    __syncthreads();
}
#undef SBAR
#undef ALAS
}
namespace mini {
typedef unsigned short bf16_t;
typedef short bf16x8 __attribute__((ext_vector_type(8)));
typedef float f32x4 __attribute__((ext_vector_type(4)));
typedef unsigned u32x4 __attribute__((ext_vector_type(4)));
#define MLAS __attribute__((address_space(3)))
constexpr int SROW0 = 32768;
constexpr size_t WS_SSS_ = ((size_t)499 << 20) + (512 << 10), WS_Q_ = (size_t)500 << 20, WS_K_ = (size_t)629 << 20, WS_V_ = (size_t)758 << 20;
constexpr size_t WS_XBS_ = (size_t)1016 << 20, WS_OS_ = WS_XBS_ + (512 << 10), WS_HS_ = (size_t)1017 << 20;
__host__ __device__ __forceinline__ size_t toff(int r, int c) { return samp_toff(r, c); }
__device__ __forceinline__ unsigned cvt_pk_bf16(float lo, float hi) { unsigned r; asm volatile("v_cvt_pk_bf16_f32 %0, %1, %2" : "=v"(r) : "v"(lo), "v"(hi)); return r; }
__device__ __forceinline__ float bf_lo(unsigned w) { return __builtin_bit_cast(float, w << 16); }
__device__ __forceinline__ float bf_hi(unsigned w) { return __builtin_bit_cast(float, w & 0xffff0000u); }
__device__ __forceinline__ float srow_rstd(const unsigned char* ws, int sel, int r) {
    const f32x4* p = (const f32x4*)(ws + WS_SSS_) + (size_t)(sel * 128 + r) * 32; float s = 0.f;
#pragma unroll
    for (int q = 0; q < 32; ++q) { const f32x4 t = p[q]; s += (t[0] + t[1]) + (t[2] + t[3]); }
    return __builtin_amdgcn_rsqf(s * (1.0f / 2048.0f) + 1e-6f);
}
template <bool ISB> struct EpiQKV {
    unsigned char* ws; float* out; int pr;
    __device__ __forceinline__ void operator()(int r, int col, const float (&v)[8]) const {
        constexpr int nkv = ISB ? 512 : 2048, CL = ISB ? 128 : 512;
        constexpr float qscale = (ISB ? 0.125f : 0.08838834764831845f) * 1.4426950408889634f;
        constexpr size_t OKS = ISB ? 118751232 : 85196800, OVS = ISB ? 119799808 : 101974016;
        const int region = col < 2048 ? 0 : (col < 2048 + nkv ? 1 : 2);
        const float rs = srow_rstd(ws, 0, r) * (region == 0 ? qscale : 1.0f);
        const int c = region == 0 ? col : (region == 1 ? col - 2048 : col - 2048 - nkv), ld = region == 0 ? 2048 : nkv;
        bf16_t* const ob = (bf16_t*)(ws + (region == 0 ? WS_Q_ : (region == 1 ? WS_K_ : WS_V_)));
        float x[8];
#pragma unroll
        for (int e = 0; e < 8; ++e) x[e] = v[e] * rs;
        u32x4 w; w.x = cvt_pk_bf16(x[0], x[1]); w.y = cvt_pk_bf16(x[2], x[3]); w.z = cvt_pk_bf16(x[4], x[5]); w.w = cvt_pk_bf16(x[6], x[7]);
        *(u32x4*)(ob + (size_t)(SROW0 + r) * ld + c) = w;
        if (region != 0) { float* d = out + (region == 1 ? OKS : OVS) + (size_t)pr * 8 * CL * nkv + (size_t)((r >> 4) * CL + (CL - 16 + (r & 15))) * nkv + c;
            *(f32x4*)d = (f32x4){x[0], x[1], x[2], x[3]}; *(f32x4*)(d + 4) = (f32x4){x[4], x[5], x[6], x[7]}; }
    }
};
struct EpiRes {
    unsigned char* ws; int sssel;
    __device__ __forceinline__ void operator()(int r, int col, const float (&v)[8]) const {
        u32x4* const px = (u32x4*)((bf16_t*)(ws + WS_XBS_) + toff(r, col)); const u32x4 xo = *px;
        u32x4 w; w.x = cvt_pk_bf16(bf_lo(xo.x) + v[0], bf_hi(xo.x) + v[1]); w.y = cvt_pk_bf16(bf_lo(xo.y) + v[2], bf_hi(xo.y) + v[3]);
        w.z = cvt_pk_bf16(bf_lo(xo.z) + v[4], bf_hi(xo.z) + v[5]); w.w = cvt_pk_bf16(bf_lo(xo.w) + v[6], bf_hi(xo.w) + v[7]);
        *px = w;
        const float r0 = bf_lo(w.x), r1 = bf_hi(w.x), r2 = bf_lo(w.y), r3 = bf_hi(w.y), r4 = bf_lo(w.z), r5 = bf_hi(w.z), r6 = bf_lo(w.w), r7 = bf_hi(w.w);
        float ssq = ((r0 * r0 + r1 * r1) + (r2 * r2 + r3 * r3)) + ((r4 * r4 + r5 * r5) + (r6 * r6 + r7 * r7));
        ssq += xl_swz<1>(ssq);
        if ((col & 15) == 0) ((float*)(ws + WS_SSS_))[(size_t)(sssel * 128 + r) * 128 + (col >> 4)] = ssq;
    }
};
struct EpiUp {
    unsigned char* ws;
    __device__ __forceinline__ void operator()(int r, int col, const float (&v)[8]) const {
        const float rs = srow_rstd(ws, 1, r); float x[8];
#pragma unroll
        for (int e = 0; e < 8; ++e) { const float a = fmaxf(v[e] * rs, 0.f); x[e] = a * a; }
        u32x4 w; w.x = cvt_pk_bf16(x[0], x[1]); w.y = cvt_pk_bf16(x[2], x[3]); w.z = cvt_pk_bf16(x[4], x[5]); w.w = cvt_pk_bf16(x[6], x[7]);
        *(u32x4*)((bf16_t*)(ws + WS_HS_) + toff(r, col)) = w;
    }
};
template <class Epi, int NT, int DEPTH>
__device__ __forceinline__ void task(const int tid, const bf16_t* A, const bf16_t* Bt, const int K, const int c0, MLAS float* red, const Epi& E) {
    const int lane = tid & 63, i = lane & 15, kq = lane >> 4; const int wid = __builtin_amdgcn_readfirstlane(tid >> 6);
    const int ks = K >> 3, nsteps = ks >> 5;
    const bf16_t* ap = A + (size_t)(wid * nsteps) * 8 * 512 + lane * 8;
    const bf16_t* bp = Bt + (size_t)(c0 + i) * K + wid * ks + 8 * kq;
    f32x4 acc[8][NT];
#pragma unroll
    for (int m = 0; m < 8; ++m)
#pragma unroll
        for (int n = 0; n < NT; ++n) acc[m][n] = (f32x4){0.f, 0.f, 0.f, 0.f};
    bf16x8 af[DEPTH][8], bfr[DEPTH][NT];
#define MLOAD(d, s) do { _Pragma("unroll") for (int m = 0; m < 8; ++m) af[d][m] = *(const bf16x8*)(ap + (size_t)((s) * 8 + m) * 512); \
        _Pragma("unroll") for (int n = 0; n < NT; ++n) bfr[d][n] = *(const bf16x8*)(bp + (size_t)(16 * n) * K + 32 * (s)); } while (0)
#define MMMA(d) do { _Pragma("unroll") for (int m = 0; m < 8; ++m) _Pragma("unroll") for (int n = 0; n < NT; ++n) acc[m][n] = __builtin_amdgcn_mfma_f32_16x16x32_bf16(af[d][m], bfr[d][n], acc[m][n], 0, 0, 0); } while (0)
#pragma unroll
    for (int d = 0; d < DEPTH - 1; ++d) MLOAD(d, d);
    __builtin_amdgcn_sched_barrier(0);
    for (int s = 0; s < nsteps; s += DEPTH) {
#pragma unroll
        for (int d = 0; d < DEPTH; ++d) {
            if (s + d + DEPTH - 1 < nsteps) MLOAD((d + DEPTH - 1) % DEPTH, s + d + DEPTH - 1);
            __builtin_amdgcn_sched_barrier(0);
            MMMA(d);
            __builtin_amdgcn_sched_barrier(0);
        }
    }
#undef MLOAD
#undef MMMA
    constexpr int NC = 16 * NT, CG = 2 * NT;
    MLAS float* mine = red + wid * (128 * NC);
#pragma unroll
    for (int m = 0; m < 8; ++m)
#pragma unroll
        for (int n = 0; n < NT; ++n)
#pragma unroll
            for (int r = 0; r < 4; ++r) mine[(16 * m + 4 * kq + r) * NC + 16 * n + i] = acc[m][n][r];
    __syncthreads();
    if (tid < 128 * CG) { const int row = tid / CG, cg = tid % CG; float v[8];
#pragma unroll
        for (int e = 0; e < 8; ++e) v[e] = 0.f;
#pragma unroll
        for (int w = 0; w < 8; ++w) { const f32x4 p = *(const MLAS f32x4*)(red + w * (128 * NC) + row * NC + 8 * cg), q = *(const MLAS f32x4*)(red + w * (128 * NC) + row * NC + 8 * cg + 4);
            v[0] += p[0]; v[1] += p[1]; v[2] += p[2]; v[3] += p[3]; v[4] += q[0]; v[5] += q[1]; v[6] += q[2]; v[7] += q[3]; }
        E(row, c0 + 8 * cg, v); }
    __syncthreads();
}
#undef MLAS
}
constexpr int NWAVES = 8;
#ifndef MK_ONE_LAUNCH
#define MK_ONE_LAUNCH 1
#endif
constexpr int DM = 2048, FF = 8192, SEQ = 8192, NBATCH = 4, MP = NBATCH * SEQ, MS = 128, MR = MP + MS, MPAD = 33024;
constexpr int NPH = 22;
constexpr size_t MiB = 1u << 20;
constexpr size_t WS_CTL = 0, CTL_ZERO_BYTES = 1 * MiB;
constexpr size_t WS_WQA = 1 * MiB, WS_WOA = 49 * MiB, WS_WQB = 65 * MiB, WS_WOB = 89 * MiB, WS_WUP = 105 * MiB, WS_WDN = 233 * MiB;
constexpr size_t WS_XB = 361 * MiB;
constexpr size_t WS_SS0 = 490 * MiB, WS_SS1 = 495 * MiB;
constexpr size_t WS_SSS = 499 * MiB + 512 * 1024;
constexpr size_t WS_ACT = 500 * MiB;
constexpr size_t WS_Q = WS_ACT, WS_K = WS_ACT + 129 * MiB, WS_V = WS_ACT + 258 * MiB, WS_O = WS_ACT + 387 * MiB;
constexpr size_t WS_XBS = 1016 * MiB, WS_OS = WS_XBS + 512 * 1024, WS_HS = 1017 * MiB, WS_END = 1019 * MiB;
static_assert((size_t)MPAD * DM * 2 == 129 * MiB && (size_t)MPAD * FF * 2 == 516 * MiB, "buffer sizes");
constexpr int CW_TMO = 0, CW_BAR = 4096, CW_TKT = 16384, CW_CPY = 20480;
constexpr size_t O_Y = 0, O_AKP = 67371008, O_AVP = 75759616, O_BKP = 84148224, O_BVP = 84672512, O_AKS = 85196800, O_AVS = 101974016, O_BKS = 118751232, O_BVS = 119799808, O_END = 120848384;
constexpr int RING_BYTES = 131072, MISC_OFF = RING_BYTES + 320, LDS_BYTES = 147456;

#define GAS __attribute__((address_space(1)))
#define LAS __attribute__((address_space(3)))
typedef unsigned short bf16;
typedef unsigned v4u __attribute__((ext_vector_type(4)));
typedef unsigned v2u __attribute__((ext_vector_type(2)));
typedef float f32x4 __attribute__((ext_vector_type(4)));
typedef GAS unsigned gu32;
#define RLX_AGENT __ATOMIC_RELAXED, __HIP_MEMORY_SCOPE_AGENT
#define LDS_WAIT() asm volatile("s_waitcnt lgkmcnt(0)" ::: "memory")
#define VM_WAIT() asm volatile("s_waitcnt vmcnt(0)" ::: "memory")
__device__ __forceinline__ unsigned f2bf(float f) { unsigned u = __builtin_bit_cast(unsigned, f); return (u + 0x7fffu + ((u >> 16) & 1u)) >> 16; }
__device__ __forceinline__ unsigned pk2(float lo, float hi) { return f2bf(lo) | (f2bf(hi) << 16); }
#define XB_TMO      128
#define XB_XCNT(j)  (256  + 64 * (j))
#define XB_XSUB(j)  (1280 + 64 * (j))
#define XB_XGEN(j)  (2304 + 64 * (j))
#define XB_TOP      3328
#define XB_TOPGEN   3392
#define XCD_BAR_WORDS 3456
#define XB_SPIN_CAP (1u << 18)

__device__ __forceinline__ unsigned xb_ld(unsigned* p)              { return __hip_atomic_load(p, __ATOMIC_RELAXED, __HIP_MEMORY_SCOPE_AGENT); }
__device__ __forceinline__ unsigned xb_add(unsigned* p, unsigned v) { return __hip_atomic_fetch_add(p, v, __ATOMIC_RELAXED, __HIP_MEMORY_SCOPE_AGENT); }
__device__ __forceinline__ unsigned xb_xcc_id() { return (unsigned)__builtin_amdgcn_s_getreg((3 << 11) | 20) & 0xFu; }
#define XB_SPIN(cond, bar) do { unsigned _sp = 0; while (cond) { __builtin_amdgcn_s_sleep(1); \
    if ((++_sp & 255u) == 0u) { if (xb_ld(&(bar)[XB_TMO])) break; if (_sp > XB_SPIN_CAP) { atomicAdd(&(bar)[XB_TMO], 1u); break; } } } } while (0)

struct XcdBarrier {
    unsigned* bar; unsigned x;
    volatile LAS unsigned* st;
};

__device__ __forceinline__ XcdBarrier xcd_barrier_post(unsigned* bar, volatile LAS unsigned* st) {
    XcdBarrier b; b.bar = bar; b.x = xb_xcc_id(); b.st = st;
    if (threadIdx.x == 0) (void)xb_add(&bar[XB_XCNT(b.x)], 1u);
    return b;
}
__device__ __forceinline__ void xcd_barrier_complete(unsigned* bar, unsigned x, unsigned& nloc, unsigned& nx) {
    const unsigned G = gridDim.x * gridDim.y * gridDim.z;
    unsigned sum, cnt, mine, sp = 0u;
    for (;;) {
        sum = 0u; cnt = 0u; mine = 0u;
#pragma unroll
        for (unsigned j = 0; j < 16; ++j) { const unsigned c = xb_ld(&bar[XB_XCNT(j)]); sum += c; cnt += (c > 0u) ? 1u : 0u; mine = (j == x) ? c : mine; }
        if (sum == G) break;
        __builtin_amdgcn_s_sleep(1);
        if ((++sp & 255u) == 0u) { if (xb_ld(&bar[XB_TMO])) break; if (sp > XB_SPIN_CAP) { atomicAdd(&bar[XB_TMO], 1u); break; } }
    }
    nloc = mine > 0u ? mine : 1u; nx = cnt > 0u ? cnt : 1u;
}

__device__ __forceinline__ void xcd_barrier(const XcdBarrier& b) {
    asm volatile("s_waitcnt vmcnt(0)" ::: "memory");
    __syncthreads();
    if (threadIdx.x == 0) {
        unsigned* bar = b.bar;
        __builtin_amdgcn_s_waitcnt(0);
        unsigned nloc = b.st[0], nx = b.st[1];
        if (nloc == 0u) { xcd_barrier_complete(bar, b.x, nloc, nx); b.st[0] = nloc; b.st[1] = nx; }
        const unsigned old = xb_add(&bar[XB_XSUB(b.x)], 1u);
        const unsigned gen = old / nloc;
        if (old + 1u == (gen + 1u) * nloc) {
            __builtin_amdgcn_fence(__ATOMIC_RELEASE, "agent");
            asm volatile("s_waitcnt vmcnt(0)" ::: "memory");
            const unsigned og = xb_add(&bar[XB_TOP], 1u);
            const unsigned tg = og / nx;
            if (og + 1u == (tg + 1u) * nx) xb_add(&bar[XB_TOPGEN], 1u);
            else XB_SPIN(xb_ld(&bar[XB_TOPGEN]) == tg, bar);
            __builtin_amdgcn_fence(__ATOMIC_ACQUIRE, "agent");
            xb_add(&bar[XB_XGEN(b.x)], 1u);
            asm volatile("s_waitcnt vmcnt(0)" ::: "memory");
        } else {
            XB_SPIN(xb_ld(&bar[XB_XGEN(b.x)]) == gen, bar);
            __builtin_amdgcn_fence(__ATOMIC_ACQUIRE, "agent");
            asm volatile("s_waitcnt vmcnt(0)" ::: "memory");
        }
    }
    __syncthreads();
}
struct Frame {
    LAS unsigned char* lds;
    volatile LAS unsigned* MISC;
};
enum { P_XP = 0, P_XS, P_CAK, P_CAV, P_CBK, P_CBV, P_NMIX, P_NFFN, P_NFIN, P_AWQKV, P_AWO, P_AREL, P_BWQKV, P_BWO, P_BSINK, P_WUP, P_WDN, P_OUT, P_WS, P_COUNT };
typedef const __attribute__((address_space(4))) unsigned long long* karg_t;
#define KARGS() karg_t KA = (karg_t)__builtin_amdgcn_kernarg_segment_ptr(); asm volatile("" : "+s"(KA))
#define FPTR(i) ((const float*)(const GAS float*)KA[(i)])
#define OUTP() ((float*)(GAS float*)KA[P_OUT])
#define WSP() ((unsigned char*)(GAS unsigned char*)KA[P_WS])
__device__ __forceinline__ int opaque_lane() { int l; asm volatile("v_mbcnt_lo_u32_b32 %0, -1, 0\n\tv_mbcnt_hi_u32_b32 %0, -1, %0" : "=v"(l)); return l; }
__device__ __forceinline__ float wave_sum(float v) {
    return xl_wave_sum(v);
}
struct WItem { const float* W; const float* gain; bf16* WT; int K, N, r; };
#define P0_LOAD(R, GV, T) do { const int nblk_ = (T).N / 32, k0_ = 64 * ((T).r / nblk_), n0_ = 32 * ((T).r % nblk_); const float* wp_ = (T).W + (size_t)(k0_ + (lane >> 5)) * (T).N + n0_ + (lane & 31); \
        GV = (T).gain ? (T).gain[k0_ + lane] : 1.0f; \
        _Pragma("unroll") for (int i = 0; i < 32; ++i) R[i] = __builtin_nontemporal_load(wp_ + (size_t)(2 * i) * (T).N); } while (0)
#define P0_PROC(R, GV, T) do { const int nblk_ = (T).N / 32, k0_ = 64 * ((T).r / nblk_), n0_ = 32 * ((T).r % nblk_); \
        _Pragma("unroll") for (int i = 0; i < 32; ++i) { const float g0_ = __builtin_bit_cast(float, __builtin_amdgcn_readlane(__builtin_bit_cast(int, GV), 2 * i)), g1_ = __builtin_bit_cast(float, __builtin_amdgcn_readlane(__builtin_bit_cast(int, GV), 2 * i + 1)); \
            scr[(2 * i + (lane >> 5)) * 33 + (lane & 31)] = R[i] * ((lane >> 5) ? g1_ : g0_); } \
        LDS_WAIT(); asm volatile("" ::: "memory"); \
        { const int c_ = lane & 7; _Pragma("unroll") for (int j = 0; j < 4; ++j) { const int n_ = (lane >> 3) + 8 * j; const LAS float* s_ = scr + (8 * c_) * 33 + n_; \
            v4u o_; o_.x = pk2(s_[0 * 33], s_[1 * 33]); o_.y = pk2(s_[2 * 33], s_[3 * 33]); o_.z = pk2(s_[4 * 33], s_[5 * 33]); o_.w = pk2(s_[6 * 33], s_[7 * 33]); \
            *(GAS v4u*)((T).WT + (size_t)(n0_ + n_) * (T).K + k0_ + 8 * c_) = o_; } } \
        LDS_WAIT(); asm volatile("" ::: "memory"); } while (0)
__device__ __forceinline__ WItem witem(karg_t KA, unsigned char* ws, const int kind, const int s, const int r) { WItem t; t.r = r;
    if (kind == 0)      { t.W = FPTR(P_AWQKV) + (size_t)s * 2048 * 6144; t.gain = FPTR(P_NMIX) + (2 * s) * 2048;     t.K = 2048; t.N = 6144; t.WT = (bf16*)(ws + WS_WQA + (size_t)s * 24 * MiB); }
    else if (kind == 1) { t.W = FPTR(P_AWO) + (size_t)s * 2048 * 2048;   t.gain = nullptr;                            t.K = 2048; t.N = 2048; t.WT = (bf16*)(ws + WS_WOA + (size_t)s * 8 * MiB); }
    else if (kind == 2) { t.W = FPTR(P_BWQKV) + (size_t)s * 2048 * 3072; t.gain = FPTR(P_NMIX) + (2 * s + 1) * 2048; t.K = 2048; t.N = 3072; t.WT = (bf16*)(ws + WS_WQB + (size_t)s * 12 * MiB); }
    else if (kind == 3) { t.W = FPTR(P_BWO) + (size_t)s * 2048 * 2048;   t.gain = nullptr;                            t.K = 2048; t.N = 2048; t.WT = (bf16*)(ws + WS_WOB + (size_t)s * 8 * MiB); }
    else if (kind == 4) { t.W = FPTR(P_WUP) + (size_t)s * 2048 * 8192;   t.gain = FPTR(P_NFFN) + s * 2048;            t.K = 2048; t.N = 8192; t.WT = (bf16*)(ws + WS_WUP + (size_t)s * 32 * MiB); }
    else                { t.W = FPTR(P_WDN) + (size_t)s * 8192 * 2048;   t.gain = nullptr;                            t.K = 8192; t.N = 2048; t.WT = (bf16*)(ws + WS_WDN + (size_t)s * 32 * MiB); }
    return t; }
constexpr int I_AQ = 32 * 192, I_O = 32 * 64, I_BQ = 32 * 96, I_UP = 32 * 256, I_DN = 128 * 64;
constexpr int P0_ITEMS = I_AQ + I_O;
__device__ __forceinline__ WItem p0_decode(karg_t KA, unsigned char* ws, const int it) {
    if (it < I_AQ) return witem(KA, ws, 0, 0, it);
    return witem(KA, ws, 1, 0, it - I_AQ); }
constexpr int FW_A0 = I_UP, FW_A1 = FW_A0 + I_DN,
              FW_B0 = FW_A1 + I_BQ, FW_B1 = FW_B0 + I_O, FW_B2 = FW_B1 + I_UP, FW_B3 = FW_B2 + I_DN, FW_B4 = FW_B3 + I_AQ, FW_B5 = FW_B4 + I_O, FW_B6 = FW_B5 + I_UP, FW_B7 = FW_B6 + I_DN,
              FW_B8 = FW_B7 + I_BQ, FW_B9 = FW_B8 + I_O, FW_B10 = FW_B9 + I_UP, FW_B11 = FW_B10 + I_DN;
constexpr int FW_TASK_ITEMS = 16, FW_TASKS = FW_B11 / FW_TASK_ITEMS;
static_assert(FW_B11 % FW_TASK_ITEMS == 0 && FW_B11 + P0_ITEMS == 2 * I_AQ + 4 * I_O + 2 * I_BQ + 4 * I_UP + 4 * I_DN, "deferred weight items");
__device__ __forceinline__ WItem fw_decode(karg_t KA, unsigned char* ws, const int it) {
    if (it < FW_A0) return witem(KA, ws, 4, 0, it);
    if (it < FW_A1) return witem(KA, ws, 5, 0, it - FW_A0);
    if (it < FW_B0) return witem(KA, ws, 2, 0, it - FW_A1);
    if (it < FW_B1) return witem(KA, ws, 3, 0, it - FW_B0);
    if (it < FW_B2) return witem(KA, ws, 4, 1, it - FW_B1);
    if (it < FW_B3) return witem(KA, ws, 5, 1, it - FW_B2);
    if (it < FW_B4) return witem(KA, ws, 0, 1, it - FW_B3);
    if (it < FW_B5) return witem(KA, ws, 1, 1, it - FW_B4);
    if (it < FW_B6) return witem(KA, ws, 4, 2, it - FW_B5);
    if (it < FW_B7) return witem(KA, ws, 5, 2, it - FW_B6);
    if (it < FW_B8) return witem(KA, ws, 2, 1, it - FW_B7);
    if (it < FW_B9) return witem(KA, ws, 3, 1, it - FW_B8);
    if (it < FW_B10) return witem(KA, ws, 4, 3, it - FW_B9);
    return witem(KA, ws, 5, 3, it - FW_B10); }
__device__ __forceinline__ unsigned fill_must(const int pr, const int site) {
    constexpr int T = FW_TASK_ITEMS;
    const int m0 = site <= 2 ? 0 : site == 3 ? FW_A0 / T : site == 4 ? FW_A1 / T : site <= 6 ? FW_B0 / T : site == 7 ? FW_B1 / T : site == 8 ? FW_B2 / T : site == 9 ? FW_B3 / T : FW_B4 / T;
    const int m1 = site <= 1 ? FW_B4 / T : site == 2 ? FW_B5 / T : site == 3 ? FW_B6 / T : site == 4 ? FW_B7 / T : site <= 6 ? FW_B8 / T : site == 7 ? FW_B9 / T : site == 8 ? FW_B10 / T : FW_B11 / T;
    return (unsigned)(pr == 0 ? m0 : m1); }
__device__ __forceinline__ void fill_weight_task(Frame& F, karg_t KA, const int tid, const int t) {
#if defined(PROBE_DUMMY_FILL) && PROBE_DUMMY_FILL == 1
    __builtin_amdgcn_s_sleep(127); return;
#endif
    const int lane = tid & 63, wave = __builtin_amdgcn_readfirstlane(tid >> 6);
    unsigned char* const ws = WSP();
    LAS float* scr = (LAS float*)(F.lds + wave * 16384);
    float ra[32], rb[32]; float ga = 1.f, gb = 1.f;
    const WItem ta = fw_decode(KA, ws, FW_TASK_ITEMS * t + wave), tb = fw_decode(KA, ws, FW_TASK_ITEMS * t + 8 + wave);
    P0_LOAD(ra, ga, ta); P0_LOAD(rb, gb, tb);
    P0_PROC(ra, ga, ta); P0_PROC(rb, gb, tb);
}
__device__ __forceinline__ void p0_prologue(Frame& F, const int wave0) {
    KARGS();
    int tid_ = (wave0 << 6) | opaque_lane(), bid_ = blockIdx.x, G_ = gridDim.x; asm volatile("" : "+v"(tid_), "+s"(bid_), "+s"(G_));
    const int lane = tid_ & 63, wave = __builtin_amdgcn_readfirstlane(tid_ >> 6), vcu = (G_ % 8 == 0) ? (bid_ % 8) * (G_ / 8) + bid_ / 8 : bid_;
    unsigned char* const ws = WSP(); float* const out = OUTP();
    LAS float* scr = (LAS float*)(F.lds + wave * 16384);
    const int gw = vcu * NWAVES + wave, NGW = G_ * NWAVES;
#ifdef PROBE_DUMMY_FILL
    constexpr int E5 = P0_ITEMS + FW_B11;
    auto decode = [&](int it) -> WItem { return it < P0_ITEMS ? p0_decode(KA, ws, it) : fw_decode(KA, ws, it - P0_ITEMS); };
#else
    constexpr int E5 = P0_ITEMS;
    auto decode = [&](int it) -> WItem { return p0_decode(KA, ws, it); };
#endif
    {
        float ra[32], rb[32]; float ga = 1.f, gb = 1.f; WItem ta, tb;
        int it = gw;
        if (it < E5) { ta = decode(it); P0_LOAD(ra, ga, ta); }
        while (it < E5) {
            const int it2 = it + NGW, it3 = it2 + NGW;
            if (it2 < E5) { tb = decode(it2); P0_LOAD(rb, gb, tb); }
            P0_PROC(ra, ga, ta);
            if (it3 < E5) { ta = decode(it3); P0_LOAD(ra, ga, ta); }
            if (it2 < E5) { P0_PROC(rb, gb, tb); }
            it = it3;
        }
    }
    bf16* XB = (bf16*)(ws + WS_XB); float* SS0 = (float*)(ws + WS_SS0); const float* const xp_ = FPTR(P_XP); const float* const xs_ = FPTR(P_XS);
    for (int m0 = gw; m0 < MPAD; m0 += 2 * NGW) {
        f32x4 v[2][8];
#pragma unroll
        for (int h = 0; h < 2; ++h) { const int m = m0 + h * NGW;
            if (m < MR) { const float* xrow = m < MP ? xp_ + (size_t)m * DM : xs_ + (size_t)(m - MP) * DM; const GAS f32x4* xr = (const GAS f32x4*)xrow + lane;
#pragma unroll
                for (int j = 0; j < 8; ++j) v[h][j] = __builtin_nontemporal_load(xr + 64 * j); }
            else {
#pragma unroll
                for (int j = 0; j < 8; ++j) v[h][j] = (f32x4){0.f, 0.f, 0.f, 0.f}; } }
#pragma unroll
        for (int h = 0; h < 2; ++h) { const int m = m0 + h * NGW;
            if (m < MPAD) { float s = 0.f;
#pragma unroll
                for (int j = 0; j < 8; ++j) s += (v[h][j][0] * v[h][j][0] + v[h][j][1] * v[h][j][1]) + (v[h][j][2] * v[h][j][2] + v[h][j][3] * v[h][j][3]);
                s = wave_sum(s);
                if (m >= MP && m < MR) {
                    bf16* const xbs = (bf16*)(ws + WS_XBS);
#pragma unroll
                    for (int j = 0; j < 8; ++j) { v2u w; w.x = pk2(v[h][j][0], v[h][j][1]); w.y = pk2(v[h][j][2], v[h][j][3]); *(GAS v2u*)(xbs + samp_toff(m - MP, 4 * lane + 256 * j)) = w; }
                } else {
                GAS v2u* o8 = (GAS v2u*)(XB + (size_t)m * DM) + lane;
#pragma unroll
                for (int j = 0; j < 8; ++j) { v2u w; w.x = pk2(v[h][j][0], v[h][j][1]); w.y = pk2(v[h][j][2], v[h][j][3]); o8[64 * j] = w; } }
                if (lane < 32) SS0[(size_t)m * 32 + lane] = lane == 0 ? s : 0.f;
                if (m >= MP && m < MR) { ((float*)(ws + WS_SSS))[(size_t)(m - MP) * 128 + lane] = lane == 0 ? s : 0.f; ((float*)(ws + WS_SSS))[(size_t)(m - MP) * 128 + 64 + lane] = 0.f; } } }
    }
}
constexpr int CPY_A_TASKS = 992, CPY_TASKS = 1048, CPY_CHUNK4 = 8192;
__device__ __forceinline__ void copy_task(const float* cak_, const float* cav_, const float* cbk_, const float* cbv_, float* out, const int t, const int tid) {
    constexpr size_t A_BLK4 = 512 * 512, A_CP4 = 496 * 512, A_TOT = 16 * A_CP4, B_BLK4 = 128 * 128, B_CP4 = 112 * 128, B_TOT = 16 * B_CP4;
    static_assert(2 * A_TOT == (size_t)CPY_A_TASKS * CPY_CHUNK4 && 2 * B_TOT == (size_t)(CPY_TASKS - CPY_A_TASKS) * CPY_CHUNK4, "copy tasks");
    const bool isa = t < CPY_A_TASKS; const size_t base = (size_t)(isa ? t : t - CPY_A_TASKS) * CPY_CHUNK4 + tid;
    const size_t TOT = isa ? A_TOT : B_TOT, CP4 = isa ? A_CP4 : B_CP4, BLK4 = isa ? A_BLK4 : B_BLK4, SKIP = isa ? 16 * 512 : 16 * 128;
    const f32x4* const sk = (const f32x4*)(isa ? cak_ : cbk_); const f32x4* const sv = (const f32x4*)(isa ? cav_ : cbv_);
    f32x4* const dk = (f32x4*)(out + (isa ? O_AKS : O_BKS)); f32x4* const dv = (f32x4*)(out + (isa ? O_AVS : O_BVS));
#pragma unroll 1
    for (int bq = 0; bq < CPY_CHUNK4 / 4096; ++bq) { f32x4 v[8];
#pragma unroll
        for (int e = 0; e < 8; ++e) { const size_t i = base + (size_t)(bq * 8 + e) * 512; const bool isv = i >= TOT; const size_t q = isv ? i - TOT : i, blk = q / CP4, off = q % CP4;
            v[e] = __builtin_nontemporal_load((isv ? sv : sk) + blk * BLK4 + SKIP + off); }
#pragma unroll
        for (int e = 0; e < 8; ++e) { const size_t i = base + (size_t)(bq * 8 + e) * 512; const bool isv = i >= TOT; const size_t q = isv ? i - TOT : i, blk = q / CP4, off = q % CP4;
            __builtin_nontemporal_store(v[e], (isv ? dv : dk) + blk * BLK4 + off); } }
}
#ifndef FILL_WQ
#define FILL_WQ 280u
#endif
#ifndef FILL_MOD
#define FILL_MOD 1u
#endif
#ifndef FILL_CQ
#define FILL_CQ 53u
#endif
constexpr unsigned FILL_TOTAL = FW_TASKS + CPY_TASKS, FILL_NONE = 0xfffffffeu, FILL_DONE = 0xffffffffu;
constexpr int ST_A_TASKS = 256, ST_B_TASKS = 16, CW_ST = CW_CPY + 256;
__device__ __forceinline__ void state_task(unsigned char* ws, float* out, const int pr, const bool isb, const int t, const int tid) {
    const int kv = isb ? t >> 3 : t >> 7, rem = isb ? (t & 7) : (t & 127), b = isb ? rem >> 1 : rem >> 5, r0 = isb ? (rem & 1) * 64 : (rem & 31) * 16;
    const size_t W = isb ? 512 : 2048, CLr = isb ? 128 : 512, srow = (size_t)b * 8192 + (8192 - CLr) + r0;
    const bf16* const src = (const bf16*)(ws + (kv ? WS_V : WS_K)) + srow * W;
    float* const dst = out + (isb ? (kv ? O_BVP : O_BKP) : (kv ? O_AVP : O_AKP)) + (size_t)pr * 4 * CLr * W + ((size_t)b * CLr + r0) * W;
    v4u w[8];
#pragma unroll
    for (int j = 0; j < 8; ++j) w[j] = *(const GAS v4u*)(src + 8 * (tid + 512 * j));
#pragma unroll
    for (int j = 0; j < 8; ++j) { GAS f32x4* const d = (GAS f32x4*)(dst + 8 * (tid + 512 * j));
        d[0] = (f32x4){__uint_as_float(w[j].x << 16), __uint_as_float(w[j].x & 0xffff0000u), __uint_as_float(w[j].y << 16), __uint_as_float(w[j].y & 0xffff0000u)};
        d[1] = (f32x4){__uint_as_float(w[j].z << 16), __uint_as_float(w[j].z & 0xffff0000u), __uint_as_float(w[j].w << 16), __uint_as_float(w[j].w & 0xffff0000u)}; }
}
__device__ __forceinline__ void fill_run(Frame& F, karg_t KA, const int tid, const unsigned t, const int st_pr, const bool st_b) {
    if (t >= FW_TASKS + CPY_TASKS) state_task(WSP(), OUTP(), st_pr, st_b, (int)(t - (FW_TASKS + CPY_TASKS)), tid);
    else if (t < (unsigned)FW_TASKS) fill_weight_task(F, KA, tid, (int)t);
    else copy_task(FPTR(P_CAK), FPTR(P_CAV), FPTR(P_CBK), FPTR(P_CBV), OUTP(), (int)(t - FW_TASKS), tid);
}
__device__ __forceinline__ void fill_until(Frame& F, karg_t KA, const int tid, const unsigned must, const unsigned mustc) {
    gu32* const ck = (gu32*)(WSP() + WS_CTL) + CW_CPY; gu32* const cc = ck + 64;
    for (;;) {
        if (tid == 0) { unsigned r = FILL_NONE;
            if (__hip_atomic_load(ck, RLX_AGENT) < must) { r = __hip_atomic_fetch_add(ck, 1u, RLX_AGENT); if (r >= (unsigned)FW_TASKS) r = FILL_NONE; }
            if (r == FILL_NONE && __hip_atomic_load(cc, RLX_AGENT) < mustc) { r = __hip_atomic_fetch_add(cc, 1u, RLX_AGENT); r = r < (unsigned)CPY_TASKS ? r + FW_TASKS : FILL_NONE; }
            F.MISC[17] = r; }
        __syncthreads();
        const unsigned t = F.MISC[17]; if (t >= FILL_TOTAL) break;
        fill_run(F, KA, tid, t, 0, false); __syncthreads();
    }
}
__device__ __forceinline__ void xcd_barrier_fill(const XcdBarrier& b, Frame& F, karg_t KA, const int tid, const unsigned must, const unsigned wq, const unsigned cq, const int st_mode, const int st_pr, const bool st_b) {
    gu32* const sc = (gu32*)(WSP() + WS_CTL) + CW_ST + 64 * (2 * st_pr + (st_b ? 1 : 0)); const unsigned st_n = st_b ? (unsigned)ST_B_TASKS : (unsigned)ST_A_TASKS;
    if (st_mode == 2 && F.MISC[19] < st_n) {
        for (;;) {
            if (tid == 0) { unsigned r = FILL_NONE; if (__hip_atomic_load(sc, RLX_AGENT) < st_n) { r = __hip_atomic_fetch_add(sc, 1u, RLX_AGENT); r = r < st_n ? r + FILL_TOTAL : FILL_NONE; } F.MISC[17] = r; }
            __syncthreads();
            const unsigned t = F.MISC[17]; if (t == FILL_NONE) break;
            fill_run(F, KA, tid, t, st_pr, st_b); __syncthreads();
        }
    }
    if (must != 0u && F.MISC[18] < must) fill_until(F, KA, tid, must, 0u);
    asm volatile("s_waitcnt vmcnt(0)" ::: "memory");
    __syncthreads();
    unsigned gen = 0u; bool open = false;
    if (tid == 0) {
        unsigned* bar = b.bar;
        __builtin_amdgcn_s_waitcnt(0);
        unsigned nloc = b.st[0], nx = b.st[1];
        if (nloc == 0u) { xcd_barrier_complete(bar, b.x, nloc, nx); b.st[0] = nloc; b.st[1] = nx; }
        const unsigned old = xb_add(&bar[XB_XSUB(b.x)], 1u);
        gen = old / nloc;
        if (old + 1u == (gen + 1u) * nloc) {
            __builtin_amdgcn_fence(__ATOMIC_RELEASE, "agent");
            asm volatile("s_waitcnt vmcnt(0)" ::: "memory");
            const unsigned og = xb_add(&bar[XB_TOP], 1u);
            const unsigned tg = og / nx;
            if (og + 1u == (tg + 1u) * nx) xb_add(&bar[XB_TOPGEN], 1u);
            else XB_SPIN(xb_ld(&bar[XB_TOPGEN]) == tg, bar);
            __builtin_amdgcn_fence(__ATOMIC_ACQUIRE, "agent");
            xb_add(&bar[XB_XGEN(b.x)], 1u);
            asm volatile("s_waitcnt vmcnt(0)" ::: "memory");
            open = true;
        }
    }
    gu32* const ck = (gu32*)(WSP() + WS_CTL) + CW_CPY; gu32* const cc = ck + 64;
    for (;;) {
        if (tid == 0) {
            unsigned r = FILL_DONE;
            if (!open) {
                unsigned* bar = b.bar;
                if (xb_ld(&bar[XB_XGEN(b.x)]) == gen) {
                    r = FILL_NONE;
                    if (st_mode == 1 && __hip_atomic_load(sc, RLX_AGENT) < st_n) { r = __hip_atomic_fetch_add(sc, 1u, RLX_AGENT); r = r < st_n ? r + FILL_TOTAL : FILL_NONE; }
                    if (r == FILL_NONE && __hip_atomic_load(ck, RLX_AGENT) < wq) { r = __hip_atomic_fetch_add(ck, 1u, RLX_AGENT); if (r >= (unsigned)FW_TASKS) r = FILL_NONE; }
                    if (r == FILL_NONE && __hip_atomic_load(cc, RLX_AGENT) < cq) { r = __hip_atomic_fetch_add(cc, 1u, RLX_AGENT); r = r < (unsigned)CPY_TASKS ? r + FW_TASKS : FILL_NONE; }
                    if (r == FILL_NONE) { XB_SPIN(xb_ld(&bar[XB_XGEN(b.x)]) == gen, bar); r = FILL_DONE; }
                }
                if (r == FILL_DONE) { __builtin_amdgcn_fence(__ATOMIC_ACQUIRE, "agent"); asm volatile("s_waitcnt vmcnt(0)" ::: "memory"); }
            }
            F.MISC[17] = r;
        }
        __syncthreads();
        const unsigned t = F.MISC[17]; if (t == FILL_DONE) break;
        fill_run(F, KA, tid, t, st_pr, st_b); __syncthreads();
    }
}
__device__ __forceinline__ void final_norm(Frame& F, const int wave0) {
    KARGS();
    int tid_ = (wave0 << 6) | opaque_lane(), bid_ = blockIdx.x, G_ = gridDim.x; asm volatile("" : "+v"(tid_), "+s"(bid_), "+s"(G_));
    const int lane = tid_ & 63, wave = __builtin_amdgcn_readfirstlane(tid_ >> 6), vcu = (G_ % 8 == 0) ? (bid_ % 8) * (G_ / 8) + bid_ / 8 : bid_;
    float* const out = OUTP(); const float* const nfin_ = FPTR(P_NFIN); const bf16* const XB = (const bf16*)(WSP() + WS_XB);
    const int gw = vcu * NWAVES + wave, NGW = G_ * NWAVES;
    f32x4 g[4][2];
#pragma unroll
    for (int j = 0; j < 4; ++j) { g[j][0] = *(const GAS f32x4*)(nfin_ + 512 * j + 8 * lane); g[j][1] = *(const GAS f32x4*)(nfin_ + 512 * j + 8 * lane + 4); }
#define FN_LOAD(W, M) do { if ((M) < MP) { const GAS v4u* xr_ = (const GAS v4u*)(XB + (size_t)(M) * DM) + lane; _Pragma("unroll") for (int j = 0; j < 4; ++j) W[j] = xr_[64 * j]; } \
        else { const bf16* const xbs_ = (const bf16*)(WSP() + WS_XBS); _Pragma("unroll") for (int j = 0; j < 4; ++j) W[j] = *(const GAS v4u*)(xbs_ + samp_toff((M) - MP, 8 * lane + 512 * j)); } } while (0)
    for (int m0 = gw; m0 < MR; m0 += 4 * NGW) {
        v4u w[4][4];
#pragma unroll
        for (int r = 0; r < 4; ++r) { const int mr = m0 + r * NGW; if (mr < MR) FN_LOAD(w[r], mr); }
#pragma unroll
        for (int r = 0; r < 4; ++r) { const int mr = m0 + r * NGW;
            if (mr < MR) { float s = 0.f; f32x4 v[4][2];
#pragma unroll
                for (int j = 0; j < 4; ++j) { v[j][0] = (f32x4){__uint_as_float(w[r][j].x << 16), __uint_as_float(w[r][j].x & 0xffff0000u), __uint_as_float(w[r][j].y << 16), __uint_as_float(w[r][j].y & 0xffff0000u)};
                    v[j][1] = (f32x4){__uint_as_float(w[r][j].z << 16), __uint_as_float(w[r][j].z & 0xffff0000u), __uint_as_float(w[r][j].w << 16), __uint_as_float(w[r][j].w & 0xffff0000u)};
#pragma unroll
                    for (int h = 0; h < 2; ++h) s += (v[j][h][0] * v[j][h][0] + v[j][h][1] * v[j][h][1]) + (v[j][h][2] * v[j][h][2] + v[j][h][3] * v[j][h][3]); }
                const float rs = 1.0f / sqrtf(wave_sum(s) * (1.0f / DM) + 1e-6f);
                GAS f32x4* yr = (GAS f32x4*)(out + (size_t)mr * DM + 8 * lane);
#pragma unroll
                for (int j = 0; j < 4; ++j) { yr[128 * j] = v[j][0] * rs * g[j][0]; yr[128 * j + 1] = v[j][1] * rs * g[j][1]; } } }
    }
#undef FN_LOAD
}

#ifndef WGM_BIG
#define WGM_BIG 4
#endif
#ifndef GP_ALIGN
#define GP_ALIGN true
#endif
#ifndef GP_SP2
#define GP_SP2 true
#endif
struct Args { const float* in[17]; float* out; unsigned char* ws; int pr_lo, pr_hi; };
template <int SITE> __global__ void __launch_bounds__(NWAVES * 64, 2) mk_fwd(Args args) {
    extern __shared__ __attribute__((aligned(16))) unsigned char lds[];
    Frame F;
    F.lds = (LAS unsigned char*)lds;
    F.MISC = (volatile LAS unsigned*)(F.lds + MISC_OFF);
    for (int u = threadIdx.x; u < (LDS_BYTES - RING_BYTES) / 4; u += NWAVES * 64) ((LAS unsigned*)(F.lds + RING_BYTES))[u] = 0u;
    __syncthreads();
    constexpr bool ALL = SITE < 0;
    const int wave0 = __builtin_amdgcn_readfirstlane(threadIdx.x >> 6);
    XcdBarrier bar; bar.bar = nullptr; bar.x = 0; bar.st = nullptr;
    if constexpr (ALL) { KARGS(); bar = xcd_barrier_post((unsigned*)(WSP() + WS_CTL) + CW_BAR, F.MISC + 8); }
#ifndef PHM
#define PHM 0xFFFF
#endif
#define ON(b) (((PHM >> (b)) & 1) && (ALL || SITE == (b)))
#ifdef TS_DIAG
    volatile LAS unsigned long long* const TSW = (volatile LAS unsigned long long*)(F.lds + MISC_OFF + 128);
    if (wave0 == 0 && opaque_lane() == 0) TSW[0] = __builtin_amdgcn_s_memrealtime();
#ifndef TS_BLOCK
#define TS_BLOCK 0
#endif
#ifndef TS_B
#define TS_B (-1)
#endif
#define TS_MARK(cat) do { if (((cat) == TS_A || (cat) == TS_B || true) && wave0 == 0 && opaque_lane() == 0) { const unsigned long long now_ = __builtin_amdgcn_s_memrealtime(), d_ = now_ - TSW[0]; if ((cat) == TS_A) TSW[1] += d_; if ((cat) == TS_B) TSW[2] += d_; TSW[0] = now_; } } while (0)
#else
#define TS_MARK(cat) do {} while (0)
#endif
#define SEAM(site) do { if constexpr (ALL) { KARGS(); OTID(ftid); XcdBarrier b_ = bar; asm volatile("" : "+s"(b_.bar)); { const unsigned e1_ = (unsigned)(((site) ? pr_ * 10 : 0) + (site) + 1); const bool el_ = (((blockIdx.x >> 3) + e1_) & (FILL_MOD - 1u)) == 0u;     \
        constexpr bool att_ = (site) == 2 || (site) == 7;     \
        xcd_barrier_fill(b_, F, KA, ftid, fill_must((site) ? pr_ : 0, (site)), att_ ? (unsigned)FW_TASKS : (el_ ? e1_ * FILL_WQ : 0u), att_ ? (unsigned)CPY_TASKS : (el_ ? e1_ * FILL_CQ : 0u), att_ ? 1 : (((site) == 3 || (site) == 8) ? 2 : 0), pr_, (site) == 7 || (site) == 8); } TS_MARK(8); } } while (0)
#define OTID(name) int name = (wave0 << 6) | opaque_lane(); asm volatile("" : "+v"(name))
#define DYN_TASKS(tidv, TKT, NTASKS, ...) do { gu32* const tk_ = (gu32*)(ws + WS_CTL) + CW_TKT + 64 * (TKT); \
        for (;;) { if ((tidv) == 0) { const unsigned tk1_ = __hip_atomic_fetch_add(tk_, 1u, __ATOMIC_RELAXED, __HIP_MEMORY_SCOPE_AGENT), fc1_ = __hip_atomic_load((gu32*)(ws + WS_CTL) + CW_CPY, RLX_AGENT); F.MISC[16] = tk1_; F.MISC[18] = fc1_; }     \
            __syncthreads(); const int t = (int)F.MISC[16]; if (t >= (NTASKS)) break; __VA_ARGS__; __syncthreads(); } } while (0)
#define DYN_TASKS_PRE(tidv, TKT, NTASKS, ...) do { gu32* const tk_ = (gu32*)(ws + WS_CTL) + CW_TKT + 64 * (TKT); \
        for (bool first_ = true;; first_ = false) { if ((tidv) == 0 && !first_) { const unsigned tk1_ = __hip_atomic_fetch_add(tk_, 1u, __ATOMIC_RELAXED, __HIP_MEMORY_SCOPE_AGENT), fc1_ = __hip_atomic_load((gu32*)(ws + WS_CTL) + CW_CPY, RLX_AGENT); F.MISC[16] = tk1_; F.MISC[18] = fc1_; }     \
            __syncthreads(); const int t = (int)F.MISC[16]; if (t >= (NTASKS)) break; __VA_ARGS__; __syncthreads(); } } while (0)
#define SITE_IDS() KARGS(); OTID(otid); (void)otid; int bid = blockIdx.x, G = gridDim.x; asm volatile("" : "+s"(bid), "+s"(G)); const int vcu = (G % 8 == 0) ? (bid % 8) * (G / 8) + bid / 8 : bid; (void)vcu
    LAS char* const alds = (LAS char*)F.lds;

    { const int pr_ = 0; if (ON(0)) { p0_prologue(F, wave0); TS_MARK(0); } SEAM(0); }

    for (int pr = args.pr_lo; pr < args.pr_hi; ++pr) { const int pr_ = pr;
        if (ON(1)) {
            SITE_IDS(); const int TKT_ID = pr * 12 + 1; (void)TKT_ID;
            unsigned char* const ws = WSP();
            pg8::Gemm g{(const bf16*)(ws + WS_XB), (const bf16*)(ws + WS_WQA + (size_t)pr * 24 * MiB), MP, 6144, 2048}; pg8::StaticOrder S; S.init(MP, 6144, G, bid, WGM_BIG);
            pg8::EpiQKV<false> E{ws, OUTP(), pr};
            pg8::gemm_phase<pg8::EpiQKV<false>, pg8::StaticOrder, GP_ALIGN, GP_SP2>(F.lds, g, S, E, otid, pg8::Tail{(unsigned*)(ws + WS_CTL) + CW_TKT + 64 * TKT_ID, (unsigned*)(ws + WS_CTL) + CW_CPY, (volatile PG8_LAS unsigned*)(F.MISC + 16), nullptr});
            { mini::EpiQKV<false> ME{ws, OUTP(), pr}; OTID(mtid);
              DYN_TASKS_PRE(mtid, TKT_ID, 6144 / 32, mini::task<mini::EpiQKV<false>, 2, 2>(mtid, (const bf16*)(ws + WS_XBS), g.Bt, 2048, 32 * t, (LAS float*)F.lds, ME)); }
        TS_MARK(1); } SEAM(1);
        if (ON(2)) {
            SITE_IDS(); const int TKT_ID = pr * 12 + 2; (void)TKT_ID;
            unsigned char* const ws = WSP(); const bf16* const QB = (const bf16*)(ws + WS_Q); bf16* const OB = (bf16*)(ws + WS_O); const bf16* const KB = (const bf16*)(ws + WS_K); const bf16* const VB = (const bf16*)(ws + WS_V);
            const float* rel = FPTR(P_AREL) + (size_t)pr * 16 * 257;
            for (int u = vcu; u < 2048; u += G) { const int bh = u >> 5, qb = u & 31;
                att::attnA_unit(otid, bh >> 4, bh & 15, qb, QB, KB, VB, OB, rel + (bh & 15) * 257, alds); }
            __syncthreads();
            OTID(otid2);
            DYN_TASKS(otid2, TKT_ID, 128, att::sample_attn_unit<128, 512, true>(otid2, t >> 4, t & 15, QB, KB, VB, (bf16*)(ws + WS_OS), FPTR(P_CAK) + (size_t)pr * 8 * 512 * 2048, FPTR(P_CAV) + (size_t)pr * 8 * 512 * 2048, rel + (t & 15) * 257, alds));
            __syncthreads();
        TS_MARK(2); } SEAM(2);
        if (ON(3)) {
            SITE_IDS(); const int TKT_ID = pr * 12 + 3; (void)TKT_ID;
            unsigned char* const ws = WSP();
            pg8::Gemm g{(const bf16*)(ws + WS_O), (const bf16*)(ws + WS_WOA + (size_t)pr * 8 * MiB), MP, 2048, 2048}; pg8::StaticOrder S; S.init(MP, 2048, G, bid, 4);
            pg8::EpiRes E{ws, 1};
            pg8::gemm_phase<pg8::EpiRes, pg8::StaticOrder, GP_ALIGN, GP_SP2>(F.lds, g, S, E, otid, pg8::Tail{(unsigned*)(ws + WS_CTL) + CW_TKT + 64 * TKT_ID, (unsigned*)(ws + WS_CTL) + CW_CPY, (volatile PG8_LAS unsigned*)(F.MISC + 16), (unsigned*)(ws + WS_CTL) + CW_ST + 64 * (2 * pr + 0)});
            { mini::EpiRes ME{ws, 1}; OTID(mtid);
              DYN_TASKS_PRE(mtid, TKT_ID, 2048 / 16, mini::task<mini::EpiRes, 1, 4>(mtid, (const bf16*)(ws + WS_OS), g.Bt, 2048, 16 * t, (LAS float*)F.lds, ME)); }
        TS_MARK(4); } SEAM(3);
        if (ON(4)) {
            SITE_IDS(); const int TKT_ID = pr * 12 + 4; (void)TKT_ID;
            unsigned char* const ws = WSP();
            pg8::Gemm g{(const bf16*)(ws + WS_XB), (const bf16*)(ws + WS_WUP + (size_t)(2 * pr) * 32 * MiB), MP, 8192, 2048}; pg8::StaticOrder S; S.init(MP, 8192, G, bid, WGM_BIG);
            pg8::EpiUp E{ws};
            pg8::gemm_phase<pg8::EpiUp, pg8::StaticOrder, GP_ALIGN, GP_SP2>(F.lds, g, S, E, otid, pg8::Tail{(unsigned*)(ws + WS_CTL) + CW_TKT + 64 * TKT_ID, (unsigned*)(ws + WS_CTL) + CW_CPY, (volatile PG8_LAS unsigned*)(F.MISC + 16), nullptr});
            { mini::EpiUp ME{ws}; OTID(mtid);
              DYN_TASKS_PRE(mtid, TKT_ID, 8192 / 32, mini::task<mini::EpiUp, 2, 2>(mtid, (const bf16*)(ws + WS_XBS), g.Bt, 2048, 32 * t, (LAS float*)F.lds, ME)); }
        TS_MARK(5); } SEAM(4);
        if (ON(5)) {
            SITE_IDS(); const int TKT_ID = pr * 12 + 5; (void)TKT_ID;
            unsigned char* const ws = WSP();
            pg8::Gemm g{(const bf16*)(ws + WS_ACT), (const bf16*)(ws + WS_WDN + (size_t)(2 * pr) * 32 * MiB), MP, 2048, 8192}; pg8::StaticOrder S; S.init(MP, 2048, G, bid, 4, 0);
            pg8::EpiRes E{ws, 0};
            pg8::gemm_phase<pg8::EpiRes, pg8::StaticOrder, GP_ALIGN, GP_SP2, true>(F.lds, g, S, E, otid, pg8::Tail{(unsigned*)(ws + WS_CTL) + CW_TKT + 64 * TKT_ID, (unsigned*)(ws + WS_CTL) + CW_CPY, (volatile PG8_LAS unsigned*)(F.MISC + 16), nullptr});
            { mini::EpiRes ME{ws, 0}; OTID(mtid);
              DYN_TASKS_PRE(mtid, TKT_ID, 2048 / 16, mini::task<mini::EpiRes, 1, 4>(mtid, (const bf16*)(ws + WS_HS), g.Bt, 8192, 16 * t, (LAS float*)F.lds, ME)); }
        TS_MARK(6); } SEAM(5);
        if (ON(6)) {
            SITE_IDS(); const int TKT_ID = pr * 12 + 6; (void)TKT_ID;
            unsigned char* const ws = WSP();
            pg8::Gemm g{(const bf16*)(ws + WS_XB), (const bf16*)(ws + WS_WQB + (size_t)pr * 12 * MiB), MP, 3072, 2048}; pg8::StaticOrder S; S.init(MP, 3072, G, bid, WGM_BIG);
            pg8::EpiQKV<true> E{ws, OUTP(), pr};
            pg8::gemm_phase<pg8::EpiQKV<true>, pg8::StaticOrder, GP_ALIGN, GP_SP2>(F.lds, g, S, E, otid, pg8::Tail{(unsigned*)(ws + WS_CTL) + CW_TKT + 64 * TKT_ID, (unsigned*)(ws + WS_CTL) + CW_CPY, (volatile PG8_LAS unsigned*)(F.MISC + 16), nullptr});
            { mini::EpiQKV<true> ME{ws, OUTP(), pr}; OTID(mtid);
              DYN_TASKS_PRE(mtid, TKT_ID, 3072 / 16, mini::task<mini::EpiQKV<true>, 1, 4>(mtid, (const bf16*)(ws + WS_XBS), g.Bt, 2048, 16 * t, (LAS float*)F.lds, ME)); }
        TS_MARK(1); } SEAM(6);
        if (ON(7)) {
            SITE_IDS(); const int TKT_ID = pr * 12 + 7; (void)TKT_ID;
            unsigned char* const ws = WSP(); const bf16* const QB = (const bf16*)(ws + WS_Q); bf16* const OB = (bf16*)(ws + WS_O); const bf16* const KB = (const bf16*)(ws + WS_K); const bf16* const VB = (const bf16*)(ws + WS_V);
            const float* sinks = FPTR(P_BSINK) + pr * 32;
            for (int u = vcu; u < 256; u += G) { const int bk = u >> 3, run = u & 7;
                att::attnB_unit(otid, bk >> 3, bk & 7, run, QB, KB, VB, OB, sinks, alds); }
            __syncthreads();
            OTID(otid2);
            DYN_TASKS(otid2, TKT_ID, 256, att::sample_attn_unit<64, 128, false>(otid2, t >> 5, t & 31, QB, KB, VB, (bf16*)(ws + WS_OS), FPTR(P_CBK) + (size_t)pr * 8 * 128 * 512, FPTR(P_CBV) + (size_t)pr * 8 * 128 * 512, sinks, alds));
            __syncthreads();
        TS_MARK(3); } SEAM(7);
        if (ON(8)) {
            SITE_IDS(); const int TKT_ID = pr * 12 + 8; (void)TKT_ID;
            unsigned char* const ws = WSP();
            pg8::Gemm g{(const bf16*)(ws + WS_O), (const bf16*)(ws + WS_WOB + (size_t)pr * 8 * MiB), MP, 2048, 2048}; pg8::StaticOrder S; S.init(MP, 2048, G, bid, 4);
            pg8::EpiRes E{ws, 1};
            pg8::gemm_phase<pg8::EpiRes, pg8::StaticOrder, GP_ALIGN, GP_SP2>(F.lds, g, S, E, otid, pg8::Tail{(unsigned*)(ws + WS_CTL) + CW_TKT + 64 * TKT_ID, (unsigned*)(ws + WS_CTL) + CW_CPY, (volatile PG8_LAS unsigned*)(F.MISC + 16), (unsigned*)(ws + WS_CTL) + CW_ST + 64 * (2 * pr + 1)});
            { mini::EpiRes ME{ws, 1}; OTID(mtid);
              DYN_TASKS_PRE(mtid, TKT_ID, 2048 / 16, mini::task<mini::EpiRes, 1, 4>(mtid, (const bf16*)(ws + WS_OS), g.Bt, 2048, 16 * t, (LAS float*)F.lds, ME)); }
        TS_MARK(4); } SEAM(8);
        if (ON(9)) {
            SITE_IDS(); const int TKT_ID = pr * 12 + 9; (void)TKT_ID;
            unsigned char* const ws = WSP();
            pg8::Gemm g{(const bf16*)(ws + WS_XB), (const bf16*)(ws + WS_WUP + (size_t)(2 * pr + 1) * 32 * MiB), MP, 8192, 2048}; pg8::StaticOrder S; S.init(MP, 8192, G, bid, WGM_BIG);
            pg8::EpiUp E{ws};
            pg8::gemm_phase<pg8::EpiUp, pg8::StaticOrder, GP_ALIGN, GP_SP2>(F.lds, g, S, E, otid, pg8::Tail{(unsigned*)(ws + WS_CTL) + CW_TKT + 64 * TKT_ID, (unsigned*)(ws + WS_CTL) + CW_CPY, (volatile PG8_LAS unsigned*)(F.MISC + 16), nullptr});
            { mini::EpiUp ME{ws}; OTID(mtid);
              DYN_TASKS_PRE(mtid, TKT_ID, 8192 / 32, mini::task<mini::EpiUp, 2, 2>(mtid, (const bf16*)(ws + WS_XBS), g.Bt, 2048, 32 * t, (LAS float*)F.lds, ME)); }
        TS_MARK(5); } SEAM(9);
        if (ON(10)) {
            SITE_IDS(); const int TKT_ID = pr * 12 + 10; (void)TKT_ID;
            unsigned char* const ws = WSP();
            pg8::Gemm g{(const bf16*)(ws + WS_ACT), (const bf16*)(ws + WS_WDN + (size_t)(2 * pr + 1) * 32 * MiB), MP, 2048, 8192}; pg8::StaticOrder S; S.init(MP, 2048, G, bid, 4, 0);
            pg8::EpiRes E{ws, 0};
            pg8::gemm_phase<pg8::EpiRes, pg8::StaticOrder, GP_ALIGN, GP_SP2, true>(F.lds, g, S, E, otid, pg8::Tail{(unsigned*)(ws + WS_CTL) + CW_TKT + 64 * TKT_ID, (unsigned*)(ws + WS_CTL) + CW_CPY, (volatile PG8_LAS unsigned*)(F.MISC + 16), nullptr});
            { mini::EpiRes ME{ws, 0}; OTID(mtid);
              DYN_TASKS_PRE(mtid, TKT_ID, 2048 / 16, mini::task<mini::EpiRes, 1, 4>(mtid, (const bf16*)(ws + WS_HS), g.Bt, 8192, 16 * t, (LAS float*)F.lds, ME)); }
        TS_MARK(6); } SEAM(10);
    }
    if (ON(11)) { final_norm(F, wave0); if constexpr (ALL) { KARGS(); OTID(ftid); __syncthreads(); fill_until(F, KA, ftid, FW_TASKS, CPY_TASKS); } }
#ifdef TS_DIAG
    TS_MARK(7);
    if constexpr (ALL) { { XcdBarrier b_ = bar; xcd_barrier(b_); } KARGS(); float* const out = OUTP(); __syncthreads(); const float va = (float)TSW[1] * 0.001f;
        OTID(dtid); if (blockIdx.x == TS_BLOCK && dtid == 0) out[(size_t)MP * DM] = va; }
#endif
#undef ON
#undef SEAM
}

extern "C" void kernel_launch(void* const* d_in, const int* in_sizes, int n_in, void* d_out, int out_size, void* d_ws, size_t ws_size, hipStream_t stream) {
    static int grid = 0;
    if (grid == 0) {
        if (n_in != 17 || in_sizes[0] != MP * DM || (size_t)out_size != O_END || ws_size < WS_END) { fprintf(stderr, "kernel_launch: unexpected shapes (n_in %d, in0 %d, out %d, ws %zu)\n", n_in, n_in > 0 ? in_sizes[0] : -1, out_size, ws_size); grid = -1; return; }
        int dev = 0, cus = 0, per_cu = 0;
        if (hipGetDevice(&dev) != hipSuccess || hipDeviceGetAttribute(&cus, hipDeviceAttributeMultiprocessorCount, dev) != hipSuccess) { grid = -1; return; }
#if MK_ONE_LAUNCH
        if (hipFuncSetAttribute((const void*)mk_fwd<-1>, hipFuncAttributeMaxDynamicSharedMemorySize, LDS_BYTES) != hipSuccess) { fprintf(stderr, "kernel_launch: hipFuncSetAttribute failed\n"); grid = -1; return; }
        if (hipOccupancyMaxActiveBlocksPerMultiprocessor(&per_cu, (const void*)mk_fwd<-1>, NWAVES * 64, LDS_BYTES) != hipSuccess || per_cu < 1) { fprintf(stderr, "kernel_launch: occupancy query reports %d workgroups per CU\n", per_cu); grid = -1; return; }
#else
#define SETATTR(s) (hipFuncSetAttribute((const void*)mk_fwd<s>, hipFuncAttributeMaxDynamicSharedMemorySize, LDS_BYTES) == hipSuccess)
        if (!(SETATTR(0) && SETATTR(1) && SETATTR(2) && SETATTR(3) && SETATTR(4) && SETATTR(5) && SETATTR(6) && SETATTR(7) && SETATTR(8) && SETATTR(9) && SETATTR(10) && SETATTR(11))) { fprintf(stderr, "kernel_launch: hipFuncSetAttribute failed\n"); grid = -1; return; }
        per_cu = 1;
#endif
        (void)hipGetLastError();
        grid = cus;
    }
    if (grid < 0) return;
    if (hipMemsetAsync((char*)d_ws + WS_CTL, 0, CTL_ZERO_BYTES, stream) != hipSuccess) return;
    Args a{};
    for (int i = 0; i < 17; ++i) a.in[i] = (const float*)d_in[i];
    a.out = (float*)d_out; a.ws = (unsigned char*)d_ws;
#if MK_ONE_LAUNCH
    a.pr_lo = 0; a.pr_hi = 2;
    hipLaunchKernelGGL(mk_fwd<-1>, dim3(grid), dim3(NWAVES * 64), LDS_BYTES, stream, a);
#else
#define LAUNCH_SITE(s, p0, p1) do { a.pr_lo = (p0); a.pr_hi = (p1); hipLaunchKernelGGL(mk_fwd<s>, dim3(grid), dim3(NWAVES * 64), LDS_BYTES, stream, a); } while (0)
    LAUNCH_SITE(0, 0, 0);
    for (int p = 0; p < 2; ++p) { LAUNCH_SITE(1, p, p + 1); LAUNCH_SITE(2, p, p + 1); LAUNCH_SITE(3, p, p + 1); LAUNCH_SITE(4, p, p + 1); LAUNCH_SITE(5, p, p + 1);
                                  LAUNCH_SITE(6, p, p + 1); LAUNCH_SITE(7, p, p + 1); LAUNCH_SITE(8, p, p + 1); LAUNCH_SITE(9, p, p + 1); LAUNCH_SITE(10, p, p + 1); }
    LAUNCH_SITE(11, 0, 0);
#endif
    const hipError_t le = hipPeekAtLastError();
    if (le != hipSuccess) fprintf(stderr, "kernel_launch: launch failed: %s\n", hipGetErrorName(le));
}
```
